# Optimizing an MI355X kernel written in HIP

```python
import math
import jax
import jax.numpy as jnp
from jax import lax
import numpy as np

D_MODEL = 1024
BATCH = 32
SEQ = 256
DEPTH = 2
DEC_BATCH = 8
DEC_SEQ = 2048
PAST_LEN = 256

GRID_W = 64
EPS = 1e-6
N_EVEN = (DEPTH + 1) // 2
N_ODD = DEPTH // 2

SSD_HEADS = 8
SSD_HEAD_DIM = 64
SSD_WIDTH = SSD_HEADS * SSD_HEAD_DIM
SSD_GROUPS = 2
SSD_HPG = SSD_HEADS // SSD_GROUPS
SSD_STATE = 64
SSD_GN = SSD_GROUPS * SSD_STATE
SSD_XBC = SSD_WIDTH + 2 * SSD_GN
SSD_CHUNK = 128
CONV_W = 5

NA_HEADS = 8
NA_HEAD_DIM = 64
NA_WIDTH = NA_HEADS * NA_HEAD_DIM
NA_ROWS = 8
NA_COLS = 16
NA_SCALE = NA_HEAD_DIM ** -0.5
CTX_BLOCK = 128

O_XBC = SSD_WIDTH
O_DT = O_XBC + SSD_XBC
O_Q = O_DT + SSD_HEADS
O_K = O_Q + NA_WIDTH
O_V = O_K + NA_WIDTH
EVEN_IN = O_V + NA_WIDTH
EVEN_MIX = SSD_WIDTH + NA_WIDTH

S5_GROUP_CH = 16
S5_GROUPS = 32
S5_WIDTH = S5_GROUPS * S5_GROUP_CH
S5_STATE = 64

FNET_GROUP_CH = 64
FNET_GROUPS = 8
FNET_WIDTH = FNET_GROUPS * FNET_GROUP_CH
ODD_IN = S5_WIDTH + FNET_WIDTH

FFN_HIDDEN = -(-8 * D_MODEL // (3 * 256)) * 256

kernel_name = 'hybrid_ssd_na_s5_fnet_prefix_step'


def rmsnorm(x, g):
    xf = x.astype(jnp.float32)
    y = xf * lax.rsqrt(jnp.mean(xf * xf, axis=-1, keepdims=True) + EPS)
    return (y * g.astype(jnp.float32)).astype(x.dtype)


def adaln(cond, w, b):
    m = jax.nn.silu(cond) @ w + b
    return jnp.split(m, 6, axis=-1)


def modulate(h, shift, scale):
    return h * (1 + scale[:, None]) + shift[:, None]


def swiglu(h, w1, w3, w2):
    return (jax.nn.silu(h @ w1) * (h @ w3)) @ w2


def dwconv(x, w, bias):
    ch = x.shape[-1]
    y = lax.conv_general_dilated(
        x, w[:, None, :].astype(x.dtype), window_strides=(1,),
        padding=[(CONV_W // 2, CONV_W // 2)],
        dimension_numbers=('NWC', 'WIO', 'NWC'), feature_group_count=ch)
    return y + bias.astype(x.dtype)


def ssd_scan(x, dt, a, bmat, cmat, s0):
    f32 = jnp.float32
    b, L, H, P = x.shape
    N = bmat.shape[-1]
    Q = SSD_CHUNK
    nc = L // Q
    xdt = (x.astype(f32) * dt[..., None]).reshape(b, nc, Q, H, P)
    bc = bmat.astype(f32).reshape(b, nc, Q, H, N)
    cc = cmat.astype(f32).reshape(b, nc, Q, H, N)
    cum = jnp.cumsum((dt * a).reshape(b, nc, Q, H), axis=2)
    causal = jnp.tril(jnp.ones((Q, Q), dtype=bool))[None, None, :, :, None]
    seg = cum[:, :, :, None, :] - cum[:, :, None, :, :]
    decay = jnp.exp(jnp.where(causal, seg, -jnp.inf))
    cb = jnp.einsum('bcihn,bcjhn->bcijh', cc, bc)
    y_diag = jnp.einsum('bcijh,bcjhp->bcihp', cb * decay, xdt)
    to_end = jnp.exp(cum[:, :, -1:, :] - cum)
    chunk_states = jnp.einsum('bcjhn,bcjh,bcjhp->bchpn', bc, to_end, xdt)
    chunk_decay = jnp.exp(cum[:, :, -1, :])

    def step(s, inp):
        cs, cd = inp
        return s * cd[:, :, None, None] + cs, s

    s_final, s_in = lax.scan(
        step, s0.astype(f32),
        (jnp.moveaxis(chunk_states, 1, 0), jnp.moveaxis(chunk_decay, 1, 0)))
    s_in = jnp.moveaxis(s_in, 0, 1)
    y_off = jnp.einsum('bcihn,bchpn,bcih->bcihp', cc, s_in, jnp.exp(cum))
    return (y_diag + y_off).reshape(b, L, H, P), s_final


def ssd_mixer(z, xbc, dt_raw, conv_w, conv_b, a_log, dt_bias, d_skip, norm_g, s0):
    f32 = jnp.float32
    b, L, _ = z.shape
    xbc = jax.nn.silu(dwconv(xbc, conv_w, conv_b))
    xs = xbc[..., :SSD_WIDTH].reshape(b, L, SSD_HEADS, SSD_HEAD_DIM)
    bm = jnp.repeat(
        xbc[..., SSD_WIDTH:SSD_WIDTH + SSD_GN].reshape(b, L, SSD_GROUPS, SSD_STATE),
        SSD_HPG, axis=2)
    cm = jnp.repeat(
        xbc[..., SSD_WIDTH + SSD_GN:].reshape(b, L, SSD_GROUPS, SSD_STATE),
        SSD_HPG, axis=2)
    y = d_skip.astype(f32)[:, None] * xs.astype(f32)
    finals = []
    for d in range(2):
        dt = jax.nn.softplus(dt_raw.astype(f32) + dt_bias[d].astype(f32))
        a = -jnp.exp(a_log[d].astype(f32))
        if d == 0:
            yd, sf = ssd_scan(xs, dt, a, bm, cm, s0[:, 0])
        else:
            yd, sf = ssd_scan(
                jnp.flip(xs, 1), jnp.flip(dt, 1), a,
                jnp.flip(bm, 1), jnp.flip(cm, 1), s0[:, 1])
            yd = jnp.flip(yd, 1)
        y = y + yd
        finals.append(sf)
    y = y.reshape(b, L, SSD_WIDTH) * jax.nn.silu(z.astype(f32))
    y = rmsnorm(y, norm_g)
    return y.astype(z.dtype), jnp.stack(finals, axis=1)


def ctx_attention(q, k, v):
    b, Lc, H, Dh = q.shape
    nb = Lc // CTX_BLOCK
    qb = jnp.moveaxis(q.reshape(b, nb, CTX_BLOCK, H, Dh), 1, 0)

    def blk(qi):
        s = jnp.einsum('bqhd,bkhd->bhqk', qi, k).astype(jnp.float32) * NA_SCALE
        p = jax.nn.softmax(s, axis=-1).astype(v.dtype)
        return jnp.einsum('bhqk,bkhd->bqhd', p, v)

    o = lax.map(blk, qb)
    return jnp.moveaxis(o, 0, 1).reshape(b, Lc, H * Dh)


def latent_na(q, k, v, k_ctx, v_ctx, rpb):
    b, L, H, Dh = q.shape
    rows = L // GRID_W
    kr = min(NA_ROWS, rows)
    qg = q.reshape(b, rows, GRID_W, H, Dh)
    kg = k.reshape(b, rows, GRID_W, H, Dh)
    vg = v.reshape(b, rows, GRID_W, H, Dh)
    col = jnp.arange(GRID_W)
    cs = jnp.clip(col - NA_COLS // 2, 0, GRID_W - NA_COLS)
    col_ok = (col[None, :] >= cs[:, None]) & (col[None, :] < cs[:, None] + NA_COLS)
    dc_idx = jnp.clip(col[None, :] - col[:, None] + NA_COLS - 1, 0, 2 * NA_COLS - 2)
    rpb32 = rpb.astype(jnp.float32)

    def row_block(r):
        rs = jnp.clip(r - kr // 2, 0, rows - kr)
        qr = lax.dynamic_index_in_dim(qg, r, axis=1, keepdims=False)
        kb = lax.dynamic_slice_in_dim(kg, rs, kr, axis=1)
        vb = lax.dynamic_slice_in_dim(vg, rs, kr, axis=1)
        dr_idx = rs + jnp.arange(kr) - r + NA_ROWS - 1
        bias = rpb32[:, dr_idx][:, :, dc_idx]
        s_loc = (jnp.einsum('bqhd,bikhd->bhqik', qr, kb).astype(jnp.float32) * NA_SCALE
                 + jnp.transpose(bias, (0, 2, 1, 3))[None])
        s_loc = jnp.where(col_ok[None, None, :, None, :], s_loc, -jnp.inf)
        s_loc = s_loc.reshape(b, H, GRID_W, kr * GRID_W)
        s_ctx = jnp.einsum('bqhd,bkhd->bhqk', qr, k_ctx).astype(jnp.float32) * NA_SCALE
        p = jax.nn.softmax(jnp.concatenate([s_loc, s_ctx], axis=-1), axis=-1).astype(v.dtype)
        p_loc = p[..., :kr * GRID_W].reshape(b, H, GRID_W, kr, GRID_W)
        return (jnp.einsum('bhqik,bikhd->bqhd', p_loc, vb)
                + jnp.einsum('bhqk,bkhd->bqhd', p[..., kr * GRID_W:], v_ctx))

    o = lax.map(row_block, jnp.arange(rows))
    return jnp.moveaxis(o, 0, 1).reshape(b, L, H * Dh)


def even_project(h, w_in):
    b, L, _ = h.shape
    p = h @ w_in
    heads = lambda t: t.reshape(b, L, NA_HEADS, NA_HEAD_DIM)
    return (p[..., :O_XBC], p[..., O_XBC:O_DT], p[..., O_DT:O_Q],
            heads(p[..., O_Q:O_K]), heads(p[..., O_K:O_V]), heads(p[..., O_V:]))


def even_context(h, w_in, conv_w, conv_b, a_log, dt_bias, d_skip, ssd_g, w_out):
    z, xbc, dt_raw, q, k, v = even_project(h, w_in)
    s0 = jnp.zeros((h.shape[0], 2, SSD_HEADS, SSD_HEAD_DIM, SSD_STATE), jnp.float32)
    y_ssd, st = ssd_mixer(z, xbc, dt_raw, conv_w, conv_b, a_log, dt_bias, d_skip, ssd_g, s0)
    o_na = ctx_attention(q, k, v)
    return jnp.concatenate([y_ssd, o_na.astype(y_ssd.dtype)], axis=-1) @ w_out, k, v, st


def even_latent(h, w_in, conv_w, conv_b, a_log, dt_bias, d_skip, ssd_g, rpb, w_out,
                k_ctx, v_ctx, s0):
    z, xbc, dt_raw, q, k, v = even_project(h, w_in)
    y_ssd, _ = ssd_mixer(z, xbc, dt_raw, conv_w, conv_b, a_log, dt_bias, d_skip, ssd_g, s0)
    o_na = latent_na(q, k, v, k_ctx.astype(k.dtype), v_ctx.astype(v.dtype), rpb)
    return jnp.concatenate([y_ssd, o_na.astype(y_ssd.dtype)], axis=-1) @ w_out


def s5_discretize(lam_re, lam_im, log_step):
    step = jnp.exp(log_step)[:, None]
    mag = jnp.exp(lam_re * step)
    a_re = mag * jnp.cos(lam_im * step)
    a_im = mag * jnp.sin(lam_im * step)
    den = lam_re * lam_re + lam_im * lam_im
    k_re = ((a_re - 1) * lam_re + a_im * lam_im) / den
    k_im = (a_im * lam_re - (a_re - 1) * lam_im) / den
    return a_re, a_im, k_re, k_im


def s5_scan(a_re, a_im, bu_re, bu_im, s0_re, s0_im):
    bu_re = bu_re.at[:, 0].add(a_re * s0_re - a_im * s0_im)
    bu_im = bu_im.at[:, 0].add(a_re * s0_im + a_im * s0_re)
    ar = jnp.broadcast_to(a_re, bu_re.shape)
    ai = jnp.broadcast_to(a_im, bu_im.shape)

    def combine(e1, e2):
        a1r, a1i, b1r, b1i = e1
        a2r, a2i, b2r, b2i = e2
        return (a1r * a2r - a1i * a2i, a1r * a2i + a1i * a2r,
                a2r * b1r - a2i * b1i + b2r, a2r * b1i + a2i * b1r + b2i)

    _, _, xr, xi = lax.associative_scan(combine, (ar, ai, bu_re, bu_im), axis=1)
    return xr, xi


def s5_mixer(u, lam_re, lam_im, log_step, b_re, b_im, c_re, c_im, d_skip, glu_w, glu_b, s0):
    f32 = jnp.float32
    b, L, _ = u.shape
    uf = u.astype(f32)
    ug = uf.reshape(b, L, S5_GROUPS, S5_GROUP_CH)
    br, bi, cr, ci = (t.astype(f32) for t in (b_re, b_im, c_re, c_im))
    s0 = s0.astype(f32)
    y = uf * d_skip.astype(f32)
    finals = []
    for d in range(2):
        a_re, a_im, k_re, k_im = s5_discretize(
            lam_re[d].astype(f32), lam_im[d].astype(f32), log_step[d].astype(f32))
        bb_re = k_re[..., None] * br - k_im[..., None] * bi
        bb_im = k_re[..., None] * bi + k_im[..., None] * br
        ud = ug if d == 0 else jnp.flip(ug, axis=1)
        bu_re = jnp.einsum('blgc,gpc->blgp', ud, bb_re)
        bu_im = jnp.einsum('blgc,gpc->blgp', ud, bb_im)
        xr, xi = s5_scan(a_re, a_im, bu_re, bu_im, s0[:, d, ..., 0], s0[:, d, ..., 1])
        finals.append(jnp.stack([xr[:, -1], xi[:, -1]], axis=-1))
        if d == 1:
            xr, xi = jnp.flip(xr, axis=1), jnp.flip(xi, axis=1)
        y = y + (jnp.einsum('gcp,blgp->blgc', cr, xr)
                 - jnp.einsum('gcp,blgp->blgc', ci, xi)).reshape(b, L, S5_WIDTH)
    g = jax.nn.gelu(y)
    out = g * jax.nn.sigmoid(g @ glu_w.astype(f32) + glu_b.astype(f32))
    return out.astype(u.dtype), jnp.stack(finals, axis=1)


def fnet_mixer(u):
    b, L, _ = u.shape
    ug = u.astype(jnp.float32).reshape(b, L, FNET_GROUPS, FNET_GROUP_CH)
    f = jnp.fft.fftn(ug, axes=(1, 3), norm='ortho').real
    return f.reshape(b, L, FNET_WIDTH).astype(u.dtype)


def odd_mixer(h, w_in, lam_re, lam_im, log_step, b_re, b_im, c_re, c_im, d_skip, glu_w,
              glu_b, w_out, s0):
    p = h @ w_in
    y_s5, st = s5_mixer(p[..., :S5_WIDTH], lam_re, lam_im, log_step, b_re, b_im, c_re,
                        c_im, d_skip, glu_w, glu_b, s0)
    y_f = fnet_mixer(p[..., S5_WIDTH:])
    return jnp.concatenate([y_s5, y_f], axis=-1) @ w_out, st


def setup_inputs(seed: int = 0) -> dict:
    key = jax.random.key(seed)
    ks = iter(jax.random.split(key, 64))
    f32 = jnp.float32
    nrm = lambda shape, s: jax.random.normal(next(ks), shape, f32) * s
    D = D_MODEL
    F = FFN_HIDDEN
    E = N_EVEN
    O = N_ODD
    dt0 = jnp.exp(jax.random.uniform(next(ks), (E, 2, SSD_HEADS), f32,
                                     minval=math.log(1e-3), maxval=math.log(1e-1)))
    dt_bias = dt0 + jnp.log(-jnp.expm1(-dt0))
    a_log = jnp.log(jax.random.uniform(next(ks), (E, 2, SSD_HEADS), f32, minval=1.0, maxval=16.0))
    n = jnp.arange(S5_STATE, dtype=f32)
    lam_re = -0.5 + nrm((O, 2, S5_GROUPS, S5_STATE), 0.01)
    lam_im = math.pi * n + nrm((O, 2, S5_GROUPS, S5_STATE), 0.01)
    log_step = jax.random.uniform(next(ks), (O, 2, S5_GROUPS), f32,
                                  minval=math.log(1e-3), maxval=math.log(1e-1))
    return {
        'x_prompt': nrm((BATCH, SEQ, D), 1.0),
        'x_sample': nrm((DEC_BATCH, DEC_SEQ, D), 1.0),
        'cache_na_k': nrm((DEC_BATCH, E, PAST_LEN, NA_HEADS, NA_HEAD_DIM), 1.0),
        'cache_na_v': nrm((DEC_BATCH, E, PAST_LEN, NA_HEADS, NA_HEAD_DIM), 1.0),
        'state_ssd': nrm((DEC_BATCH, E, 2, SSD_HEADS, SSD_HEAD_DIM, SSD_STATE), 0.5),
        'state_s5': nrm((DEC_BATCH, O, 2, S5_GROUPS, S5_STATE, 2), 0.5),
        'c': nrm((DEC_BATCH, D), 1.0),
        'c_ctx': nrm((D,), 1.0),
        'mod_w': nrm((DEPTH, D, 6 * D), 0.5 * D ** -0.5),
        'mod_b': nrm((DEPTH, 6 * D), 0.02),
        'norm1_g': 1.0 + nrm((DEPTH, D), 0.02),
        'norm2_g': 1.0 + nrm((DEPTH, D), 0.02),
        'ffn_w1': nrm((DEPTH, D, F), D ** -0.5),
        'ffn_w3': nrm((DEPTH, D, F), D ** -0.5),
        'ffn_w2': nrm((DEPTH, F, D), F ** -0.5),
        'final_g': 1.0 + nrm((D,), 0.02),
        'ev_w_in': nrm((E, D, EVEN_IN), D ** -0.5),
        'ev_conv_w': nrm((E, CONV_W, SSD_XBC), CONV_W ** -0.5),
        'ev_conv_b': nrm((E, SSD_XBC), 0.02),
        'ev_a_log': a_log,
        'ev_dt_bias': dt_bias,
        'ev_d_skip': 1.0 + nrm((E, SSD_HEADS), 0.1),
        'ev_ssd_norm_g': 1.0 + nrm((E, SSD_WIDTH), 0.02),
        'ev_rpb': nrm((E, NA_HEADS, 2 * NA_ROWS - 1, 2 * NA_COLS - 1), 0.1),
        'ev_w_out': nrm((E, EVEN_MIX, D), EVEN_MIX ** -0.5),
        'od_w_in': nrm((O, D, ODD_IN), D ** -0.5),
        'od_lam_re': lam_re,
        'od_lam_im': lam_im,
        'od_log_step': log_step,
        'od_b_re': nrm((O, S5_GROUPS, S5_STATE, S5_GROUP_CH), (2 * S5_GROUP_CH) ** -0.5),
        'od_b_im': nrm((O, S5_GROUPS, S5_STATE, S5_GROUP_CH), (2 * S5_GROUP_CH) ** -0.5),
        'od_c_re': nrm((O, S5_GROUPS, S5_GROUP_CH, S5_STATE), S5_STATE ** -0.5),
        'od_c_im': nrm((O, S5_GROUPS, S5_GROUP_CH, S5_STATE), S5_STATE ** -0.5),
        'od_d_skip': nrm((O, S5_WIDTH), 0.5),
        'od_glu_w': nrm((O, S5_WIDTH, S5_WIDTH), S5_WIDTH ** -0.5),
        'od_glu_b': nrm((O, S5_WIDTH), 0.02),
        'od_w_out': nrm((O, ODD_IN, D), ODD_IN ** -0.5),
    }


def reference(x_prompt, x_sample, cache_na_k, cache_na_v, state_ssd, state_s5, c, c_ctx,
              mod_w, mod_b, norm1_g, norm2_g, ffn_w1, ffn_w3, ffn_w2, final_g,
              ev_w_in, ev_conv_w, ev_conv_b, ev_a_log, ev_dt_bias, ev_d_skip, ev_ssd_norm_g,
              ev_rpb, ev_w_out, od_w_in, od_lam_re, od_lam_im, od_log_step, od_b_re, od_b_im,
              od_c_re, od_c_im, od_d_skip, od_glu_w, od_glu_b, od_w_out):
    xc = x_prompt
    xl = x_sample
    new_k, new_v, new_ssd, new_s5 = [], [], [], []
    for i in range(DEPTH):
        j = i // 2
        mc = adaln(c_ctx[None], mod_w[i], mod_b[i])
        ml = adaln(c, mod_w[i], mod_b[i])
        hc = modulate(rmsnorm(xc, norm1_g[i]), mc[0], mc[1])
        hl = modulate(rmsnorm(xl, norm1_g[i]), ml[0], ml[1])
        if i % 2 == 0:
            oc, kc, vc, sc = even_context(
                hc, ev_w_in[j], ev_conv_w[j], ev_conv_b[j], ev_a_log[j], ev_dt_bias[j],
                ev_d_skip[j], ev_ssd_norm_g[j], ev_w_out[j])
            ol = even_latent(
                hl, ev_w_in[j], ev_conv_w[j], ev_conv_b[j], ev_a_log[j], ev_dt_bias[j],
                ev_d_skip[j], ev_ssd_norm_g[j], ev_rpb[j], ev_w_out[j],
                cache_na_k[:, j], cache_na_v[:, j], state_ssd[:, j])
            new_k.append(kc)
            new_v.append(vc)
            new_ssd.append(sc)
        else:
            zero = jnp.zeros((xc.shape[0], 2, S5_GROUPS, S5_STATE, 2), jnp.float32)
            oc, sc = odd_mixer(
                hc, od_w_in[j], od_lam_re[j], od_lam_im[j], od_log_step[j], od_b_re[j],
                od_b_im[j], od_c_re[j], od_c_im[j], od_d_skip[j], od_glu_w[j], od_glu_b[j],
                od_w_out[j], zero)
            ol, _ = odd_mixer(
                hl, od_w_in[j], od_lam_re[j], od_lam_im[j], od_log_step[j], od_b_re[j],
                od_b_im[j], od_c_re[j], od_c_im[j], od_d_skip[j], od_glu_w[j], od_glu_b[j],
                od_w_out[j], state_s5[:, j])
            new_s5.append(sc)
        xc = xc + mc[2][:, None] * oc.astype(xc.dtype)
        xl = xl + ml[2][:, None] * ol.astype(xl.dtype)
        hc = modulate(rmsnorm(xc, norm2_g[i]), mc[3], mc[4])
        hl = modulate(rmsnorm(xl, norm2_g[i]), ml[3], ml[4])
        xc = xc + mc[5][:, None] * swiglu(hc, ffn_w1[i], ffn_w3[i], ffn_w2[i])
        xl = xl + ml[5][:, None] * swiglu(hl, ffn_w1[i], ffn_w3[i], ffn_w2[i])
    y_prompt = rmsnorm(xc, final_g)
    y_sample = rmsnorm(xl, final_g)
    new_cache_na_k = jnp.stack(new_k, axis=1)
    new_cache_na_v = jnp.stack(new_v, axis=1)
    new_state_ssd = jnp.stack(new_ssd, axis=1)
    new_state_s5 = jnp.stack(new_s5, axis=1)
    return (y_prompt, y_sample, new_cache_na_k, new_cache_na_v, new_state_ssd, new_state_s5)
```

```cpp
#include <hip/hip_runtime.h>
#include <hip/hip_cooperative_groups.h>
#include <cstdio>
#include <cstdint>
namespace cg = cooperative_groups;

#ifndef MK_MODE
#define MK_MODE 1
#endif

#define LAS __attribute__((address_space(3)))
typedef unsigned short bf16;
typedef short bf16x8 __attribute__((ext_vector_type(8)));
typedef float f32x4 __attribute__((ext_vector_type(4)));
typedef unsigned u32x4 __attribute__((ext_vector_type(4)));
typedef unsigned u32x2 __attribute__((ext_vector_type(2)));

constexpr int D = 1024, TC = 8192, TL = 16384, T = 24576, FF = 2816;
constexpr int PLD = 2816;
constexpr int PZ = 0, PQ = 512, PX = 1024, PK = 1792, PV = 2304;
constexpr int NPH = 20;
constexpr int LDS_BYTES = 147456;
constexpr int SLOT_OFF = LDS_BYTES - 64;
constexpr size_t MiB = 1u << 20;
constexpr size_t WS_CTL = 0, CTL_BYTES = 32768, WS_BAR = 4096;
constexpr size_t WS_MODV = 64 * 1024;
constexpr size_t WS_DT = 1 * MiB;
constexpr size_t WS_WEVIN = 2 * MiB;
constexpr size_t WS_WEVOUT = 8 * MiB;
constexpr size_t WS_WODIN = 10 * MiB;
constexpr size_t WS_WODOUT = 13 * MiB;
constexpr size_t WS_WGLU = 15 * MiB;
constexpr size_t WS_DFTC = 15 * MiB + 512 * 1024;
constexpr size_t WS_WFUP = 16 * MiB;
constexpr size_t WS_WFDN = 27 * MiB;
constexpr size_t WS_WBS = 33 * MiB;
constexpr size_t WS_WWY = 37 * MiB;
constexpr size_t WS_DFTL = 45 * MiB;
constexpr size_t WS_R1 = 62 * MiB;
constexpr size_t WS_R2 = 110 * MiB;
constexpr size_t WS_END = 242 * MiB;
constexpr size_t R2_A2 = 0, R2_ZTL = 48 * MiB, R2_ZTC = 80 * MiB, R2_G5 = 96 * MiB;
constexpr size_t O_K = 25165824, O_V = 29360128, O_SSD = 33554432, O_S5 = 35651584;

struct Args { const float* in[37]; float* out; unsigned char* ws; int ph_lo, ph_hi; };

__device__ __forceinline__ unsigned f2bf(float f) { unsigned u = __builtin_bit_cast(unsigned, f); return (u + 0x7fffu + ((u >> 16) & 1u)) >> 16; }
__device__ __forceinline__ unsigned pk2(float lo, float hi) { return f2bf(lo) | (f2bf(hi) << 16); }
__device__ __forceinline__ float bflo(unsigned u) { return __builtin_bit_cast(float, u << 16); }
__device__ __forceinline__ float bfhi(unsigned u) { return __builtin_bit_cast(float, u & 0xffff0000u); }
__device__ __forceinline__ unsigned cvt_pk_bf16(float lo, float hi) { unsigned r; asm volatile("v_cvt_pk_bf16_f32 %0, %1, %2" : "=v"(r) : "v"(lo), "v"(hi)); return r; }
__device__ __forceinline__ u32x4 pack8(f32x4 a, f32x4 b) { u32x4 w; w.x = cvt_pk_bf16(a[0], a[1]); w.y = cvt_pk_bf16(a[2], a[3]); w.z = cvt_pk_bf16(b[0], b[1]); w.w = cvt_pk_bf16(b[2], b[3]); return w; }
__device__ __forceinline__ float silu_f(float x) { return x / (1.f + __expf(-x)); }
__device__ __forceinline__ float sigmoid_f(float x) { return 1.f / (1.f + __expf(-x)); }
__device__ __forceinline__ float gelu_tanh(float x) { const float u = 0.7978845608028654f * (x + 0.044715f * x * x * x); const float t = 1.f - 2.f / (__expf(2.f * u) + 1.f); return 0.5f * x * (1.f + t); }
__device__ __forceinline__ float wave_sum(float v) {
#pragma unroll
    for (int o = 1; o < 64; o <<= 1) v += __shfl_xor(v, o);
    return v;
}
__device__ __forceinline__ int mod_row(int row) { return row < TC ? 0 : 1 + ((row - TC) >> 11); }
#define LDS_WAIT() asm volatile("s_waitcnt lgkmcnt(0)" ::: "memory")
__device__ __forceinline__ f32x4 mma16(bf16x8 a, bf16x8 b, f32x4 c) { return __builtin_amdgcn_mfma_f32_16x16x32_bf16(a, b, c, 0, 0, 0); }
__device__ __forceinline__ bf16x8 ldfrag(const bf16* base, int stride, int lane, int ks) { return *(const bf16x8*)(base + (lane & 15) * stride + ks * 32 + (lane >> 4) * 8); }

namespace pg8 {
constexpr int BM = 256, BK = 64, HALF = 128, HTB = HALF * BK * 2, NXCD = 8, WGM = 8;
__host__ __device__ __forceinline__ int lds_byte(int r, int c) { const int st = (r >> 4) * 2 + (c >> 5), rr = r & 15, cc = c & 31, ob = rr * 64 + cc * 2; return st * 1024 + (ob ^ (((ob >> 9) & 1) << 5)); }
__host__ __device__ __forceinline__ void stage_rc(int b, int& R, int& C) { const int st = b / 1024, sb = b % 1024, swz = sb ^ (((sb >> 9) & 1) << 5); R = (st >> 1) * 16 + swz / 64; C = (st & 1) * 32 + (swz % 64) / 2; }
__host__ __device__ __forceinline__ int perm32(int rho) { const int n = rho >> 4, i = rho & 15; return 8 * (i >> 2) + 4 * n + (i & 3); }
struct Unit { int pm, pn; };
struct Gemm { const bf16* A; const bf16* Bt; int K, lda, ldb; };
struct StaticOrder {
    int nM, nN, nwg, G, c;
    __device__ void init(int M, int N, int G_, int c_) { nM = M / BM; nN = N / BM; nwg = nM * nN; G = G_; c = c_; }
    __device__ bool next(int i, Unit& u) const {
        const long L = (long)i * G + c; if (L >= nwg) return false;
        int wgid = (int)L; { const int q = nwg / NXCD, r = nwg % NXCD, xcd = wgid % NXCD, off = wgid / NXCD; wgid = (xcd < r ? xcd * (q + 1) : r * (q + 1) + (xcd - r) * q) + off; }
        const int nig = WGM * nN, gid = wgid / nig, fm = gid * WGM, gsz = (nM - fm) < WGM ? (nM - fm) : WGM;
        u.pm = fm + ((wgid % nig) % gsz); u.pn = (wgid % nig) / gsz; return true;
    }
};
struct SchedS5 {
    int G, c, nunits;
    __device__ bool next(int i, Unit& u) const { const long L = (long)i * G + c; if (L >= nunits) return false; u.pm = (int)L; u.pn = (int)L / 6; return true; }
};
template <class F> struct Epi8 {
    static constexpr bool PERM = true;
    F f;
    __device__ __forceinline__ void operator()(const f32x4 (&acc)[2][2][4][2], const Unit& u, int wr, int wc, int fr, int fq) const {
#pragma unroll
        for (int ai = 0; ai < 2; ++ai)
#pragma unroll
            for (int m = 0; m < 4; ++m) { const int row = u.pm * BM + ai * HALF + wr * 64 + m * 16 + fr;
#pragma unroll
                for (int bj = 0; bj < 2; ++bj) { const int col0 = u.pn * BM + bj * HALF + wc * 32 + 8 * fq; f(row, col0, acc[ai][bj][m][0], acc[ai][bj][m][1]); } }
    }
};

template <class Epi, class Sched>
__device__ __forceinline__ void gemm_phase(LAS unsigned char* lds, const Gemm g, const Sched& S, const Epi& E) {
    const int tid = threadIdx.x, wid = __builtin_amdgcn_readfirstlane(tid >> 6), lane = tid & 63, wr = wid >> 2, wc = wid & 3, fr = lane & 15, fq = lane >> 4;
    const int K = g.K, nt = K / BK;
    unsigned voffA[2], voffB[2];
#pragma unroll
    for (int i = 0; i < 2; ++i) { int R, C; stage_rc(tid * 16 + i * 8192, R, C); const int Rb = (R & ~31) + perm32(R & 31);
        voffA[i] = (unsigned)(R * g.lda + C) * 2u; voffB[i] = (unsigned)(Rb * g.ldb + C) * 2u; }
    const size_t kstep = (size_t)(BK * 2);
    const size_t hstepA = (size_t)HALF * g.lda * 2, hstepB = (size_t)HALF * g.ldb * 2;
    const size_t tstepA = 2 * hstepA, tstepB = 2 * hstepB;
    const unsigned ldsw = (unsigned)wid * 1024u;
    const int aoff = lds_byte(wr * 64 + fr, fq * 8), boff = lds_byte(wc * 32 + fr, fq * 8);
#define PG8_SA(b, h) (((b) * 2 + (h)) * HTB)
#define PG8_SB(b, h) ((4 + (b) * 2 + (h)) * HTB)
#define PG8_STAGE(bufoff, gbase, voff) do { _Pragma("unroll") for (int _i = 0; _i < 2; ++_i) \
        __builtin_amdgcn_global_load_lds((const unsigned*)((const char*)(gbase) + (voff)[_i]), (LAS unsigned*)(lds + (bufoff) + ldsw + _i * 8192), 16, 0, 0); } while (0)
#define PG8_LDA(dst, b, h) do { _Pragma("unroll") for (int m = 0; m < 4; ++m) _Pragma("unroll") for (int k = 0; k < 2; ++k) dst[m][k] = *(const LAS bf16x8*)(lds + PG8_SA(b, h) + aoff + m * 2048 + k * 1024); } while (0)
#define PG8_LDB(dst, b, h) do { _Pragma("unroll") for (int n = 0; n < 2; ++n) _Pragma("unroll") for (int k = 0; k < 2; ++k) dst[n][k] = *(const LAS bf16x8*)(lds + PG8_SB(b, h) + boff + n * 2048 + k * 1024); } while (0)
#define PG8_MMA(ai, bj, At, Bt) do { __builtin_amdgcn_s_setprio(1); _Pragma("unroll") for (int m = 0; m < 4; ++m) _Pragma("unroll") for (int n = 0; n < 2; ++n) _Pragma("unroll") for (int k = 0; k < 2; ++k) \
        acc[ai][bj][m][n] = __builtin_amdgcn_mfma_f32_16x16x32_bf16(Bt[n][k], At[m][k], acc[ai][bj][m][n], 0, 0, 0); __builtin_amdgcn_s_setprio(0); } while (0)
#define PG8_WAIT_V(n) asm volatile("s_waitcnt vmcnt(" #n ")" ::: "memory")
#define PG8_WAIT_L(n) asm volatile("s_waitcnt lgkmcnt(" #n ")" ::: "memory")
#define PG8_BAR __builtin_amdgcn_s_barrier()
#define PG8_SCHED __builtin_amdgcn_sched_barrier(0)
    Unit cur, nxt; int ui = 0;
    if (!S.next(0, cur)) return;
    f32x4 acc[2][2][4][2];
#pragma unroll
    for (int a = 0; a < 2; ++a)
#pragma unroll
        for (int b = 0; b < 2; ++b)
#pragma unroll
            for (int m = 0; m < 4; ++m)
#pragma unroll
                for (int n = 0; n < 2; ++n) acc[a][b][m][n] = (f32x4){0.f, 0.f, 0.f, 0.f};
    bf16x8 At[4][2], B0[2][2], B1[2][2];
    const char* cA = (const char*)g.A + (size_t)cur.pm * tstepA; const char* cB = (const char*)g.Bt + (size_t)cur.pn * tstepB;
    PG8_STAGE(PG8_SB(0, 0), cB, voffB); PG8_STAGE(PG8_SB(0, 1), cB + hstepB, voffB); PG8_STAGE(PG8_SA(0, 0), cA, voffA); PG8_STAGE(PG8_SA(0, 1), cA + hstepA, voffA);
    if (wr == 1) PG8_BAR;
    PG8_WAIT_V(2); PG8_BAR;
    PG8_STAGE(PG8_SB(1, 0), cB + kstep, voffB); PG8_STAGE(PG8_SA(1, 0), cA + kstep, voffA); PG8_STAGE(PG8_SB(1, 1), cB + hstepB + kstep, voffB);
    PG8_WAIT_V(6); PG8_BAR;
    for (;;) {
        const bool has_next = S.next(ui + 1, nxt);
        const char* nA = has_next ? (const char*)g.A + (size_t)nxt.pm * tstepA : cA; const char* nB = has_next ? (const char*)g.Bt + (size_t)nxt.pn * tstepB : cB;
        for (int t = 0; t < nt; t += 2) {
            const bool last = (t == nt - 2);
            const char* a1 = cA + (size_t)(t + 1) * kstep;
            const char* a2 = last ? nA : cA + (size_t)(t + 2) * kstep; const char* b2 = last ? nB : cB + (size_t)(t + 2) * kstep;
            const char* a3 = a2 + kstep; const char* b3 = b2 + kstep;
            PG8_LDB(B0, 0, 0); PG8_LDB(B1, 0, 1); PG8_SCHED; PG8_LDA(At, 0, 0); PG8_STAGE(PG8_SA(1, 1), a1 + hstepA, voffA);
            PG8_WAIT_V(8); PG8_WAIT_L(0); PG8_BAR; PG8_MMA(0, 0, At, B0); PG8_MMA(0, 1, At, B1); PG8_BAR; PG8_SCHED;
            PG8_LDA(At, 0, 1); PG8_STAGE(PG8_SB(0, 0), b2, voffB); PG8_STAGE(PG8_SB(0, 1), b2 + hstepB, voffB); PG8_STAGE(PG8_SA(0, 0), a2, voffA);
            PG8_WAIT_V(8); PG8_WAIT_L(0); PG8_BAR; PG8_MMA(1, 0, At, B0); PG8_MMA(1, 1, At, B1); PG8_BAR; PG8_SCHED;
            PG8_LDB(B0, 1, 0); PG8_LDB(B1, 1, 1); PG8_SCHED; PG8_LDA(At, 1, 0); PG8_STAGE(PG8_SA(0, 1), a2 + hstepA, voffA);
            PG8_WAIT_V(8); PG8_WAIT_L(0); PG8_BAR; PG8_MMA(0, 0, At, B0); PG8_MMA(0, 1, At, B1); PG8_BAR; PG8_SCHED;
            PG8_LDA(At, 1, 1); PG8_STAGE(PG8_SB(1, 0), b3, voffB); PG8_STAGE(PG8_SB(1, 1), b3 + hstepB, voffB); PG8_STAGE(PG8_SA(1, 0), a3, voffA);
            PG8_WAIT_V(8); PG8_WAIT_L(0); PG8_BAR; PG8_MMA(1, 0, At, B0); PG8_MMA(1, 1, At, B1); PG8_BAR; PG8_SCHED;
        }
        if (wr == 0) PG8_BAR;
        E(acc, cur, wr, wc, fr, fq);
        if (!has_next) break;
#pragma unroll
        for (int a = 0; a < 2; ++a)
#pragma unroll
            for (int b = 0; b < 2; ++b)
#pragma unroll
                for (int m = 0; m < 4; ++m)
#pragma unroll
                    for (int n = 0; n < 2; ++n) acc[a][b][m][n] = (f32x4){0.f, 0.f, 0.f, 0.f};
        cur = nxt; cA = nA; cB = nB; ++ui;
        if (wr == 1) PG8_BAR;
    }
    PG8_WAIT_V(0);
    PG8_BAR;
#undef PG8_SA
#undef PG8_SB
#undef PG8_STAGE
#undef PG8_LDA
#undef PG8_LDB
#undef PG8_MMA
#undef PG8_WAIT_V
#undef PG8_WAIT_L
#undef PG8_BAR
#undef PG8_SCHED
}
}

struct EInProj0 { bf16* PROJ; float* DT; float* outk; float* outv;
    __device__ __forceinline__ void operator()(int row, int col, f32x4 v0, f32x4 v1) const {
        if (col < 2816) {
            if (col >= PQ && col < PX) { v0 = v0 * 0.125f; v1 = v1 * 0.125f; }
            *(u32x4*)(PROJ + (size_t)row * PLD + col) = pack8(v0, v1);
            if (row < TC && col >= PK) { float* o = (col < PV) ? outk + (size_t)row * 512 + (col - PK) : outv + (size_t)row * 512 + (col - PV); *(f32x4*)o = v0; *(f32x4*)(o + 4) = v1; }
        } else if (col == 2816) { float* o = DT + (size_t)row * 8; *(f32x4*)o = v0; *(f32x4*)(o + 4) = v1; }
    } };
struct EResid { const float* xp; const float* xs; float* XR; const float* gate; int first;
    __device__ __forceinline__ void operator()(int row, int col, f32x4 v0, f32x4 v1) const {
        const float* g = gate + mod_row(row) * 6144 + col;
        const float* b = first ? (row < TC ? xp + (size_t)row * D : xs + (size_t)(row - TC) * D) + col : XR + (size_t)row * D + col;
        const f32x4 g0 = *(const f32x4*)g, g1 = *(const f32x4*)(g + 4), b0 = *(const f32x4*)b, b1 = *(const f32x4*)(b + 4);
        float* o = XR + (size_t)row * D + col; *(f32x4*)o = b0 + g0 * v0; *(f32x4*)(o + 4) = b1 + g1 * v1;
    } };
struct ESwiglu { bf16* G;
    __device__ __forceinline__ void operator()(int row, int col, f32x4 v0, f32x4 v1) const {
        u32x2 w; w.x = cvt_pk_bf16(silu_f(v0[0]) * v1[0], silu_f(v0[1]) * v1[1]); w.y = cvt_pk_bf16(silu_f(v0[2]) * v1[2], silu_f(v0[3]) * v1[3]);
        *(u32x2*)(G + (size_t)row * FF + (col >> 1)) = w;
    } };
struct EInProj1 { bf16* A2; bf16* ZTL; bf16* ZTC;
    __device__ __forceinline__ void operator()(int row, int col, f32x4 v0, f32x4 v1) const {
        if (col < 512) { const int g = col >> 4, cc = col & 15, ch = row >> 4, j = row & 15;
            *(u32x4*)(A2 + ((size_t)(g * 1536 + ch)) * 512 + j * 16 + cc) = pack8(v0, v1);
        } else { const int cs = (col - 512) >> 9, n = (col - 512) & 511; bf16* p; size_t st;
            if (row < TC) { const int b = row >> 8, l = row & 255; p = ZTC + ((size_t)(b * 512 + n)) * 512 + cs * 256 + l; st = 512; }
            else { const int r2 = row - TC, b = r2 >> 11, l = r2 & 2047; p = ZTL + ((size_t)(b * 512 + n)) * 4096 + cs * 2048 + l; st = 4096; }
#pragma unroll
            for (int e = 0; e < 4; ++e) { p[(size_t)e * st] = (bf16)f2bf(v0[e]); p[(size_t)(e + 4) * st] = (bf16)f2bf(v1[e]); }
        }
    } };
struct ESloc { float* S;
    __device__ __forceinline__ void operator()(int row, int col, f32x4 v0, f32x4 v1) const { float* o = S + (size_t)row * 256 + (col & 255); *(f32x4*)o = v0; *(f32x4*)(o + 4) = v1; } };
struct EY { bf16* G5;
    __device__ __forceinline__ void operator()(int row, int col, f32x4 v0, f32x4 v1) const {
        const int g = row / 1536, ch = row - g * 1536, c2 = col & 255, i = c2 >> 4, cc = c2 & 15;
        f32x4 a, b;
#pragma unroll
        for (int e = 0; e < 4; ++e) { a[e] = gelu_tanh(v0[e]); b[e] = gelu_tanh(v1[e]); }
        *(u32x4*)(G5 + (size_t)(ch * 16 + i) * 512 + g * 16 + cc) = pack8(a, b);
    } };
struct EGlu { const bf16* G5; const float* bias; bf16* MIX2;
    __device__ __forceinline__ void operator()(int row, int col, f32x4 v0, f32x4 v1) const {
        const u32x4 gr = *(const u32x4*)(G5 + (size_t)row * 512 + col); const f32x4 b0 = *(const f32x4*)(bias + col), b1 = *(const f32x4*)(bias + col + 4);
        f32x4 a, b;
        a[0] = bflo(gr.x) * sigmoid_f(v0[0] + b0[0]); a[1] = bfhi(gr.x) * sigmoid_f(v0[1] + b0[1]); a[2] = bflo(gr.y) * sigmoid_f(v0[2] + b0[2]); a[3] = bfhi(gr.y) * sigmoid_f(v0[3] + b0[3]);
        b[0] = bflo(gr.z) * sigmoid_f(v1[0] + b1[0]); b[1] = bfhi(gr.z) * sigmoid_f(v1[1] + b1[1]); b[2] = bflo(gr.w) * sigmoid_f(v1[2] + b1[2]); b[3] = bfhi(gr.w) * sigmoid_f(v1[3] + b1[3]);
        *(u32x4*)(MIX2 + (size_t)row * D + col) = pack8(a, b);
    } };
struct EFnetL { bf16* MIX2;
    __device__ __forceinline__ void operator()(int row, int col, f32x4 v0, f32x4 v1) const { const int b = col >> 9, n = col & 511; *(u32x4*)(MIX2 + (size_t)(TC + b * 2048 + row) * D + 512 + n) = pack8(v0, v1); } };
struct EFnetC { bf16* MIX2;
    __device__ __forceinline__ void operator()(int row, int col, f32x4 v0, f32x4 v1) const { const int b = col >> 9, n = col & 511; *(u32x4*)(MIX2 + (size_t)(b * 256 + row) * D + 512 + n) = pack8(v0, v1); } };

__device__ __forceinline__ int evin_dst(int n) {
    if (n < 512) return n;
    if (n < 1280) return n - 512 + PX;
    if (n < 1288) return n - 1280 + 2816;
    if (n < 1800) return n - 1288 + PQ;
    if (n < 2312) return n - 1800 + PK;
    return n - 2312 + PV;
}
template <int MODE> __device__ __forceinline__ int dst_row(int n) {
    if (MODE == 0) return n;
    if (MODE == 1) return evin_dst(n);
    if (MODE == 2) return 8 * (n >> 2) + (n & 3);
    return 8 * (n >> 2) + 4 + (n & 3);
}
template <int MODE> __device__ __forceinline__ void transpose_item(const float* W, int K, int N, int ldw, bf16* WT, float* scr, int item, int lane) {
    const int nblk = (N + 31) >> 5, kb = item / nblk, nb = item - kb * nblk, k0 = 64 * kb, n0 = 32 * nb;
    const int nn = n0 + (lane & 31); const bool ok = nn < N;
#pragma unroll 8
    for (int i = 0; i < 32; ++i) { const int kk = 2 * i + (lane >> 5); scr[kk * 33 + (lane & 31)] = ok ? W[(size_t)(k0 + kk) * ldw + nn] : 0.f; }
    LDS_WAIT(); asm volatile("" ::: "memory");
    const int c = lane & 7;
#pragma unroll
    for (int j = 0; j < 4; ++j) { const int n = (lane >> 3) + 8 * j;
        if (n0 + n < N) { const float* s = scr + (8 * c) * 33 + n;
            u32x4 o; o.x = pk2(s[0 * 33], s[1 * 33]); o.y = pk2(s[2 * 33], s[3 * 33]); o.z = pk2(s[4 * 33], s[5 * 33]); o.w = pk2(s[6 * 33], s[7 * 33]);
            *(u32x4*)(WT + (size_t)dst_row<MODE>(n0 + n) * K + k0 + 8 * c) = o; } }
    LDS_WAIT(); asm volatile("" ::: "memory");
}
template <int MODE> __device__ __forceinline__ void transpose_all(const float* W, int K, int N, int ldw, bf16* WT, float* scr, int gw, int NGW, int lane) {
    const int nitems = (K >> 6) * ((N + 31) >> 5);
    for (int it = gw; it < nitems; it += NGW) transpose_item<MODE>(W, K, N, ldw, WT, scr, it, lane);
}
__device__ __forceinline__ void fold_item(const float* W, bf16* WT, float* scr, int item, int lane) {
    const int g = item >> 4, k0 = (item & 15) * 64;
    for (int i = 0; i < 64; ++i) scr[i * 65 + lane] = W[(size_t)(k0 + i) * 1024 + 512 + g * 64 + lane];
    scr[64 * 65 + lane] = cospif(lane * (1.f / 32.f)) * 0.125f; scr[64 * 65 + 64 + lane] = sinpif(lane * (1.f / 32.f)) * 0.125f;
    LDS_WAIT(); asm volatile("" ::: "memory");
    for (int half = 0; half < 2; ++half) {
        float ac[32], as[32];
#pragma unroll
        for (int kk = 0; kk < 32; ++kk) { ac[kk] = 0.f; as[kk] = 0.f; }
        for (int c = 0; c < 64; ++c) { const int idx = (c * lane) & 63; const float ct = scr[64 * 65 + idx], st = scr[64 * 65 + 64 + idx];
#pragma unroll
            for (int kk = 0; kk < 32; ++kk) { const float w = scr[(half * 32 + kk) * 65 + c]; ac[kk] += w * ct; as[kk] += w * st; } }
        bf16* oc = WT + (size_t)(512 + g * 64 + lane) * 1024 + k0 + half * 32; bf16* os = WT + (size_t)(1024 + g * 64 + lane) * 1024 + k0 + half * 32;
#pragma unroll
        for (int q = 0; q < 4; ++q) {
            u32x4 a, b; a.x = pk2(ac[8 * q], ac[8 * q + 1]); a.y = pk2(ac[8 * q + 2], ac[8 * q + 3]); a.z = pk2(ac[8 * q + 4], ac[8 * q + 5]); a.w = pk2(ac[8 * q + 6], ac[8 * q + 7]);
            b.x = pk2(as[8 * q], as[8 * q + 1]); b.y = pk2(as[8 * q + 2], as[8 * q + 3]); b.z = pk2(as[8 * q + 4], as[8 * q + 5]); b.w = pk2(as[8 * q + 6], as[8 * q + 7]);
            *(u32x4*)(oc + 8 * q) = a; *(u32x4*)(os + 8 * q) = b; }
    }
    LDS_WAIT(); asm volatile("" ::: "memory");
}
__device__ __forceinline__ void cpow(float lre, float lim, float step, float e, float& re, float& im) {
    const float mag = __expf(e * lre * step); float tr = e * (lim * step * 0.15915494309189535f); tr -= floorf(tr);
    re = mag * cospif(2.f * tr); im = mag * sinpif(2.f * tr);
}
__device__ __forceinline__ void s5_k(float lre, float lim, float step, float& kr, float& ki) {
    const float zr = lre * step, zi = lim * step;
    if (zr * zr + zi * zi < 0.01f) {
        float pr = 1.f, pi = 0.f, sr = 1.f, si = 0.f; const float inv[4] = {0.5f, 1.f / 6.f, 1.f / 24.f, 1.f / 120.f};
#pragma unroll
        for (int q = 0; q < 4; ++q) { const float nr = pr * zr - pi * zi, ni = pr * zi + pi * zr; pr = nr; pi = ni; sr += pr * inv[q]; si += pi * inv[q]; }
        kr = step * sr; ki = step * si;
    } else { float ar, ai; cpow(lre, lim, step, 1.f, ar, ai); ar -= 1.f; const float den = lre * lre + lim * lim; kr = (ar * lre + ai * lim) / den; ki = (ai * lre - ar * lim) / den; }
}

__device__ __forceinline__ void prologue(const Args& A, unsigned char* lds) {
    const int tid = threadIdx.x, lane = tid & 63, wave = tid >> 6, G = gridDim.x;
    const int gw = blockIdx.x * 8 + wave, NGW = G * 8;
    const int gt = blockIdx.x * 512 + tid, NGT = G * 512;
    unsigned char* ws = A.ws;
    float* scr = (float*)(lds + wave * 17408);
    if (blockIdx.x < 192) {
        float* sc = (float*)lds;
        float* red = (float*)(lds + 36864);
        for (int i = tid; i < 9 * 1024; i += 512) { const int r = i >> 10, k = i & 1023; const float v = r == 0 ? A.in[7][k] : A.in[6][(r - 1) * 1024 + k]; sc[i] = silu_f(v); }
        __syncthreads();
        for (int item = blockIdx.x; item < 192; item += G) {
            const int layer = item / 96, n0 = (item % 96) * 64;
            const float* W = A.in[8] + (size_t)layer * 1024 * 6144 + n0 + lane;
            float acc[9];
#pragma unroll
            for (int r = 0; r < 9; ++r) acc[r] = 0.f;
            for (int k = wave * 128; k < wave * 128 + 128; k += 8) {
                float wv[8];
#pragma unroll
                for (int u = 0; u < 8; ++u) wv[u] = W[(size_t)(k + u) * 6144];
#pragma unroll
                for (int u = 0; u < 8; ++u)
#pragma unroll
                    for (int r = 0; r < 9; ++r) acc[r] += sc[r * 1024 + k + u] * wv[u];
            }
#pragma unroll
            for (int r = 0; r < 9; ++r) red[(wave * 9 + r) * 64 + lane] = acc[r];
            __syncthreads();
            for (int i = tid; i < 576; i += 512) { const int r = i >> 6, l = i & 63; float s = A.in[9][layer * 6144 + n0 + l];
#pragma unroll
                for (int w = 0; w < 8; ++w) s += red[(w * 9 + r) * 64 + l];
                ((float*)(ws + WS_MODV))[(layer * 9 + r) * 6144 + n0 + l] = s; }
            __syncthreads();
        }
    }
    __syncthreads();
    transpose_all<1>(A.in[16], 1024, 2824, 2824, (bf16*)(ws + WS_WEVIN), scr, gw, NGW, lane);
    transpose_all<0>(A.in[24], 1024, 1024, 1024, (bf16*)(ws + WS_WEVOUT), scr, gw, NGW, lane);
    transpose_all<0>(A.in[25], 1024, 512, 1024, (bf16*)(ws + WS_WODIN), scr, gw, NGW, lane);
    transpose_all<0>(A.in[36], 1024, 1024, 1024, (bf16*)(ws + WS_WODOUT), scr, gw, NGW, lane);
    transpose_all<0>(A.in[34], 512, 512, 512, (bf16*)(ws + WS_WGLU), scr, gw, NGW, lane);
    transpose_all<2>(A.in[12], 1024, 2816, 2816, (bf16*)(ws + WS_WFUP), scr, gw, NGW, lane);
    transpose_all<3>(A.in[13], 1024, 2816, 2816, (bf16*)(ws + WS_WFUP), scr, gw, NGW, lane);
    transpose_all<0>(A.in[14], 2816, 1024, 1024, (bf16*)(ws + WS_WFDN), scr, gw, NGW, lane);
    for (int it = gw; it < 128; it += NGW) fold_item(A.in[25], (bf16*)(ws + WS_WODIN), scr, it, lane);
    { u32x4* z = (u32x4*)(ws + WS_WEVIN + (size_t)2824 * 1024 * 2); const int n16 = 248 * 1024 * 2 / 16; for (int i = gt; i < n16; i += NGT) z[i] = (u32x4){0u, 0u, 0u, 0u}; }
    { bf16* DL = (bf16*)(ws + WS_DFTL); const float sc = 0.02209708691207961f;
      for (int i = gt; i < 2048 * 256; i += NGT) { const int k = i >> 8, l0 = (i & 255) * 8; float c[8], s[8];
#pragma unroll
        for (int e = 0; e < 8; ++e) { const int m = (k * (l0 + e)) & 2047; const float x = m * (1.f / 1024.f); c[e] = cospif(x) * sc; s[e] = -sinpif(x) * sc; }
        u32x4 a, b; a.x = pk2(c[0], c[1]); a.y = pk2(c[2], c[3]); a.z = pk2(c[4], c[5]); a.w = pk2(c[6], c[7]); b.x = pk2(s[0], s[1]); b.y = pk2(s[2], s[3]); b.z = pk2(s[4], s[5]); b.w = pk2(s[6], s[7]);
        *(u32x4*)(DL + (size_t)k * 4096 + l0) = a; *(u32x4*)(DL + (size_t)k * 4096 + 2048 + l0) = b; }
      bf16* DC = (bf16*)(ws + WS_DFTC); const float sc2 = 0.0625f;
      for (int i = gt; i < 256 * 32; i += NGT) { const int k = i >> 5, l0 = (i & 31) * 8; float c[8], s[8];
#pragma unroll
        for (int e = 0; e < 8; ++e) { const int m = (k * (l0 + e)) & 255; const float x = m * (1.f / 128.f); c[e] = cospif(x) * sc2; s[e] = -sinpif(x) * sc2; }
        u32x4 a, b; a.x = pk2(c[0], c[1]); a.y = pk2(c[2], c[3]); a.z = pk2(c[4], c[5]); a.w = pk2(c[6], c[7]); b.x = pk2(s[0], s[1]); b.y = pk2(s[2], s[3]); b.z = pk2(s[4], s[5]); b.w = pk2(s[6], s[7]);
        *(u32x4*)(DC + (size_t)k * 512 + l0) = a; *(u32x4*)(DC + (size_t)k * 512 + 256 + l0) = b; } }
    { const float* lamr = A.in[26]; const float* lami = A.in[27]; const float* lstep = A.in[28];
      const float* bre = A.in[29]; const float* bim = A.in[30]; const float* cre = A.in[31]; const float* cim = A.in[32]; const float* dsk = A.in[33];
      bf16* WY = (bf16*)(ws + WS_WWY); bf16* BS = (bf16*)(ws + WS_WBS);
      for (int i = gt; i < 32 * 16 * 256; i += NGT) {
          const int g = i >> 12, tau = (i >> 8) & 15, c = (i >> 4) & 15, cp = i & 15;
          float t0 = 0.f, t1 = 0.f;
          for (int d = 0; d < 2; ++d) { const float step = __expf(lstep[d * 32 + g]); float acc = 0.f;
              for (int p = 0; p < 64; ++p) { const float lre = lamr[(d * 32 + g) * 64 + p], lim = lami[(d * 32 + g) * 64 + p];
                  float kr, ki; s5_k(lre, lim, step, kr, ki); float pr, pi; cpow(lre, lim, step, (float)tau, pr, pi);
                  const float br = bre[(g * 64 + p) * 16 + cp], bi = bim[(g * 64 + p) * 16 + cp];
                  const float tbr = kr * br - ki * bi, tbi = kr * bi + ki * br;
                  const float qr = pr * tbr - pi * tbi, qi = pr * tbi + pi * tbr;
                  acc += cre[(g * 16 + c) * 64 + p] * qr - cim[(g * 16 + c) * 64 + p] * qi; }
              if (d == 0) t0 = acc; else t1 = acc; }
          bf16* base = WY + (size_t)g * 256 * 512;
          if (tau == 0) { const float v = t0 + t1 + (c == cp ? dsk[g * 16 + c] : 0.f); for (int ii = 0; ii < 16; ++ii) base[(size_t)(ii * 16 + c) * 512 + ii * 16 + cp] = (bf16)f2bf(v); }
          else { for (int ii = tau; ii < 16; ++ii) base[(size_t)(ii * 16 + c) * 512 + (ii - tau) * 16 + cp] = (bf16)f2bf(t0);
                 for (int ii = 0; ii < 16 - tau; ++ii) base[(size_t)(ii * 16 + c) * 512 + (ii + tau) * 16 + cp] = (bf16)f2bf(t1); }
      }
      for (int i = gt; i < 32 * 16 * 16 * 128; i += NGT) {
          const int p = i & 63, d = (i >> 6) & 1, c = (i >> 7) & 15, ii = (i >> 11) & 15, g = i >> 15;
          const float step = __expf(lstep[d * 32 + g]); const float lre = lamr[(d * 32 + g) * 64 + p], lim = lami[(d * 32 + g) * 64 + p];
          float pr, pi; cpow(lre, lim, step, d == 0 ? (float)(ii + 1) : (float)(16 - ii), pr, pi);
          const float cr = cre[(g * 16 + c) * 64 + p], ci = cim[(g * 16 + c) * 64 + p];
          const float vr = cr * pr - ci * pi, vi = cr * pi + ci * pr;
          bf16* rowp = WY + ((size_t)g * 256 + ii * 16 + c) * 512 + 256 + d * 128;
          rowp[p] = (bf16)f2bf(vr); rowp[64 + p] = (bf16)f2bf(-vi);
      }
      for (int i = gt; i < 32 * 2 * 64 * 256; i += NGT) {
          const int cp = i & 15, j = (i >> 4) & 15, p = (i >> 8) & 63, d = (i >> 14) & 1, g = i >> 15;
          const float step = __expf(lstep[d * 32 + g]); const float lre = lamr[(d * 32 + g) * 64 + p], lim = lami[(d * 32 + g) * 64 + p];
          float kr, ki; s5_k(lre, lim, step, kr, ki); float pr, pi; cpow(lre, lim, step, d == 0 ? (float)(15 - j) : (float)j, pr, pi);
          const float br = bre[(g * 64 + p) * 16 + cp], bi = bim[(g * 64 + p) * 16 + cp];
          const float tbr = kr * br - ki * bi, tbi = kr * bi + ki * br;
          bf16* o = BS + ((size_t)g * 256 + d * 128 + p) * 256 + j * 16 + cp;
          o[0] = (bf16)f2bf(pr * tbr - pi * tbi); o[(size_t)64 * 256] = (bf16)f2bf(pr * tbi + pi * tbr);
      }
    }
}

__device__ __forceinline__ void norm_phase(const float* xp, const float* xs, const float* XR, int first, const float* gam, const float* shift, const float* scale, bf16* H) {
    const int lane = threadIdx.x & 63, gw = blockIdx.x * 8 + (threadIdx.x >> 6), NGW = gridDim.x * 8;
    for (int row = gw; row < T; row += NGW) {
        const float* xr = first ? (row < TC ? xp + (size_t)row * D : xs + (size_t)(row - TC) * D) : XR + (size_t)row * D;
        f32x4 v[4]; float s = 0.f;
#pragma unroll
        for (int j = 0; j < 4; ++j) { v[j] = *(const f32x4*)(xr + 4 * lane + 256 * j); s += (v[j][0] * v[j][0] + v[j][1] * v[j][1]) + (v[j][2] * v[j][2] + v[j][3] * v[j][3]); }
        const float rstd = rsqrtf(wave_sum(s) * (1.f / D) + 1e-6f);
        const int mr = mod_row(row);
#pragma unroll
        for (int j = 0; j < 4; ++j) { const int c = 4 * lane + 256 * j; const f32x4 g = *(const f32x4*)(gam + c), sh = *(const f32x4*)(shift + mr * 6144 + c), sc = *(const f32x4*)(scale + mr * 6144 + c);
            const f32x4 y = v[j] * rstd * g * (sc + 1.f) + sh; u32x2 w; w.x = cvt_pk_bf16(y[0], y[1]); w.y = cvt_pk_bf16(y[2], y[3]); *(u32x2*)(H + (size_t)row * D + c) = w; }
    }
}
__device__ __forceinline__ void final_norm_phase(float* XR, const float* gam) {
    const int lane = threadIdx.x & 63, gw = blockIdx.x * 8 + (threadIdx.x >> 6), NGW = gridDim.x * 8;
    for (int row = gw; row < T; row += NGW) {
        float* xr = XR + (size_t)row * D; f32x4 v[4]; float s = 0.f;
#pragma unroll
        for (int j = 0; j < 4; ++j) { v[j] = *(const f32x4*)(xr + 4 * lane + 256 * j); s += (v[j][0] * v[j][0] + v[j][1] * v[j][1]) + (v[j][2] * v[j][2] + v[j][3] * v[j][3]); }
        const float rstd = rsqrtf(wave_sum(s) * (1.f / D) + 1e-6f);
#pragma unroll
        for (int j = 0; j < 4; ++j) { const int c = 4 * lane + 256 * j; const f32x4 g = *(const f32x4*)(gam + c); *(f32x4*)(xr + c) = v[j] * rstd * g; }
    }
}
__device__ __forceinline__ void gate_phase(const bf16* YD, bf16* PROJ, const float* gam) {
    const int lane = threadIdx.x & 63, gw = blockIdx.x * 8 + (threadIdx.x >> 6), NGW = gridDim.x * 8;
    for (int row = gw; row < T; row += NGW) {
        const u32x4 a = *(const u32x4*)(YD + (size_t)row * 512 + 8 * lane), b = *(const u32x4*)(YD + ((size_t)T + row) * 512 + 8 * lane), z = *(const u32x4*)(PROJ + (size_t)row * PLD + 8 * lane);
        float y[8];
        y[0] = (bflo(a.x) + bflo(b.x)) * silu_f(bflo(z.x)); y[1] = (bfhi(a.x) + bfhi(b.x)) * silu_f(bfhi(z.x));
        y[2] = (bflo(a.y) + bflo(b.y)) * silu_f(bflo(z.y)); y[3] = (bfhi(a.y) + bfhi(b.y)) * silu_f(bfhi(z.y));
        y[4] = (bflo(a.z) + bflo(b.z)) * silu_f(bflo(z.z)); y[5] = (bfhi(a.z) + bfhi(b.z)) * silu_f(bfhi(z.z));
        y[6] = (bflo(a.w) + bflo(b.w)) * silu_f(bflo(z.w)); y[7] = (bfhi(a.w) + bfhi(b.w)) * silu_f(bfhi(z.w));
        float s = 0.f;
#pragma unroll
        for (int e = 0; e < 8; ++e) s += y[e] * y[e];
        const float rstd = rsqrtf(wave_sum(s) * (1.f / 512.f) + 1e-6f);
        const f32x4 g0 = *(const f32x4*)(gam + 8 * lane), g1 = *(const f32x4*)(gam + 8 * lane + 4);
        u32x4 o; o.x = cvt_pk_bf16(y[0] * rstd * g0[0], y[1] * rstd * g0[1]); o.y = cvt_pk_bf16(y[2] * rstd * g0[2], y[3] * rstd * g0[3]);
        o.z = cvt_pk_bf16(y[4] * rstd * g1[0], y[5] * rstd * g1[1]); o.w = cvt_pk_bf16(y[6] * rstd * g1[2], y[7] * rstd * g1[3]);
        *(u32x4*)(PROJ + (size_t)row * PLD + 8 * lane) = o;
    }
}

__device__ __forceinline__ void ssd_item(const Args& A, unsigned char* lds, int item) {
    const int tid = threadIdx.x, lane = tid & 63, w = __builtin_amdgcn_readfirstlane(tid >> 6), fr = lane & 15, fq = lane >> 4;
    int seq, dir, h, L, tok0, nch; bool lat;
    if (item < 128) { lat = true; seq = item >> 4; dir = (item >> 3) & 1; h = item & 7; L = 2048; tok0 = TC + seq * 2048; nch = 16; }
    else { const int it = item - 128; lat = false; seq = it >> 4; dir = (it >> 3) & 1; h = it & 7; L = 256; tok0 = seq * 256; nch = 2; }
    const int g = h >> 2;
    bf16* Cm = (bf16*)lds; bf16* Bm = Cm + 128 * 72; bf16* XT = Bm + 128 * 72; bf16* BT = XT + 64 * 136; bf16* Mm = BT + 64 * 136; bf16* ST = Mm + 128 * 136;
    float* cum = (float*)(ST + 64 * 72); float* dtv = cum + 128; float* da = dtv + 128;
    const bf16* PROJ = (const bf16*)(A.ws + WS_R2); const float* DT = (const float*)(A.ws + WS_DT); bf16* YD = (bf16*)(A.ws + WS_R1);
    const float* convw = A.in[17]; const float* convb = A.in[18];
    const int pt = w >> 1, nt0 = 2 * (w & 1);
    f32x4 st[2];
#pragma unroll
    for (int q = 0; q < 2; ++q)
#pragma unroll
        for (int r = 0; r < 4; ++r) { const int p = 16 * pt + 4 * fq + r, n = 16 * (nt0 + q) + fr; st[q][r] = lat ? A.in[4][(size_t)((seq * 2 + dir) * 8 + h) * 4096 + p * 64 + n] : 0.f; }
    const float Aneg = -__expf(A.in[19][dir * 8 + h]); const float dtb = A.in[20][dir * 8 + h]; const float Dh = A.in[21][h];
    for (int c = 0; c < nch; ++c) {
        if (tid < 128) { const int j = tid; const int t = dir ? (L - 1 - (c * 128 + j)) : (c * 128 + j); const float x = DT[(size_t)(tok0 + t) * 8 + h] + dtb; const float dt = x > 20.f ? x : log1pf(__expf(x)); dtv[j] = dt; da[j] = dt * Aneg; }
#pragma unroll
        for (int q = 0; q < 2; ++q)
#pragma unroll
            for (int r = 0; r < 4; ++r) ST[(16 * pt + 4 * fq + r) * 72 + 16 * (nt0 + q) + fr] = (bf16)f2bf(st[q][r]);
        __syncthreads();
        if (tid < 128) { float s = 0.f; for (int j = 0; j <= tid; ++j) s += da[j]; cum[tid] = s; }
        __syncthreads();
        const float cl = cum[127];
        for (int idx = tid; idx < 3072; idx += 512) {
            const int j = idx / 24, cgp = idx - j * 24; const int t = dir ? (L - 1 - (c * 128 + j)) : (c * 128 + j);
            int ch; if (cgp < 8) ch = h * 64 + cgp * 8; else if (cgp < 16) ch = 512 + g * 64 + (cgp - 8) * 8; else ch = 640 + g * 64 + (cgp - 16) * 8;
            float acc[8];
            { const f32x4 b0 = *(const f32x4*)(convb + ch), b1 = *(const f32x4*)(convb + ch + 4); acc[0] = b0[0]; acc[1] = b0[1]; acc[2] = b0[2]; acc[3] = b0[3]; acc[4] = b1[0]; acc[5] = b1[1]; acc[6] = b1[2]; acc[7] = b1[3]; }
#pragma unroll
            for (int wv = 0; wv < 5; ++wv) { const int tt = t + wv - 2;
                if (tt >= 0 && tt < L) { const u32x4 raw = *(const u32x4*)(PROJ + (size_t)(tok0 + tt) * PLD + PX + ch);
                    const f32x4 w0 = *(const f32x4*)(convw + wv * 768 + ch), w1 = *(const f32x4*)(convw + wv * 768 + ch + 4);
                    acc[0] += w0[0] * bflo(raw.x); acc[1] += w0[1] * bfhi(raw.x); acc[2] += w0[2] * bflo(raw.y); acc[3] += w0[3] * bfhi(raw.y);
                    acc[4] += w1[0] * bflo(raw.z); acc[5] += w1[1] * bfhi(raw.z); acc[6] += w1[2] * bflo(raw.w); acc[7] += w1[3] * bfhi(raw.w); } }
#pragma unroll
            for (int e = 0; e < 8; ++e) acc[e] = silu_f(acc[e]);
            if (cgp < 8) { const float dt = dtv[j];
#pragma unroll
                for (int e = 0; e < 8; ++e) XT[(cgp * 8 + e) * 136 + j] = (bf16)f2bf(acc[e] * dt); }
            else if (cgp < 16) { const float te = __expf(cl - cum[j]); const int n0 = (cgp - 8) * 8;
                u32x4 o; o.x = pk2(acc[0], acc[1]); o.y = pk2(acc[2], acc[3]); o.z = pk2(acc[4], acc[5]); o.w = pk2(acc[6], acc[7]); *(u32x4*)(Bm + j * 72 + n0) = o;
#pragma unroll
                for (int e = 0; e < 8; ++e) BT[(n0 + e) * 136 + j] = (bf16)f2bf(acc[e] * te); }
            else { const int n0 = (cgp - 16) * 8; u32x4 o; o.x = pk2(acc[0], acc[1]); o.y = pk2(acc[2], acc[3]); o.z = pk2(acc[4], acc[5]); o.w = pk2(acc[6], acc[7]); *(u32x4*)(Cm + j * 72 + n0) = o; }
        }
        __syncthreads();
        {
            const bf16x8 af0 = ldfrag(Cm + 16 * w * 72, 72, lane, 0), af1 = ldfrag(Cm + 16 * w * 72, 72, lane, 1);
            for (int jt = 0; jt < 8; ++jt) { f32x4 acc = (f32x4){0.f, 0.f, 0.f, 0.f};
                acc = mma16(af0, ldfrag(Bm + 16 * jt * 72, 72, lane, 0), acc); acc = mma16(af1, ldfrag(Bm + 16 * jt * 72, 72, lane, 1), acc);
#pragma unroll
                for (int r = 0; r < 4; ++r) { const int i = 16 * w + 4 * fq + r, j = 16 * jt + fr; float v = (j <= i) ? acc[r] * __expf(cum[i] - cum[j]) : 0.f; if (dir == 0 && i == j) v += Dh / dtv[i]; Mm[i * 136 + j] = (bf16)f2bf(v); } }
        }
        __syncthreads();
        {
            f32x4 yd[4], yo[4];
#pragma unroll
            for (int q = 0; q < 4; ++q) { yd[q] = (f32x4){0.f, 0.f, 0.f, 0.f}; yo[q] = (f32x4){0.f, 0.f, 0.f, 0.f}; }
#pragma unroll
            for (int ks = 0; ks < 4; ++ks) { if (32 * ks <= 16 * w + 15) { const bf16x8 am = ldfrag(Mm + 16 * w * 136, 136, lane, ks);
#pragma unroll
                for (int q = 0; q < 4; ++q) yd[q] = mma16(am, ldfrag(XT + 16 * q * 136, 136, lane, ks), yd[q]); } }
#pragma unroll
            for (int ks = 0; ks < 2; ++ks) { const bf16x8 ac = ldfrag(Cm + 16 * w * 72, 72, lane, ks);
#pragma unroll
                for (int q = 0; q < 4; ++q) yo[q] = mma16(ac, ldfrag(ST + 16 * q * 72, 72, lane, ks), yo[q]); }
#pragma unroll
            for (int r = 0; r < 4; ++r) { const int i = 16 * w + 4 * fq + r; const float ec = __expf(cum[i]); const int t = dir ? (L - 1 - (c * 128 + i)) : (c * 128 + i);
                bf16* yp = YD + ((size_t)dir * T + tok0 + t) * 512 + h * 64 + fr;
#pragma unroll
                for (int q = 0; q < 4; ++q) yp[16 * q] = (bf16)f2bf(yd[q][r] + ec * yo[q][r]); }
        }
        {
            const float cd = __expf(cl);
#pragma unroll
            for (int q = 0; q < 2; ++q) st[q] = st[q] * cd;
#pragma unroll
            for (int ks = 0; ks < 4; ++ks) { const bf16x8 ax = ldfrag(XT + 16 * pt * 136, 136, lane, ks);
#pragma unroll
                for (int q = 0; q < 2; ++q) st[q] = mma16(ax, ldfrag(BT + 16 * (nt0 + q) * 136, 136, lane, ks), st[q]); }
        }
        __syncthreads();
    }
    if (!lat) {
#pragma unroll
        for (int q = 0; q < 2; ++q)
#pragma unroll
            for (int r = 0; r < 4; ++r) { const int p = 16 * pt + 4 * fq + r, n = 16 * (nt0 + q) + fr; A.out[O_SSD + (size_t)((seq * 2 + dir) * 8 + h) * 4096 + p * 64 + n] = st[q][r]; }
    }
}

__device__ __forceinline__ void attn_pair(const Args& A, unsigned char* lds, int pairidx) {
    const int tid = threadIdx.x, half = __builtin_amdgcn_readfirstlane(tid >> 8), ht = tid & 255, lane = tid & 63, w = __builtin_amdgcn_readfirstlane((tid >> 6) & 3), fr = lane & 15, fq = lane >> 4;
    unsigned char* hl = lds + half * 32768;
    bf16* Ks = (bf16*)hl; bf16* Vt = Ks + 64 * 72; bf16* Ps = Vt + 64 * 72 + w * 16 * 72; float* rp = (float*)(hl + 27648);
    bf16* PROJ = (bf16*)(A.ws + WS_R2);
    const int item = pairidx * 2 + half;
    const bool lat = item < 2048;
    int b, h, r = 0, rs = 0, qtok0, ntiles;
    if (lat) { b = item >> 8; h = (item >> 5) & 7; r = item & 31; qtok0 = TC + b * 2048 + r * 64; rs = min(max(r - 4, 0), 24); ntiles = 12; }
    else { const int it = item - 2048; b = it >> 5; h = (it >> 2) & 7; const int qb = it & 3; qtok0 = b * 256 + qb * 64; ntiles = 4; }
    for (int i = ht; i < 465; i += 256) rp[i] = A.in[23][h * 465 + i];
    bf16x8 qf[2];
    { const bf16* qp = PROJ + (size_t)(qtok0 + 16 * w + fr) * PLD + PQ + h * 64 + fq * 8; qf[0] = *(const bf16x8*)qp; qf[1] = *(const bf16x8*)(qp + 32); }
    f32x4 o[4]; float m[4], l[4];
#pragma unroll
    for (int q = 0; q < 4; ++q) { o[q] = (f32x4){0.f, 0.f, 0.f, 0.f}; m[q] = -1e30f; l[q] = 0.f; }
    for (int ti = 0; ti < ntiles; ++ti) {
        __syncthreads();
        for (int idx = ht; idx < 512; idx += 256) { const int key = idx >> 3, dc = idx & 7; u32x4 kv, vv;
            if (lat && ti >= 8) {
                const size_t off = (((size_t)b * 256 + (ti - 8) * 64 + key) * 8 + h) * 64 + dc * 8;
                const f32x4 k0 = *(const f32x4*)(A.in[2] + off), k1 = *(const f32x4*)(A.in[2] + off + 4), v0 = *(const f32x4*)(A.in[3] + off), v1 = *(const f32x4*)(A.in[3] + off + 4);
                kv.x = pk2(k0[0], k0[1]); kv.y = pk2(k0[2], k0[3]); kv.z = pk2(k1[0], k1[1]); kv.w = pk2(k1[2], k1[3]);
                vv.x = pk2(v0[0], v0[1]); vv.y = pk2(v0[2], v0[3]); vv.z = pk2(v1[0], v1[1]); vv.w = pk2(v1[2], v1[3]);
            } else {
                const size_t tok = lat ? (size_t)(TC + b * 2048 + (rs + ti) * 64 + key) : (size_t)(b * 256 + ti * 64 + key);
                kv = *(const u32x4*)(PROJ + tok * PLD + PK + h * 64 + dc * 8); vv = *(const u32x4*)(PROJ + tok * PLD + PV + h * 64 + dc * 8);
            }
            *(u32x4*)(Ks + key * 72 + dc * 8) = kv;
            bf16* vt = Vt + (dc * 8) * 72 + key;
            vt[0] = (bf16)(vv.x & 0xffff); vt[72] = (bf16)(vv.x >> 16); vt[144] = (bf16)(vv.y & 0xffff); vt[216] = (bf16)(vv.y >> 16);
            vt[288] = (bf16)(vv.z & 0xffff); vt[360] = (bf16)(vv.z >> 16); vt[432] = (bf16)(vv.w & 0xffff); vt[504] = (bf16)(vv.w >> 16);
        }
        __syncthreads();
        f32x4 s[4];
#pragma unroll
        for (int t = 0; t < 4; ++t) { s[t] = (f32x4){0.f, 0.f, 0.f, 0.f};
#pragma unroll
            for (int ks = 0; ks < 2; ++ks) s[t] = mma16(qf[ks], ldfrag(Ks + 16 * t * 72, 72, lane, ks), s[t]); }
        if (lat && ti < 8) { const int dr = rs + ti - r + 7;
#pragma unroll
            for (int t = 0; t < 4; ++t)
#pragma unroll
                for (int rr = 0; rr < 4; ++rr) { const int qc = 16 * w + 4 * fq + rr, kc = 16 * t + fr; const int cs = min(max(qc - 8, 0), 48); const bool ok = (kc >= cs) && (kc < cs + 16);
                    const int bi = min(max(kc - qc + 15, 0), 30); s[t][rr] = ok ? s[t][rr] + rp[dr * 31 + bi] : -1e30f; } }
#pragma unroll
        for (int rr = 0; rr < 4; ++rr) {
            float mx = fmaxf(fmaxf(s[0][rr], s[1][rr]), fmaxf(s[2][rr], s[3][rr]));
            mx = fmaxf(mx, __shfl_xor(mx, 1)); mx = fmaxf(mx, __shfl_xor(mx, 2)); mx = fmaxf(mx, __shfl_xor(mx, 4)); mx = fmaxf(mx, __shfl_xor(mx, 8));
            const float mn = fmaxf(m[rr], mx); const float al = __expf(m[rr] - mn); m[rr] = mn; float sum = 0.f;
#pragma unroll
            for (int t = 0; t < 4; ++t) { const float p = __expf(s[t][rr] - mn); s[t][rr] = p; sum += p; }
            sum += __shfl_xor(sum, 1); sum += __shfl_xor(sum, 2); sum += __shfl_xor(sum, 4); sum += __shfl_xor(sum, 8);
            l[rr] = l[rr] * al + sum;
#pragma unroll
            for (int q = 0; q < 4; ++q) o[q][rr] *= al;
        }
#pragma unroll
        for (int t = 0; t < 4; ++t)
#pragma unroll
            for (int rr = 0; rr < 4; ++rr) Ps[(4 * fq + rr) * 72 + 16 * t + fr] = (bf16)f2bf(s[t][rr]);
        __syncthreads();
#pragma unroll
        for (int ks = 0; ks < 2; ++ks) { const bf16x8 pa = ldfrag(Ps, 72, lane, ks);
#pragma unroll
            for (int q = 0; q < 4; ++q) o[q] = mma16(pa, ldfrag(Vt + 16 * q * 72, 72, lane, ks), o[q]); }
    }
#pragma unroll
    for (int rr = 0; rr < 4; ++rr) { const float inv = 1.f / l[rr]; bf16* op = PROJ + (size_t)(qtok0 + 16 * w + 4 * fq + rr) * PLD + PQ + h * 64 + fr;
#pragma unroll
        for (int q = 0; q < 4; ++q) op[16 * q] = (bf16)f2bf(o[q][rr] * inv); }
}

__device__ __forceinline__ void s5_scan_phase(const Args& A) {
    const int gt = blockIdx.x * 512 + threadIdx.x, NGT = gridDim.x * 512;
    const float* Sloc = (const float*)(A.ws + WS_R1); bf16* A2 = (bf16*)(A.ws + WS_R2 + R2_A2);
    for (int idx = gt; idx < 163840; idx += NGT) {
        const bool lat = idx < 32768; const int i2 = lat ? idx : idx - 32768;
        const int b = i2 >> 12, rem = i2 & 4095, g = rem >> 7, d = (rem >> 6) & 1, p = rem & 63;
        const int nch = lat ? 128 : 16, chunk0 = lat ? 512 + b * 128 : b * 16, rowbase = g * 1536 + chunk0;
        const float step = __expf(A.in[28][d * 32 + g]); const float lre = A.in[26][(d * 32 + g) * 64 + p], lim = A.in[27][(d * 32 + g) * 64 + p];
        float ar, ai; cpow(lre, lim, step, 16.f, ar, ai);
        float sr = 0.f, si = 0.f;
        if (lat) { const float* s0 = A.in[5] + ((size_t)((b * 2 + d) * 32 + g) * 64 + p) * 2; sr = s0[0]; si = s0[1]; }
        for (int n0 = 0; n0 < nch; n0 += 16) {
            float xr[16], xi[16];
#pragma unroll
            for (int u = 0; u < 16; ++u) { const int n = d == 0 ? n0 + u : nch - 1 - (n0 + u); const float* sp = Sloc + (size_t)(rowbase + n) * 256 + d * 128 + p; xr[u] = sp[0]; xi[u] = sp[64]; }
#pragma unroll
            for (int u = 0; u < 16; ++u) { const int n = d == 0 ? n0 + u : nch - 1 - (n0 + u); bf16* ap = A2 + (size_t)(rowbase + n) * 512 + 256 + d * 128 + p;
                ap[0] = (bf16)f2bf(sr); ap[64] = (bf16)f2bf(si);
                const float nr = ar * sr - ai * si + xr[u], ni = ar * si + ai * sr + xi[u]; sr = nr; si = ni; }
        }
        if (!lat) { float* o = A.out + O_S5 + ((size_t)((b * 2 + d) * 32 + g) * 64 + p) * 2; o[0] = sr; o[1] = si; }
    }
}


#define XB_TMO      128
#define XB_XCNT(j)  (256  + 64 * (j))
#define XB_XSUB(j)  (1280 + 64 * (j))
#define XB_XGEN(j)  (2304 + 64 * (j))
#define XB_TOP      3328
#define XB_TOPGEN   3392
#define XB_SPIN_CAP (1u << 22)
__device__ __forceinline__ unsigned xb_ld(unsigned* p)              { return __hip_atomic_load(p, __ATOMIC_RELAXED, __HIP_MEMORY_SCOPE_AGENT); }
__device__ __forceinline__ unsigned xb_add(unsigned* p, unsigned v) { return __hip_atomic_fetch_add(p, v, __ATOMIC_RELAXED, __HIP_MEMORY_SCOPE_AGENT); }
__device__ __forceinline__ unsigned xb_xcc_id() { return (unsigned)__builtin_amdgcn_s_getreg((3 << 11) | 20) & 0xFu; }
#define XB_SPIN(cond, bar) do { unsigned _sp = 0; while (cond) { __builtin_amdgcn_s_sleep(1); \
    if ((++_sp & 255u) == 0u) { if (xb_ld(&(bar)[XB_TMO])) break; if (_sp > XB_SPIN_CAP) { atomicAdd(&(bar)[XB_TMO], 1u); break; } } } } while (0)
struct XcdBarrier { unsigned* bar; unsigned x; volatile unsigned* st; };
__device__ __forceinline__ XcdBarrier xcd_barrier_post(unsigned* bar, volatile unsigned* st) {
    XcdBarrier b; b.bar = bar; b.x = xb_xcc_id(); b.st = st;
    if (threadIdx.x == 0) (void)xb_add(&bar[XB_XCNT(b.x)], 1u);
    return b;
}
__device__ __forceinline__ void xcd_barrier_complete(unsigned* bar, unsigned x, unsigned& nloc, unsigned& nx) {
    const unsigned G = gridDim.x;
    unsigned sum, cnt, mine, sp = 0u;
    for (;;) {
        sum = 0u; cnt = 0u; mine = 0u;
#pragma unroll
        for (unsigned j = 0; j < 16; ++j) { const unsigned c = xb_ld(&bar[XB_XCNT(j)]); sum += c; cnt += (c > 0u) ? 1u : 0u; mine = (j == x) ? c : mine; }
        if (sum == G) break;
        __builtin_amdgcn_s_sleep(1);
        if ((++sp & 255u) == 0u) { if (xb_ld(&bar[XB_TMO])) break; if (sp > XB_SPIN_CAP) { atomicAdd(&bar[XB_TMO], 1u); break; } }
    }
    nloc = mine > 0u ? mine : 1u; nx = cnt > 0u ? cnt : 1u;
}
__device__ __forceinline__ void xcd_barrier(const XcdBarrier& b) {
    asm volatile("s_waitcnt vmcnt(0)" ::: "memory");
    __syncthreads();
    if (threadIdx.x == 0) {
        unsigned* bar = b.bar;
        __builtin_amdgcn_s_waitcnt(0);
        unsigned nloc = b.st[0], nx = b.st[1];
        if (nloc == 0u) { xcd_barrier_complete(bar, b.x, nloc, nx); b.st[0] = nloc; b.st[1] = nx; }
        const unsigned old = xb_add(&bar[XB_XSUB(b.x)], 1u);
        const unsigned gen = old / nloc;
        if (old + 1u == (gen + 1u) * nloc) {
            __builtin_amdgcn_fence(__ATOMIC_RELEASE, "agent");
            asm volatile("s_waitcnt vmcnt(0)" ::: "memory");
            const unsigned og = xb_add(&bar[XB_TOP], 1u);
            const unsigned tg = og / nx;
            if (og + 1u == (tg + 1u) * nx) xb_add(&bar[XB_TOPGEN], 1u);
            else XB_SPIN(xb_ld(&bar[XB_TOPGEN]) == tg, bar);
            __builtin_amdgcn_fence(__ATOMIC_ACQUIRE, "agent");
            xb_add(&bar[XB_XGEN(b.x)], 1u);
            asm volatile("s_waitcnt vmcnt(0)" ::: "memory");
        } else {
            XB_SPIN(xb_ld(&bar[XB_XGEN(b.x)]) == gen, bar);
            __builtin_amdgcn_fence(__ATOMIC_ACQUIRE, "agent");
            asm volatile("s_waitcnt vmcnt(0)" ::: "memory");
        }
    }
    __syncthreads();
}

__global__ void __launch_bounds__(512, 2) mk_fwd(Args A) {
    extern __shared__ __attribute__((aligned(16))) unsigned char lds[];
    cg::grid_group grid = cg::this_grid();
    const int tid = threadIdx.x, G = gridDim.x, bx = blockIdx.x;
    unsigned char* ws = A.ws;
    LAS unsigned char* ldsl = (LAS unsigned char*)lds;
    const int lo = A.ph_lo, hi = A.ph_hi;
#define IN(k) (lo <= (k) && (k) < hi)
#define SEAM(k) do { if (IN(k) && IN((k) + 1)) { if ((k) == 0) grid.sync(); else xcd_barrier(xb); } } while (0)
    volatile unsigned* xst = (volatile unsigned*)(lds + SLOT_OFF + 16);
    if (tid == 0) { xst[0] = 0u; xst[1] = 0u; }
    __syncthreads();
    XcdBarrier xb; xb.bar = (unsigned*)(ws + WS_BAR); xb.x = 0; xb.st = xst;
    if (hi - lo > 1) xb = xcd_barrier_post((unsigned*)(ws + WS_BAR), xst);
    float* XR = A.out;
    const float* MODV = (const float*)(ws + WS_MODV);
    bf16* H = (bf16*)(ws + WS_R1); bf16* PROJ = (bf16*)(ws + WS_R2); bf16* Gb = (bf16*)(ws + WS_R2);
    bf16* MIX2 = (bf16*)(ws + WS_R1); bf16* A2 = (bf16*)(ws + WS_R2 + R2_A2); bf16* ZTL = (bf16*)(ws + WS_R2 + R2_ZTL); bf16* ZTC = (bf16*)(ws + WS_R2 + R2_ZTC); bf16* G5 = (bf16*)(ws + WS_R2 + R2_G5);

    if (IN(0)) { prologue(A, lds); } SEAM(0);
    if (IN(1)) { norm_phase(A.in[0], A.in[1], XR, 1, A.in[10], MODV, MODV + 1024, H); } SEAM(1);
    if (IN(2)) { pg8::Gemm g{H, (const bf16*)(ws + WS_WEVIN), 1024, 1024, 1024}; pg8::StaticOrder S; S.init(T, 3072, G, bx);
        pg8::Epi8<EInProj0> E{{PROJ, (float*)(ws + WS_DT), A.out + O_K, A.out + O_V}}; pg8::gemm_phase(ldsl, g, S, E); } SEAM(2);
    if (IN(3)) {
        unsigned* ctr = (unsigned*)(ws + WS_CTL); volatile int* slot = (volatile int*)(lds + SLOT_OFF);
        for (;;) { __syncthreads(); if (tid == 0) *slot = (int)atomicAdd(ctr, 1u); __syncthreads(); const int it = *slot;
            if (it >= 640 + 1536) break; if (it < 640) ssd_item(A, lds, it); else attn_pair(A, lds, it - 640); }
    } SEAM(3);
    if (IN(4)) { gate_phase((const bf16*)(ws + WS_R1), PROJ, A.in[22]); } SEAM(4);
    if (IN(5)) { pg8::Gemm g{PROJ, (const bf16*)(ws + WS_WEVOUT), 1024, PLD, 1024}; pg8::StaticOrder S; S.init(T, 1024, G, bx);
        pg8::Epi8<EResid> E{{A.in[0], A.in[1], XR, MODV + 2048, 1}}; pg8::gemm_phase(ldsl, g, S, E); } SEAM(5);
    if (IN(6)) { norm_phase(A.in[0], A.in[1], XR, 0, A.in[11], MODV + 3072, MODV + 4096, H); } SEAM(6);
    if (IN(7)) { pg8::Gemm g{H, (const bf16*)(ws + WS_WFUP), 1024, 1024, 1024}; pg8::StaticOrder S; S.init(T, 5632, G, bx);
        pg8::Epi8<ESwiglu> E{{Gb}}; pg8::gemm_phase(ldsl, g, S, E); } SEAM(7);
    if (IN(8)) { pg8::Gemm g{Gb, (const bf16*)(ws + WS_WFDN), 2816, 2816, 2816}; pg8::StaticOrder S; S.init(T, 1024, G, bx);
        pg8::Epi8<EResid> E{{A.in[0], A.in[1], XR, MODV + 5120, 0}}; pg8::gemm_phase(ldsl, g, S, E); } SEAM(8);
    const float* MODV1 = MODV + 9 * 6144;
    if (IN(9)) { norm_phase(A.in[0], A.in[1], XR, 0, A.in[10] + 1024, MODV1, MODV1 + 1024, H);
        __syncthreads();
        float* scr = (float*)(lds + (tid >> 6) * 17408); const int gw = bx * 8 + (tid >> 6), NGW = G * 8, lane = tid & 63;
        transpose_all<2>(A.in[12] + (size_t)1024 * 2816, 1024, 2816, 2816, (bf16*)(ws + WS_WFUP), scr, gw, NGW, lane);
        transpose_all<3>(A.in[13] + (size_t)1024 * 2816, 1024, 2816, 2816, (bf16*)(ws + WS_WFUP), scr, gw, NGW, lane);
        transpose_all<0>(A.in[14] + (size_t)2816 * 1024, 2816, 1024, 1024, (bf16*)(ws + WS_WFDN), scr, gw, NGW, lane);
        __syncthreads(); } SEAM(9);
    if (IN(10)) { pg8::Gemm g{H, (const bf16*)(ws + WS_WODIN), 1024, 1024, 1024}; pg8::StaticOrder S; S.init(T, 1536, G, bx);
        pg8::Epi8<EInProj1> E{{A2, ZTL, ZTC}}; pg8::gemm_phase(ldsl, g, S, E); } SEAM(10);
    if (IN(11)) { pg8::Gemm g{A2, (const bf16*)(ws + WS_WBS), 256, 512, 256}; pg8::SchedS5 S{G, bx, 192};
        pg8::Epi8<ESloc> E{{(float*)(ws + WS_R1)}}; pg8::gemm_phase(ldsl, g, S, E); } SEAM(11);
    if (IN(12)) { s5_scan_phase(A); } SEAM(12);
    if (IN(13)) {
        { pg8::Gemm g{(const bf16*)(ws + WS_DFTL), ZTL, 4096, 4096, 4096}; pg8::StaticOrder S; S.init(2048, 4096, 128, bx < 128 ? bx : (1 << 30));
          pg8::Epi8<EFnetL> E{{MIX2}}; pg8::gemm_phase(ldsl, g, S, E); }
        { pg8::Gemm g{A2, (const bf16*)(ws + WS_WWY), 512, 512, 512}; pg8::SchedS5 S{128, bx >= 128 ? bx - 128 : (1 << 30), 192};
          pg8::Epi8<EY> E{{G5}}; pg8::gemm_phase(ldsl, g, S, E); }
        { pg8::Gemm g{(const bf16*)(ws + WS_DFTC), ZTC, 512, 512, 512}; pg8::StaticOrder S; S.init(256, 16384, 64, bx >= 192 ? bx - 192 : (1 << 30));
          pg8::Epi8<EFnetC> E{{MIX2}}; pg8::gemm_phase(ldsl, g, S, E); }
    } SEAM(13);
    if (IN(14)) { pg8::Gemm g{G5, (const bf16*)(ws + WS_WGLU), 512, 512, 512}; pg8::StaticOrder S; S.init(T, 512, G, bx);
        pg8::Epi8<EGlu> E{{G5, A.in[35], MIX2}}; pg8::gemm_phase(ldsl, g, S, E); } SEAM(14);
    if (IN(15)) { pg8::Gemm g{MIX2, (const bf16*)(ws + WS_WODOUT), 1024, 1024, 1024}; pg8::StaticOrder S; S.init(T, 1024, G, bx);
        pg8::Epi8<EResid> E{{A.in[0], A.in[1], XR, MODV1 + 2048, 0}}; pg8::gemm_phase(ldsl, g, S, E); } SEAM(15);
    if (IN(16)) { norm_phase(A.in[0], A.in[1], XR, 0, A.in[11] + 1024, MODV1 + 3072, MODV1 + 4096, H); } SEAM(16);
    if (IN(17)) { pg8::Gemm g{H, (const bf16*)(ws + WS_WFUP), 1024, 1024, 1024}; pg8::StaticOrder S; S.init(T, 5632, G, bx);
        pg8::Epi8<ESwiglu> E{{Gb}}; pg8::gemm_phase(ldsl, g, S, E); } SEAM(17);
    if (IN(18)) { pg8::Gemm g{Gb, (const bf16*)(ws + WS_WFDN), 2816, 2816, 2816}; pg8::StaticOrder S; S.init(T, 1024, G, bx);
        pg8::Epi8<EResid> E{{A.in[0], A.in[1], XR, MODV1 + 5120, 0}}; pg8::gemm_phase(ldsl, g, S, E); } SEAM(18);
    if (IN(19)) { final_norm_phase(XR, A.in[15]); }
#undef IN
#undef SEAM
}

extern "C" void kernel_launch(void* const* d_in, const int* in_sizes, int n_in, void* d_out, int out_size, void* d_ws, size_t ws_size, hipStream_t stream) {
    static int grid = 0;
    if (grid == 0) {
        if (n_in != 37 || ws_size < WS_END) { fprintf(stderr, "kernel_launch: unexpected n_in %d / ws %zu\n", n_in, ws_size); grid = -1; return; }
        int dev = 0, cus = 0, per_cu = 0;
        hipGetDevice(&dev); hipDeviceGetAttribute(&cus, hipDeviceAttributeMultiprocessorCount, dev);
        if (hipFuncSetAttribute((const void*)mk_fwd, hipFuncAttributeMaxDynamicSharedMemorySize, LDS_BYTES) != hipSuccess) { fprintf(stderr, "kernel_launch: hipFuncSetAttribute failed\n"); grid = -1; return; }
        hipOccupancyMaxActiveBlocksPerMultiprocessor(&per_cu, (const void*)mk_fwd, 512, LDS_BYTES);
        (void)hipGetLastError();
        if (per_cu < 1) per_cu = 1;
        grid = cus * 1;
        if (grid <= 0) grid = 256;
    }
    if (grid < 0) return;
    hipMemsetAsync((char*)d_ws + WS_CTL, 0, CTL_BYTES, stream);
    Args a{};
    for (int i = 0; i < 37; ++i) a.in[i] = (const float*)d_in[i];
    a.out = (float*)d_out; a.ws = (unsigned char*)d_ws;
#if MK_MODE == 1
    for (int ph = 0; ph < NPH; ++ph) { a.ph_lo = ph; a.ph_hi = ph + 1; hipLaunchKernelGGL(mk_fwd, dim3(grid), dim3(512), LDS_BYTES, stream, a); }
#else
    a.ph_lo = 0; a.ph_hi = NPH;
    void* params[] = {&a};
    hipError_t e = hipLaunchCooperativeKernel((const void*)mk_fwd, dim3(grid), dim3(512), params, LDS_BYTES, stream);
    if (e != hipSuccess) fprintf(stderr, "cooperative launch failed: %s (grid %d)\n", hipGetErrorString(e), grid);
#endif
}
```

```cpp
#include <hip/hip_runtime.h>
#include <hip/hip_cooperative_groups.h>
#include <cstdio>
#include <cstdint>
namespace cg = cooperative_groups;

#ifndef MK_MODE
#define MK_MODE 0
#endif

#define LAS __attribute__((address_space(3)))
typedef unsigned short bf16;
typedef short bf16x8 __attribute__((ext_vector_type(8)));
typedef float f32x4 __attribute__((ext_vector_type(4)));
typedef unsigned u32x4 __attribute__((ext_vector_type(4)));
typedef unsigned u32x2 __attribute__((ext_vector_type(2)));

constexpr int D = 1024, TC = 8192, TL = 16384, T = 24576, FF = 2816;
constexpr int PLD = 2816;
constexpr int PZ = 0, PQ = 512, PX = 1024, PK = 1792, PV = 2304;
constexpr int NPH = 20;
constexpr int LDS_BYTES = 147456;
constexpr int SLOT_OFF = LDS_BYTES - 64;
constexpr size_t MiB = 1u << 20;
constexpr size_t WS_CTL = 0, CTL_BYTES = 32768, WS_BAR = 4096;
constexpr size_t WS_MODV = 64 * 1024;
constexpr size_t WS_DT = 1 * MiB;
constexpr size_t WS_WEVIN = 2 * MiB;
constexpr size_t WS_WEVOUT = 8 * MiB;
constexpr size_t WS_WODIN = 10 * MiB;
constexpr size_t WS_WODOUT = 13 * MiB;
constexpr size_t WS_WGLU = 15 * MiB;
constexpr size_t WS_DFTC = 15 * MiB + 512 * 1024;
constexpr size_t WS_WFUP = 16 * MiB;
constexpr size_t WS_WFDN = 27 * MiB;
constexpr size_t WS_WBS = 33 * MiB;
constexpr size_t WS_WWY = 37 * MiB;
constexpr size_t WS_DFTL = 45 * MiB;
constexpr size_t WS_R1 = 62 * MiB;
constexpr size_t WS_R2 = 110 * MiB;
constexpr size_t WS_END = 242 * MiB;
constexpr size_t R2_A2 = 0, R2_ZTL = 48 * MiB, R2_ZTC = 80 * MiB, R2_G5 = 96 * MiB;
constexpr size_t O_K = 25165824, O_V = 29360128, O_SSD = 33554432, O_S5 = 35651584;

struct Args { const float* in[37]; float* out; unsigned char* ws; int ph_lo, ph_hi; };

__device__ __forceinline__ unsigned f2bf(float f) { unsigned u = __builtin_bit_cast(unsigned, f); return (u + 0x7fffu + ((u >> 16) & 1u)) >> 16; }
__device__ __forceinline__ unsigned pk2(float lo, float hi) { return f2bf(lo) | (f2bf(hi) << 16); }
__device__ __forceinline__ float bflo(unsigned u) { return __builtin_bit_cast(float, u << 16); }
__device__ __forceinline__ float bfhi(unsigned u) { return __builtin_bit_cast(float, u & 0xffff0000u); }
__device__ __forceinline__ unsigned cvt_pk_bf16(float lo, float hi) { unsigned r; asm volatile("v_cvt_pk_bf16_f32 %0, %1, %2" : "=v"(r) : "v"(lo), "v"(hi)); return r; }
__device__ __forceinline__ u32x4 pack8(f32x4 a, f32x4 b) { u32x4 w; w.x = cvt_pk_bf16(a[0], a[1]); w.y = cvt_pk_bf16(a[2], a[3]); w.z = cvt_pk_bf16(b[0], b[1]); w.w = cvt_pk_bf16(b[2], b[3]); return w; }
__device__ __forceinline__ float silu_f(float x) { return x / (1.f + __expf(-x)); }
__device__ __forceinline__ float sigmoid_f(float x) { return 1.f / (1.f + __expf(-x)); }
__device__ __forceinline__ float gelu_tanh(float x) { const float u = 0.7978845608028654f * (x + 0.044715f * x * x * x); const float t = 1.f - 2.f / (__expf(2.f * u) + 1.f); return 0.5f * x * (1.f + t); }
__device__ __forceinline__ float wave_sum(float v) {
#pragma unroll
    for (int o = 1; o < 64; o <<= 1) v += __shfl_xor(v, o);
    return v;
}
__device__ __forceinline__ int mod_row(int row) { return row < TC ? 0 : 1 + ((row - TC) >> 11); }
#define LDS_WAIT() asm volatile("s_waitcnt lgkmcnt(0)" ::: "memory")
__device__ __forceinline__ f32x4 mma16(bf16x8 a, bf16x8 b, f32x4 c) { return __builtin_amdgcn_mfma_f32_16x16x32_bf16(a, b, c, 0, 0, 0); }
__device__ __forceinline__ bf16x8 ldfrag(const bf16* base, int stride, int lane, int ks) { return *(const bf16x8*)(base + (lane & 15) * stride + ks * 32 + (lane >> 4) * 8); }

namespace pg8 {
constexpr int BM = 256, BK = 64, HALF = 128, HTB = HALF * BK * 2, NXCD = 8, WGM = 8;
__host__ __device__ __forceinline__ int lds_byte(int r, int c) { const int st = (r >> 4) * 2 + (c >> 5), rr = r & 15, cc = c & 31, ob = rr * 64 + cc * 2; return st * 1024 + (ob ^ (((ob >> 9) & 1) << 5)); }
__host__ __device__ __forceinline__ void stage_rc(int b, int& R, int& C) { const int st = b / 1024, sb = b % 1024, swz = sb ^ (((sb >> 9) & 1) << 5); R = (st >> 1) * 16 + swz / 64; C = (st & 1) * 32 + (swz % 64) / 2; }
__host__ __device__ __forceinline__ int perm32(int rho) { const int n = rho >> 4, i = rho & 15; return 8 * (i >> 2) + 4 * n + (i & 3); }
struct Unit { int pm, pn; };
struct Gemm { const bf16* A; const bf16* Bt; int K, lda, ldb; };
struct StaticOrder {
    int nM, nN, nwg, G, c;
    __device__ void init(int M, int N, int G_, int c_) { nM = M / BM; nN = N / BM; nwg = nM * nN; G = G_; c = c_; }
    __device__ bool next(int i, Unit& u) const {
        const long L = (long)i * G + c; if (L >= nwg) return false;
        int wgid = (int)L; { const int q = nwg / NXCD, r = nwg % NXCD, xcd = wgid % NXCD, off = wgid / NXCD; wgid = (xcd < r ? xcd * (q + 1) : r * (q + 1) + (xcd - r) * q) + off; }
        const int nig = WGM * nN, gid = wgid / nig, fm = gid * WGM, gsz = (nM - fm) < WGM ? (nM - fm) : WGM;
        u.pm = fm + ((wgid % nig) % gsz); u.pn = (wgid % nig) / gsz; return true;
    }
};
struct SchedS5 {
    int G, c, nunits;
    __device__ bool next(int i, Unit& u) const { const long L = (long)i * G + c; if (L >= nunits) return false; u.pm = (int)L; u.pn = (int)L / 6; return true; }
};
template <class F> struct Epi8 {
    static constexpr bool PERM = true;
    F f;
    __device__ __forceinline__ void operator()(const f32x4 (&acc)[2][2][4][2], const Unit& u, int wr, int wc, int fr, int fq) const {
#pragma unroll
        for (int ai = 0; ai < 2; ++ai)
#pragma unroll
            for (int m = 0; m < 4; ++m) { const int row = u.pm * BM + ai * HALF + wr * 64 + m * 16 + fr;
#pragma unroll
                for (int bj = 0; bj < 2; ++bj) { const int col0 = u.pn * BM + bj * HALF + wc * 32 + 8 * fq; f(row, col0, acc[ai][bj][m][0], acc[ai][bj][m][1]); } }
    }
};

template <class Epi, class Sched>
__device__ __forceinline__ void gemm_phase(LAS unsigned char* lds, const Gemm g, const Sched& S, const Epi& E) {
    const int tid = threadIdx.x, wid = __builtin_amdgcn_readfirstlane(tid >> 6), lane = tid & 63, wr = wid >> 2, wc = wid & 3, fr = lane & 15, fq = lane >> 4;
    const int K = g.K, nt = K / BK;
    unsigned voffA[2], voffB[2];
#pragma unroll
    for (int i = 0; i < 2; ++i) { int R, C; stage_rc(tid * 16 + i * 8192, R, C); const int Rb = (R & ~31) + perm32(R & 31);
        voffA[i] = (unsigned)(R * g.lda + C) * 2u; voffB[i] = (unsigned)(Rb * g.ldb + C) * 2u; }
    const size_t kstep = (size_t)(BK * 2);
    const size_t hstepA = (size_t)HALF * g.lda * 2, hstepB = (size_t)HALF * g.ldb * 2;
    const size_t tstepA = 2 * hstepA, tstepB = 2 * hstepB;
    const unsigned ldsw = (unsigned)wid * 1024u;
    const int aoff = lds_byte(wr * 64 + fr, fq * 8), boff = lds_byte(wc * 32 + fr, fq * 8);
#define PG8_SA(b, h) (((b) * 2 + (h)) * HTB)
#define PG8_SB(b, h) ((4 + (b) * 2 + (h)) * HTB)
#define PG8_STAGE(bufoff, gbase, voff) do { _Pragma("unroll") for (int _i = 0; _i < 2; ++_i) \
        __builtin_amdgcn_global_load_lds((const unsigned*)((const char*)(gbase) + (voff)[_i]), (LAS unsigned*)(lds + (bufoff) + ldsw + _i * 8192), 16, 0, 0); } while (0)
#define PG8_LDA(dst, b, h) do { _Pragma("unroll") for (int m = 0; m < 4; ++m) _Pragma("unroll") for (int k = 0; k < 2; ++k) dst[m][k] = *(const LAS bf16x8*)(lds + PG8_SA(b, h) + aoff + m * 2048 + k * 1024); } while (0)
#define PG8_LDB(dst, b, h) do { _Pragma("unroll") for (int n = 0; n < 2; ++n) _Pragma("unroll") for (int k = 0; k < 2; ++k) dst[n][k] = *(const LAS bf16x8*)(lds + PG8_SB(b, h) + boff + n * 2048 + k * 1024); } while (0)
#define PG8_MMA(ai, bj, At, Bt) do { __builtin_amdgcn_s_setprio(1); _Pragma("unroll") for (int m = 0; m < 4; ++m) _Pragma("unroll") for (int n = 0; n < 2; ++n) _Pragma("unroll") for (int k = 0; k < 2; ++k) \
        acc[ai][bj][m][n] = __builtin_amdgcn_mfma_f32_16x16x32_bf16(Bt[n][k], At[m][k], acc[ai][bj][m][n], 0, 0, 0); __builtin_amdgcn_s_setprio(0); } while (0)
#define PG8_WAIT_V(n) asm volatile("s_waitcnt vmcnt(" #n ")" ::: "memory")
#define PG8_WAIT_L(n) asm volatile("s_waitcnt lgkmcnt(" #n ")" ::: "memory")
#define PG8_BAR __builtin_amdgcn_s_barrier()
#define PG8_SCHED __builtin_amdgcn_sched_barrier(0)
    Unit cur, nxt; int ui = 0;
    if (!S.next(0, cur)) return;
    f32x4 acc[2][2][4][2];
#pragma unroll
    for (int a = 0; a < 2; ++a)
#pragma unroll
        for (int b = 0; b < 2; ++b)
#pragma unroll
            for (int m = 0; m < 4; ++m)
#pragma unroll
                for (int n = 0; n < 2; ++n) acc[a][b][m][n] = (f32x4){0.f, 0.f, 0.f, 0.f};
    bf16x8 At[4][2], B0[2][2], B1[2][2];
    const char* cA = (const char*)g.A + (size_t)cur.pm * tstepA; const char* cB = (const char*)g.Bt + (size_t)cur.pn * tstepB;
    PG8_STAGE(PG8_SB(0, 0), cB, voffB); PG8_STAGE(PG8_SB(0, 1), cB + hstepB, voffB); PG8_STAGE(PG8_SA(0, 0), cA, voffA); PG8_STAGE(PG8_SA(0, 1), cA + hstepA, voffA);
    if (wr == 1) PG8_BAR;
    PG8_WAIT_V(2); PG8_BAR;
    PG8_STAGE(PG8_SB(1, 0), cB + kstep, voffB); PG8_STAGE(PG8_SA(1, 0), cA + kstep, voffA); PG8_STAGE(PG8_SB(1, 1), cB + hstepB + kstep, voffB);
    PG8_WAIT_V(6); PG8_BAR;
    for (;;) {
        const bool has_next = S.next(ui + 1, nxt);
        const char* nA = has_next ? (const char*)g.A + (size_t)nxt.pm * tstepA : cA; const char* nB = has_next ? (const char*)g.Bt + (size_t)nxt.pn * tstepB : cB;
        for (int t = 0; t < nt; t += 2) {
            const bool last = (t == nt - 2);
            const char* a1 = cA + (size_t)(t + 1) * kstep;
            const char* a2 = last ? nA : cA + (size_t)(t + 2) * kstep; const char* b2 = last ? nB : cB + (size_t)(t + 2) * kstep;
            const char* a3 = a2 + kstep; const char* b3 = b2 + kstep;
            PG8_LDB(B0, 0, 0); PG8_LDB(B1, 0, 1); PG8_SCHED; PG8_LDA(At, 0, 0); PG8_STAGE(PG8_SA(1, 1), a1 + hstepA, voffA);
            PG8_WAIT_V(8); PG8_WAIT_L(0); PG8_BAR; PG8_MMA(0, 0, At, B0); PG8_MMA(0, 1, At, B1); PG8_BAR; PG8_SCHED;
            PG8_LDA(At, 0, 1); PG8_STAGE(PG8_SB(0, 0), b2, voffB); PG8_STAGE(PG8_SB(0, 1), b2 + hstepB, voffB); PG8_STAGE(PG8_SA(0, 0), a2, voffA);
            PG8_WAIT_V(8); PG8_WAIT_L(0); PG8_BAR; PG8_MMA(1, 0, At, B0); PG8_MMA(1, 1, At, B1); PG8_BAR; PG8_SCHED;
            PG8_LDB(B0, 1, 0); PG8_LDB(B1, 1, 1); PG8_SCHED; PG8_LDA(At, 1, 0); PG8_STAGE(PG8_SA(0, 1), a2 + hstepA, voffA);
            PG8_WAIT_V(8); PG8_WAIT_L(0); PG8_BAR; PG8_MMA(0, 0, At, B0); PG8_MMA(0, 1, At, B1); PG8_BAR; PG8_SCHED;
            PG8_LDA(At, 1, 1); PG8_STAGE(PG8_SB(1, 0), b3, voffB); PG8_STAGE(PG8_SB(1, 1), b3 + hstepB, voffB); PG8_STAGE(PG8_SA(1, 0), a3, voffA);
            PG8_WAIT_V(8); PG8_WAIT_L(0); PG8_BAR; PG8_MMA(1, 0, At, B0); PG8_MMA(1, 1, At, B1); PG8_BAR; PG8_SCHED;
        }
        if (wr == 0) PG8_BAR;
        E(acc, cur, wr, wc, fr, fq);
        if (!has_next) break;
#pragma unroll
        for (int a = 0; a < 2; ++a)
#pragma unroll
            for (int b = 0; b < 2; ++b)
#pragma unroll
                for (int m = 0; m < 4; ++m)
#pragma unroll
                    for (int n = 0; n < 2; ++n) acc[a][b][m][n] = (f32x4){0.f, 0.f, 0.f, 0.f};
        cur = nxt; cA = nA; cB = nB; ++ui;
        if (wr == 1) PG8_BAR;
    }
    PG8_WAIT_V(0);
    PG8_BAR;
#undef PG8_SA
#undef PG8_SB
#undef PG8_STAGE
#undef PG8_LDA
#undef PG8_LDB
#undef PG8_MMA
#undef PG8_WAIT_V
#undef PG8_WAIT_L
#undef PG8_BAR
#undef PG8_SCHED
}
}

struct EInProj0 { bf16* PROJ; float* DT; float* outk; float* outv;
    __device__ __forceinline__ void operator()(int row, int col, f32x4 v0, f32x4 v1) const {
        if (col < 2816) {
            if (col >= PQ && col < PX) { v0 = v0 * 0.125f; v1 = v1 * 0.125f; }
            *(u32x4*)(PROJ + (size_t)row * PLD + col) = pack8(v0, v1);
            if (row < TC && col >= PK) { float* o = (col < PV) ? outk + (size_t)row * 512 + (col - PK) : outv + (size_t)row * 512 + (col - PV); *(f32x4*)o = v0; *(f32x4*)(o + 4) = v1; }
        } else if (col == 2816) { float* o = DT + (size_t)row * 8; *(f32x4*)o = v0; *(f32x4*)(o + 4) = v1; }
    } };
struct EResid { const float* xp; const float* xs; float* XR; const float* gate; int first;
    __device__ __forceinline__ void operator()(int row, int col, f32x4 v0, f32x4 v1) const {
        const float* g = gate + mod_row(row) * 6144 + col;
        const float* b = first ? (row < TC ? xp + (size_t)row * D : xs + (size_t)(row - TC) * D) + col : XR + (size_t)row * D + col;
        const f32x4 g0 = *(const f32x4*)g, g1 = *(const f32x4*)(g + 4), b0 = *(const f32x4*)b, b1 = *(const f32x4*)(b + 4);
        float* o = XR + (size_t)row * D + col; *(f32x4*)o = b0 + g0 * v0; *(f32x4*)(o + 4) = b1 + g1 * v1;
    } };
struct ESwiglu { bf16* G;
    __device__ __forceinline__ void operator()(int row, int col, f32x4 v0, f32x4 v1) const {
        u32x2 w; w.x = cvt_pk_bf16(silu_f(v0[0]) * v1[0], silu_f(v0[1]) * v1[1]); w.y = cvt_pk_bf16(silu_f(v0[2]) * v1[2], silu_f(v0[3]) * v1[3]);
        *(u32x2*)(G + (size_t)row * FF + (col >> 1)) = w;
    } };
struct EInProj1 { bf16* A2; bf16* ZTL; bf16* ZTC;
    __device__ __forceinline__ void operator()(int row, int col, f32x4 v0, f32x4 v1) const {
        if (col < 512) { const int g = col >> 4, cc = col & 15, ch = row >> 4, j = row & 15;
            *(u32x4*)(A2 + ((size_t)(g * 1536 + ch)) * 512 + j * 16 + cc) = pack8(v0, v1);
        } else { const int cs = (col - 512) >> 9, n = (col - 512) & 511; bf16* p; size_t st;
            if (row < TC) { const int b = row >> 8, l = row & 255; p = ZTC + ((size_t)(b * 512 + n)) * 512 + cs * 256 + l; st = 512; }
            else { const int r2 = row - TC, b = r2 >> 11, l = r2 & 2047; p = ZTL + ((size_t)(b * 512 + n)) * 4096 + cs * 2048 + l; st = 4096; }
#pragma unroll
            for (int e = 0; e < 4; ++e) { p[(size_t)e * st] = (bf16)f2bf(v0[e]); p[(size_t)(e + 4) * st] = (bf16)f2bf(v1[e]); }
        }
    } };
struct ESloc { float* S;
    __device__ __forceinline__ void operator()(int row, int col, f32x4 v0, f32x4 v1) const { float* o = S + (size_t)row * 256 + (col & 255); *(f32x4*)o = v0; *(f32x4*)(o + 4) = v1; } };
struct EY { bf16* G5;
    __device__ __forceinline__ void operator()(int row, int col, f32x4 v0, f32x4 v1) const {
        const int g = row / 1536, ch = row - g * 1536, c2 = col & 255, i = c2 >> 4, cc = c2 & 15;
        f32x4 a, b;
#pragma unroll
        for (int e = 0; e < 4; ++e) { a[e] = gelu_tanh(v0[e]); b[e] = gelu_tanh(v1[e]); }
        *(u32x4*)(G5 + (size_t)(ch * 16 + i) * 512 + g * 16 + cc) = pack8(a, b);
    } };
struct EGlu { const bf16* G5; const float* bias; bf16* MIX2;
    __device__ __forceinline__ void operator()(int row, int col, f32x4 v0, f32x4 v1) const {
        const u32x4 gr = *(const u32x4*)(G5 + (size_t)row * 512 + col); const f32x4 b0 = *(const f32x4*)(bias + col), b1 = *(const f32x4*)(bias + col + 4);
        f32x4 a, b;
        a[0] = bflo(gr.x) * sigmoid_f(v0[0] + b0[0]); a[1] = bfhi(gr.x) * sigmoid_f(v0[1] + b0[1]); a[2] = bflo(gr.y) * sigmoid_f(v0[2] + b0[2]); a[3] = bfhi(gr.y) * sigmoid_f(v0[3] + b0[3]);
        b[0] = bflo(gr.z) * sigmoid_f(v1[0] + b1[0]); b[1] = bfhi(gr.z) * sigmoid_f(v1[1] + b1[1]); b[2] = bflo(gr.w) * sigmoid_f(v1[2] + b1[2]); b[3] = bfhi(gr.w) * sigmoid_f(v1[3] + b1[3]);
        *(u32x4*)(MIX2 + (size_t)row * D + col) = pack8(a, b);
    } };
struct EFnetL { bf16* MIX2;
    __device__ __forceinline__ void operator()(int row, int col, f32x4 v0, f32x4 v1) const { const int b = col >> 9, n = col & 511; *(u32x4*)(MIX2 + (size_t)(TC + b * 2048 + row) * D + 512 + n) = pack8(v0, v1); } };
struct EFnetC { bf16* MIX2;
    __device__ __forceinline__ void operator()(int row, int col, f32x4 v0, f32x4 v1) const { const int b = col >> 9, n = col & 511; *(u32x4*)(MIX2 + (size_t)(b * 256 + row) * D + 512 + n) = pack8(v0, v1); } };

__device__ __forceinline__ int evin_dst(int n) {
    if (n < 512) return n;
    if (n < 1280) return n - 512 + PX;
    if (n < 1288) return n - 1280 + 2816;
    if (n < 1800) return n - 1288 + PQ;
    if (n < 2312) return n - 1800 + PK;
    return n - 2312 + PV;
}
template <int MODE> __device__ __forceinline__ int dst_row(int n) {
    if (MODE == 0) return n;
    if (MODE == 1) return evin_dst(n);
    if (MODE == 2) return 8 * (n >> 2) + (n & 3);
    return 8 * (n >> 2) + 4 + (n & 3);
}
template <int MODE> __device__ __forceinline__ void transpose_item(const float* W, int K, int N, int ldw, bf16* WT, float* scr, int item, int lane) {
    const int nblk = (N + 31) >> 5, kb = item / nblk, nb = item - kb * nblk, k0 = 64 * kb, n0 = 32 * nb;
    const int nn = n0 + (lane & 31); const bool ok = nn < N;
#pragma unroll 8
    for (int i = 0; i < 32; ++i) { const int kk = 2 * i + (lane >> 5); scr[kk * 33 + (lane & 31)] = ok ? W[(size_t)(k0 + kk) * ldw + nn] : 0.f; }
    LDS_WAIT(); asm volatile("" ::: "memory");
    const int c = lane & 7;
#pragma unroll
    for (int j = 0; j < 4; ++j) { const int n = (lane >> 3) + 8 * j;
        if (n0 + n < N) { const float* s = scr + (8 * c) * 33 + n;
            u32x4 o; o.x = pk2(s[0 * 33], s[1 * 33]); o.y = pk2(s[2 * 33], s[3 * 33]); o.z = pk2(s[4 * 33], s[5 * 33]); o.w = pk2(s[6 * 33], s[7 * 33]);
            *(u32x4*)(WT + (size_t)dst_row<MODE>(n0 + n) * K + k0 + 8 * c) = o; } }
    LDS_WAIT(); asm volatile("" ::: "memory");
}
template <int MODE> __device__ __forceinline__ void transpose_all(const float* W, int K, int N, int ldw, bf16* WT, float* scr, int gw, int NGW, int lane) {
    const int nitems = (K >> 6) * ((N + 31) >> 5);
    for (int it = gw; it < nitems; it += NGW) transpose_item<MODE>(W, K, N, ldw, WT, scr, it, lane);
}
__device__ __forceinline__ void fold_item(const float* W, bf16* WT, float* scr, int item, int lane) {
    const int g = item >> 4, k0 = (item & 15) * 64;
    for (int i = 0; i < 64; ++i) scr[i * 65 + lane] = W[(size_t)(k0 + i) * 1024 + 512 + g * 64 + lane];
    scr[64 * 65 + lane] = cospif(lane * (1.f / 32.f)) * 0.125f; scr[64 * 65 + 64 + lane] = sinpif(lane * (1.f / 32.f)) * 0.125f;
    LDS_WAIT(); asm volatile("" ::: "memory");
    for (int half = 0; half < 2; ++half) {
        float ac[32], as[32];
#pragma unroll
        for (int kk = 0; kk < 32; ++kk) { ac[kk] = 0.f; as[kk] = 0.f; }
        for (int c = 0; c < 64; ++c) { const int idx = (c * lane) & 63; const float ct = scr[64 * 65 + idx], st = scr[64 * 65 + 64 + idx];
#pragma unroll
            for (int kk = 0; kk < 32; ++kk) { const float w = scr[(half * 32 + kk) * 65 + c]; ac[kk] += w * ct; as[kk] += w * st; } }
        bf16* oc = WT + (size_t)(512 + g * 64 + lane) * 1024 + k0 + half * 32; bf16* os = WT + (size_t)(1024 + g * 64 + lane) * 1024 + k0 + half * 32;
#pragma unroll
        for (int q = 0; q < 4; ++q) {
            u32x4 a, b; a.x = pk2(ac[8 * q], ac[8 * q + 1]); a.y = pk2(ac[8 * q + 2], ac[8 * q + 3]); a.z = pk2(ac[8 * q + 4], ac[8 * q + 5]); a.w = pk2(ac[8 * q + 6], ac[8 * q + 7]);
            b.x = pk2(as[8 * q], as[8 * q + 1]); b.y = pk2(as[8 * q + 2], as[8 * q + 3]); b.z = pk2(as[8 * q + 4], as[8 * q + 5]); b.w = pk2(as[8 * q + 6], as[8 * q + 7]);
            *(u32x4*)(oc + 8 * q) = a; *(u32x4*)(os + 8 * q) = b; }
    }
    LDS_WAIT(); asm volatile("" ::: "memory");
}
__device__ __forceinline__ void cpow(float lre, float lim, float step, float e, float& re, float& im) {
    const float mag = __expf(e * lre * step); float tr = e * (lim * step * 0.15915494309189535f); tr -= floorf(tr);
    re = mag * cospif(2.f * tr); im = mag * sinpif(2.f * tr);
}
__device__ __forceinline__ void s5_k(float lre, float lim, float step, float& kr, float& ki) {
    const float zr = lre * step, zi = lim * step;
    if (zr * zr + zi * zi < 0.01f) {
        float pr = 1.f, pi = 0.f, sr = 1.f, si = 0.f; const float inv[4] = {0.5f, 1.f / 6.f, 1.f / 24.f, 1.f / 120.f};
#pragma unroll
        for (int q = 0; q < 4; ++q) { const float nr = pr * zr - pi * zi, ni = pr * zi + pi * zr; pr = nr; pi = ni; sr += pr * inv[q]; si += pi * inv[q]; }
        kr = step * sr; ki = step * si;
    } else { float ar, ai; cpow(lre, lim, step, 1.f, ar, ai); ar -= 1.f; const float den = lre * lre + lim * lim; kr = (ar * lre + ai * lim) / den; ki = (ai * lre - ar * lim) / den; }
}

__device__ __forceinline__ void prologue(const Args& A, unsigned char* lds) {
    const int tid = threadIdx.x, lane = tid & 63, wave = tid >> 6, G = gridDim.x;
    const int gw = blockIdx.x * 8 + wave, NGW = G * 8;
    const int gt = blockIdx.x * 512 + tid, NGT = G * 512;
    unsigned char* ws = A.ws;
    float* scr = (float*)(lds + wave * 17408);
    if (blockIdx.x < 192) {
        float* sc = (float*)lds;
        float* red = (float*)(lds + 36864);
        for (int i = tid; i < 9 * 1024; i += 512) { const int r = i >> 10, k = i & 1023; const float v = r == 0 ? A.in[7][k] : A.in[6][(r - 1) * 1024 + k]; sc[i] = silu_f(v); }
        __syncthreads();
        for (int item = blockIdx.x; item < 192; item += G) {
            const int layer = item / 96, n0 = (item % 96) * 64;
            const float* W = A.in[8] + (size_t)layer * 1024 * 6144 + n0 + lane;
            float acc[9];
#pragma unroll
            for (int r = 0; r < 9; ++r) acc[r] = 0.f;
            for (int k = wave * 128; k < wave * 128 + 128; k += 8) {
                float wv[8];
#pragma unroll
                for (int u = 0; u < 8; ++u) wv[u] = W[(size_t)(k + u) * 6144];
#pragma unroll
                for (int u = 0; u < 8; ++u)
#pragma unroll
                    for (int r = 0; r < 9; ++r) acc[r] += sc[r * 1024 + k + u] * wv[u];
            }
#pragma unroll
            for (int r = 0; r < 9; ++r) red[(wave * 9 + r) * 64 + lane] = acc[r];
            __syncthreads();
            for (int i = tid; i < 576; i += 512) { const int r = i >> 6, l = i & 63; float s = A.in[9][layer * 6144 + n0 + l];
#pragma unroll
                for (int w = 0; w < 8; ++w) s += red[(w * 9 + r) * 64 + l];
                ((float*)(ws + WS_MODV))[(layer * 9 + r) * 6144 + n0 + l] = s; }
            __syncthreads();
        }
    }
    __syncthreads();
    transpose_all<1>(A.in[16], 1024, 2824, 2824, (bf16*)(ws + WS_WEVIN), scr, gw, NGW, lane);
    transpose_all<0>(A.in[24], 1024, 1024, 1024, (bf16*)(ws + WS_WEVOUT), scr, gw, NGW, lane);
    transpose_all<0>(A.in[25], 1024, 512, 1024, (bf16*)(ws + WS_WODIN), scr, gw, NGW, lane);
    transpose_all<0>(A.in[36], 1024, 1024, 1024, (bf16*)(ws + WS_WODOUT), scr, gw, NGW, lane);
    transpose_all<0>(A.in[34], 512, 512, 512, (bf16*)(ws + WS_WGLU), scr, gw, NGW, lane);
    transpose_all<2>(A.in[12], 1024, 2816, 2816, (bf16*)(ws + WS_WFUP), scr, gw, NGW, lane);
    transpose_all<3>(A.in[13], 1024, 2816, 2816, (bf16*)(ws + WS_WFUP), scr, gw, NGW, lane);
    transpose_all<0>(A.in[14], 2816, 1024, 1024, (bf16*)(ws + WS_WFDN), scr, gw, NGW, lane);
    for (int it = gw; it < 128; it += NGW) fold_item(A.in[25], (bf16*)(ws + WS_WODIN), scr, it, lane);
    { u32x4* z = (u32x4*)(ws + WS_WEVIN + (size_t)2824 * 1024 * 2); const int n16 = 248 * 1024 * 2 / 16; for (int i = gt; i < n16; i += NGT) z[i] = (u32x4){0u, 0u, 0u, 0u}; }
    { bf16* DL = (bf16*)(ws + WS_DFTL); const float sc = 0.02209708691207961f;
      for (int i = gt; i < 2048 * 256; i += NGT) { const int k = i >> 8, l0 = (i & 255) * 8; float c[8], s[8];
#pragma unroll
        for (int e = 0; e < 8; ++e) { const int m = (k * (l0 + e)) & 2047; const float x = m * (1.f / 1024.f); c[e] = cospif(x) * sc; s[e] = -sinpif(x) * sc; }
        u32x4 a, b; a.x = pk2(c[0], c[1]); a.y = pk2(c[2], c[3]); a.z = pk2(c[4], c[5]); a.w = pk2(c[6], c[7]); b.x = pk2(s[0], s[1]); b.y = pk2(s[2], s[3]); b.z = pk2(s[4], s[5]); b.w = pk2(s[6], s[7]);
        *(u32x4*)(DL + (size_t)k * 4096 + l0) = a; *(u32x4*)(DL + (size_t)k * 4096 + 2048 + l0) = b; }
      bf16* DC = (bf16*)(ws + WS_DFTC); const float sc2 = 0.0625f;
      for (int i = gt; i < 256 * 32; i += NGT) { const int k = i >> 5, l0 = (i & 31) * 8; float c[8], s[8];
#pragma unroll
        for (int e = 0; e < 8; ++e) { const int m = (k * (l0 + e)) & 255; const float x = m * (1.f / 128.f); c[e] = cospif(x) * sc2; s[e] = -sinpif(x) * sc2; }
        u32x4 a, b; a.x = pk2(c[0], c[1]); a.y = pk2(c[2], c[3]); a.z = pk2(c[4], c[5]); a.w = pk2(c[6], c[7]); b.x = pk2(s[0], s[1]); b.y = pk2(s[2], s[3]); b.z = pk2(s[4], s[5]); b.w = pk2(s[6], s[7]);
        *(u32x4*)(DC + (size_t)k * 512 + l0) = a; *(u32x4*)(DC + (size_t)k * 512 + 256 + l0) = b; } }
    { const float* lamr = A.in[26]; const float* lami = A.in[27]; const float* lstep = A.in[28];
      const float* bre = A.in[29]; const float* bim = A.in[30]; const float* cre = A.in[31]; const float* cim = A.in[32]; const float* dsk = A.in[33];
      bf16* WY = (bf16*)(ws + WS_WWY); bf16* BS = (bf16*)(ws + WS_WBS);
      for (int i = gt; i < 32 * 16 * 256; i += NGT) {
          const int g = i >> 12, tau = (i >> 8) & 15, c = (i >> 4) & 15, cp = i & 15;
          float t0 = 0.f, t1 = 0.f;
          for (int d = 0; d < 2; ++d) { const float step = __expf(lstep[d * 32 + g]); float acc = 0.f;
              for (int p = 0; p < 64; ++p) { const float lre = lamr[(d * 32 + g) * 64 + p], lim = lami[(d * 32 + g) * 64 + p];
                  float kr, ki; s5_k(lre, lim, step, kr, ki); float pr, pi; cpow(lre, lim, step, (float)tau, pr, pi);
                  const float br = bre[(g * 64 + p) * 16 + cp], bi = bim[(g * 64 + p) * 16 + cp];
                  const float tbr = kr * br - ki * bi, tbi = kr * bi + ki * br;
                  const float qr = pr * tbr - pi * tbi, qi = pr * tbi + pi * tbr;
                  acc += cre[(g * 16 + c) * 64 + p] * qr - cim[(g * 16 + c) * 64 + p] * qi; }
              if (d == 0) t0 = acc; else t1 = acc; }
          bf16* base = WY + (size_t)g * 256 * 512;
          if (tau == 0) { const float v = t0 + t1 + (c == cp ? dsk[g * 16 + c] : 0.f); for (int ii = 0; ii < 16; ++ii) base[(size_t)(ii * 16 + c) * 512 + ii * 16 + cp] = (bf16)f2bf(v); }
          else { for (int ii = tau; ii < 16; ++ii) base[(size_t)(ii * 16 + c) * 512 + (ii - tau) * 16 + cp] = (bf16)f2bf(t0);
                 for (int ii = 0; ii < 16 - tau; ++ii) base[(size_t)(ii * 16 + c) * 512 + (ii + tau) * 16 + cp] = (bf16)f2bf(t1); }
      }
      for (int i = gt; i < 32 * 16 * 16 * 128; i += NGT) {
          const int p = i & 63, d = (i >> 6) & 1, c = (i >> 7) & 15, ii = (i >> 11) & 15, g = i >> 15;
          const float step = __expf(lstep[d * 32 + g]); const float lre = lamr[(d * 32 + g) * 64 + p], lim = lami[(d * 32 + g) * 64 + p];
          float pr, pi; cpow(lre, lim, step, d == 0 ? (float)(ii + 1) : (float)(16 - ii), pr, pi);
          const float cr = cre[(g * 16 + c) * 64 + p], ci = cim[(g * 16 + c) * 64 + p];
          const float vr = cr * pr - ci * pi, vi = cr * pi + ci * pr;
          bf16* rowp = WY + ((size_t)g * 256 + ii * 16 + c) * 512 + 256 + d * 128;
          rowp[p] = (bf16)f2bf(vr); rowp[64 + p] = (bf16)f2bf(-vi);
      }
      for (int i = gt; i < 32 * 2 * 64 * 256; i += NGT) {
          const int cp = i & 15, j = (i >> 4) & 15, p = (i >> 8) & 63, d = (i >> 14) & 1, g = i >> 15;
          const float step = __expf(lstep[d * 32 + g]); const float lre = lamr[(d * 32 + g) * 64 + p], lim = lami[(d * 32 + g) * 64 + p];
          float kr, ki; s5_k(lre, lim, step, kr, ki); float pr, pi; cpow(lre, lim, step, d == 0 ? (float)(15 - j) : (float)j, pr, pi);
          const float br = bre[(g * 64 + p) * 16 + cp], bi = bim[(g * 64 + p) * 16 + cp];
          const float tbr = kr * br - ki * bi, tbi = kr * bi + ki * br;
          bf16* o = BS + ((size_t)g * 256 + d * 128 + p) * 256 + j * 16 + cp;
          o[0] = (bf16)f2bf(pr * tbr - pi * tbi); o[(size_t)64 * 256] = (bf16)f2bf(pr * tbi + pi * tbr);
      }
    }
}

__device__ __forceinline__ void norm_phase(const float* xp, const float* xs, const float* XR, int first, const float* gam, const float* shift, const float* scale, bf16* H) {
    const int lane = threadIdx.x & 63, gw = blockIdx.x * 8 + (threadIdx.x >> 6), NGW = gridDim.x * 8;
    for (int row = gw; row < T; row += NGW) {
        const float* xr = first ? (row < TC ? xp + (size_t)row * D : xs + (size_t)(row - TC) * D) : XR + (size_t)row * D;
        f32x4 v[4]; float s = 0.f;
#pragma unroll
        for (int j = 0; j < 4; ++j) { v[j] = *(const f32x4*)(xr + 4 * lane + 256 * j); s += (v[j][0] * v[j][0] + v[j][1] * v[j][1]) + (v[j][2] * v[j][2] + v[j][3] * v[j][3]); }
        const float rstd = rsqrtf(wave_sum(s) * (1.f / D) + 1e-6f);
        const int mr = mod_row(row);
#pragma unroll
        for (int j = 0; j < 4; ++j) { const int c = 4 * lane + 256 * j; const f32x4 g = *(const f32x4*)(gam + c), sh = *(const f32x4*)(shift + mr * 6144 + c), sc = *(const f32x4*)(scale + mr * 6144 + c);
            const f32x4 y = v[j] * rstd * g * (sc + 1.f) + sh; u32x2 w; w.x = cvt_pk_bf16(y[0], y[1]); w.y = cvt_pk_bf16(y[2], y[3]); *(u32x2*)(H + (size_t)row * D + c) = w; }
    }
}
__device__ __forceinline__ void final_norm_phase(float* XR, const float* gam) {
    const int lane = threadIdx.x & 63, gw = blockIdx.x * 8 + (threadIdx.x >> 6), NGW = gridDim.x * 8;
    for (int row = gw; row < T; row += NGW) {
        float* xr = XR + (size_t)row * D; f32x4 v[4]; float s = 0.f;
#pragma unroll
        for (int j = 0; j < 4; ++j) { v[j] = *(const f32x4*)(xr + 4 * lane + 256 * j); s += (v[j][0] * v[j][0] + v[j][1] * v[j][1]) + (v[j][2] * v[j][2] + v[j][3] * v[j][3]); }
        const float rstd = rsqrtf(wave_sum(s) * (1.f / D) + 1e-6f);
#pragma unroll
        for (int j = 0; j < 4; ++j) { const int c = 4 * lane + 256 * j; const f32x4 g = *(const f32x4*)(gam + c); *(f32x4*)(xr + c) = v[j] * rstd * g; }
    }
}
__device__ __forceinline__ void gate_phase(const bf16* YD, bf16* PROJ, const float* gam) {
    const int lane = threadIdx.x & 63, gw = blockIdx.x * 8 + (threadIdx.x >> 6), NGW = gridDim.x * 8;
    for (int row = gw; row < T; row += NGW) {
        const u32x4 a = *(const u32x4*)(YD + (size_t)row * 512 + 8 * lane), b = *(const u32x4*)(YD + ((size_t)T + row) * 512 + 8 * lane), z = *(const u32x4*)(PROJ + (size_t)row * PLD + 8 * lane);
        float y[8];
        y[0] = (bflo(a.x) + bflo(b.x)) * silu_f(bflo(z.x)); y[1] = (bfhi(a.x) + bfhi(b.x)) * silu_f(bfhi(z.x));
        y[2] = (bflo(a.y) + bflo(b.y)) * silu_f(bflo(z.y)); y[3] = (bfhi(a.y) + bfhi(b.y)) * silu_f(bfhi(z.y));
        y[4] = (bflo(a.z) + bflo(b.z)) * silu_f(bflo(z.z)); y[5] = (bfhi(a.z) + bfhi(b.z)) * silu_f(bfhi(z.z));
        y[6] = (bflo(a.w) + bflo(b.w)) * silu_f(bflo(z.w)); y[7] = (bfhi(a.w) + bfhi(b.w)) * silu_f(bfhi(z.w));
        float s = 0.f;
#pragma unroll
        for (int e = 0; e < 8; ++e) s += y[e] * y[e];
        const float rstd = rsqrtf(wave_sum(s) * (1.f / 512.f) + 1e-6f);
        const f32x4 g0 = *(const f32x4*)(gam + 8 * lane), g1 = *(const f32x4*)(gam + 8 * lane + 4);
        u32x4 o; o.x = cvt_pk_bf16(y[0] * rstd * g0[0], y[1] * rstd * g0[1]); o.y = cvt_pk_bf16(y[2] * rstd * g0[2], y[3] * rstd * g0[3]);
        o.z = cvt_pk_bf16(y[4] * rstd * g1[0], y[5] * rstd * g1[1]); o.w = cvt_pk_bf16(y[6] * rstd * g1[2], y[7] * rstd * g1[3]);
        *(u32x4*)(PROJ + (size_t)row * PLD + 8 * lane) = o;
    }
}

__device__ __forceinline__ void ssd_item(const Args& A, unsigned char* lds, int item) {
    const int tid = threadIdx.x, lane = tid & 63, w = __builtin_amdgcn_readfirstlane(tid >> 6), fr = lane & 15, fq = lane >> 4;
    int seq, dir, h, L, tok0, nch; bool lat;
    if (item < 128) { lat = true; seq = item >> 4; dir = (item >> 3) & 1; h = item & 7; L = 2048; tok0 = TC + seq * 2048; nch = 16; }
    else { const int it = item - 128; lat = false; seq = it >> 4; dir = (it >> 3) & 1; h = it & 7; L = 256; tok0 = seq * 256; nch = 2; }
    const int g = h >> 2;
    bf16* Cm = (bf16*)lds; bf16* Bm = Cm + 128 * 72; bf16* XT = Bm + 128 * 72; bf16* BT = XT + 64 * 136; bf16* Mm = BT + 64 * 136; bf16* ST = Mm + 128 * 136;
    float* cum = (float*)(ST + 64 * 72); float* dtv = cum + 128; float* da = dtv + 128;
    const bf16* PROJ = (const bf16*)(A.ws + WS_R2); const float* DT = (const float*)(A.ws + WS_DT); bf16* YD = (bf16*)(A.ws + WS_R1);
    const float* convw = A.in[17]; const float* convb = A.in[18];
    const int pt = w >> 1, nt0 = 2 * (w & 1);
    f32x4 st[2];
#pragma unroll
    for (int q = 0; q < 2; ++q)
#pragma unroll
        for (int r = 0; r < 4; ++r) { const int p = 16 * pt + 4 * fq + r, n = 16 * (nt0 + q) + fr; st[q][r] = lat ? A.in[4][(size_t)((seq * 2 + dir) * 8 + h) * 4096 + p * 64 + n] : 0.f; }
    const float Aneg = -__expf(A.in[19][dir * 8 + h]); const float dtb = A.in[20][dir * 8 + h]; const float Dh = A.in[21][h];
    for (int c = 0; c < nch; ++c) {
        if (tid < 128) { const int j = tid; const int t = dir ? (L - 1 - (c * 128 + j)) : (c * 128 + j); const float x = DT[(size_t)(tok0 + t) * 8 + h] + dtb; const float dt = x > 20.f ? x : log1pf(__expf(x)); dtv[j] = dt; da[j] = dt * Aneg; }
#pragma unroll
        for (int q = 0; q < 2; ++q)
#pragma unroll
            for (int r = 0; r < 4; ++r) ST[(16 * pt + 4 * fq + r) * 72 + 16 * (nt0 + q) + fr] = (bf16)f2bf(st[q][r]);
        __syncthreads();
        if (tid < 128) { float s = 0.f; for (int j = 0; j <= tid; ++j) s += da[j]; cum[tid] = s; }
        __syncthreads();
        const float cl = cum[127];
        for (int idx = tid; idx < 3072; idx += 512) {
            const int j = idx / 24, cgp = idx - j * 24; const int t = dir ? (L - 1 - (c * 128 + j)) : (c * 128 + j);
            int ch; if (cgp < 8) ch = h * 64 + cgp * 8; else if (cgp < 16) ch = 512 + g * 64 + (cgp - 8) * 8; else ch = 640 + g * 64 + (cgp - 16) * 8;
            float acc[8];
            { const f32x4 b0 = *(const f32x4*)(convb + ch), b1 = *(const f32x4*)(convb + ch + 4); acc[0] = b0[0]; acc[1] = b0[1]; acc[2] = b0[2]; acc[3] = b0[3]; acc[4] = b1[0]; acc[5] = b1[1]; acc[6] = b1[2]; acc[7] = b1[3]; }
#pragma unroll
            for (int wv = 0; wv < 5; ++wv) { const int tt = t + wv - 2;
                if (tt >= 0 && tt < L) { const u32x4 raw = *(const u32x4*)(PROJ + (size_t)(tok0 + tt) * PLD + PX + ch);
                    const f32x4 w0 = *(const f32x4*)(convw + wv * 768 + ch), w1 = *(const f32x4*)(convw + wv * 768 + ch + 4);
                    acc[0] += w0[0] * bflo(raw.x); acc[1] += w0[1] * bfhi(raw.x); acc[2] += w0[2] * bflo(raw.y); acc[3] += w0[3] * bfhi(raw.y);
                    acc[4] += w1[0] * bflo(raw.z); acc[5] += w1[1] * bfhi(raw.z); acc[6] += w1[2] * bflo(raw.w); acc[7] += w1[3] * bfhi(raw.w); } }
#pragma unroll
            for (int e = 0; e < 8; ++e) acc[e] = silu_f(acc[e]);
            if (cgp < 8) { const float dt = dtv[j];
#pragma unroll
                for (int e = 0; e < 8; ++e) XT[(cgp * 8 + e) * 136 + j] = (bf16)f2bf(acc[e] * dt); }
            else if (cgp < 16) { const float te = __expf(cl - cum[j]); const int n0 = (cgp - 8) * 8;
                u32x4 o; o.x = pk2(acc[0], acc[1]); o.y = pk2(acc[2], acc[3]); o.z = pk2(acc[4], acc[5]); o.w = pk2(acc[6], acc[7]); *(u32x4*)(Bm + j * 72 + n0) = o;
#pragma unroll
                for (int e = 0; e < 8; ++e) BT[(n0 + e) * 136 + j] = (bf16)f2bf(acc[e] * te); }
            else { const int n0 = (cgp - 16) * 8; u32x4 o; o.x = pk2(acc[0], acc[1]); o.y = pk2(acc[2], acc[3]); o.z = pk2(acc[4], acc[5]); o.w = pk2(acc[6], acc[7]); *(u32x4*)(Cm + j * 72 + n0) = o; }
        }
        __syncthreads();
        {
            const bf16x8 af0 = ldfrag(Cm + 16 * w * 72, 72, lane, 0), af1 = ldfrag(Cm + 16 * w * 72, 72, lane, 1);
            for (int jt = 0; jt < 8; ++jt) { f32x4 acc = (f32x4){0.f, 0.f, 0.f, 0.f};
                acc = mma16(af0, ldfrag(Bm + 16 * jt * 72, 72, lane, 0), acc); acc = mma16(af1, ldfrag(Bm + 16 * jt * 72, 72, lane, 1), acc);
#pragma unroll
                for (int r = 0; r < 4; ++r) { const int i = 16 * w + 4 * fq + r, j = 16 * jt + fr; float v = (j <= i) ? acc[r] * __expf(cum[i] - cum[j]) : 0.f; if (dir == 0 && i == j) v += Dh / dtv[i]; Mm[i * 136 + j] = (bf16)f2bf(v); } }
        }
        __syncthreads();
        {
            f32x4 yd[4], yo[4];
#pragma unroll
            for (int q = 0; q < 4; ++q) { yd[q] = (f32x4){0.f, 0.f, 0.f, 0.f}; yo[q] = (f32x4){0.f, 0.f, 0.f, 0.f}; }
#pragma unroll
            for (int ks = 0; ks < 4; ++ks) { if (32 * ks <= 16 * w + 15) { const bf16x8 am = ldfrag(Mm + 16 * w * 136, 136, lane, ks);
#pragma unroll
                for (int q = 0; q < 4; ++q) yd[q] = mma16(am, ldfrag(XT + 16 * q * 136, 136, lane, ks), yd[q]); } }
#pragma unroll
            for (int ks = 0; ks < 2; ++ks) { const bf16x8 ac = ldfrag(Cm + 16 * w * 72, 72, lane, ks);
#pragma unroll
                for (int q = 0; q < 4; ++q) yo[q] = mma16(ac, ldfrag(ST + 16 * q * 72, 72, lane, ks), yo[q]); }
#pragma unroll
            for (int r = 0; r < 4; ++r) { const int i = 16 * w + 4 * fq + r; const float ec = __expf(cum[i]); const int t = dir ? (L - 1 - (c * 128 + i)) : (c * 128 + i);
                bf16* yp = YD + ((size_t)dir * T + tok0 + t) * 512 + h * 64 + fr;
#pragma unroll
                for (int q = 0; q < 4; ++q) yp[16 * q] = (bf16)f2bf(yd[q][r] + ec * yo[q][r]); }
        }
        {
            const float cd = __expf(cl);
#pragma unroll
            for (int q = 0; q < 2; ++q) st[q] = st[q] * cd;
#pragma unroll
            for (int ks = 0; ks < 4; ++ks) { const bf16x8 ax = ldfrag(XT + 16 * pt * 136, 136, lane, ks);
#pragma unroll
                for (int q = 0; q < 2; ++q) st[q] = mma16(ax, ldfrag(BT + 16 * (nt0 + q) * 136, 136, lane, ks), st[q]); }
        }
        __syncthreads();
    }
    if (!lat) {
#pragma unroll
        for (int q = 0; q < 2; ++q)
#pragma unroll
            for (int r = 0; r < 4; ++r) { const int p = 16 * pt + 4 * fq + r, n = 16 * (nt0 + q) + fr; A.out[O_SSD + (size_t)((seq * 2 + dir) * 8 + h) * 4096 + p * 64 + n] = st[q][r]; }
    }
}

__device__ __forceinline__ void attn_pair(const Args& A, unsigned char* lds, int pairidx) {
    const int tid = threadIdx.x, half = __builtin_amdgcn_readfirstlane(tid >> 8), ht = tid & 255, lane = tid & 63, w = __builtin_amdgcn_readfirstlane((tid >> 6) & 3), fr = lane & 15, fq = lane >> 4;
    unsigned char* hl = lds + half * 32768;
    bf16* Ks = (bf16*)hl; bf16* Vt = Ks + 64 * 72; bf16* Ps = Vt + 64 * 72 + w * 16 * 72; float* rp = (float*)(hl + 27648);
    bf16* PROJ = (bf16*)(A.ws + WS_R2);
    const int item = pairidx * 2 + half;
    const bool lat = item < 2048;
    int b, h, r = 0, rs = 0, qtok0, ntiles;
    if (lat) { b = item >> 8; h = (item >> 5) & 7; r = item & 31; qtok0 = TC + b * 2048 + r * 64; rs = min(max(r - 4, 0), 24); ntiles = 12; }
    else { const int it = item - 2048; b = it >> 5; h = (it >> 2) & 7; const int qb = it & 3; qtok0 = b * 256 + qb * 64; ntiles = 4; }
    for (int i = ht; i < 465; i += 256) rp[i] = A.in[23][h * 465 + i];
    bf16x8 qf[2];
    { const bf16* qp = PROJ + (size_t)(qtok0 + 16 * w + fr) * PLD + PQ + h * 64 + fq * 8; qf[0] = *(const bf16x8*)qp; qf[1] = *(const bf16x8*)(qp + 32); }
    f32x4 o[4]; float m[4], l[4];
#pragma unroll
    for (int q = 0; q < 4; ++q) { o[q] = (f32x4){0.f, 0.f, 0.f, 0.f}; m[q] = -1e30f; l[q] = 0.f; }
    for (int ti = 0; ti < ntiles; ++ti) {
        __syncthreads();
        for (int idx = ht; idx < 512; idx += 256) { const int key = idx >> 3, dc = idx & 7; u32x4 kv, vv;
            if (lat && ti >= 8) {
                const size_t off = (((size_t)b * 256 + (ti - 8) * 64 + key) * 8 + h) * 64 + dc * 8;
                const f32x4 k0 = *(const f32x4*)(A.in[2] + off), k1 = *(const f32x4*)(A.in[2] + off + 4), v0 = *(const f32x4*)(A.in[3] + off), v1 = *(const f32x4*)(A.in[3] + off + 4);
                kv.x = pk2(k0[0], k0[1]); kv.y = pk2(k0[2], k0[3]); kv.z = pk2(k1[0], k1[1]); kv.w = pk2(k1[2], k1[3]);
                vv.x = pk2(v0[0], v0[1]); vv.y = pk2(v0[2], v0[3]); vv.z = pk2(v1[0], v1[1]); vv.w = pk2(v1[2], v1[3]);
            } else {
                const size_t tok = lat ? (size_t)(TC + b * 2048 + (rs + ti) * 64 + key) : (size_t)(b * 256 + ti * 64 + key);
                kv = *(const u32x4*)(PROJ + tok * PLD + PK + h * 64 + dc * 8); vv = *(const u32x4*)(PROJ + tok * PLD + PV + h * 64 + dc * 8);
            }
            *(u32x4*)(Ks + key * 72 + dc * 8) = kv;
            bf16* vt = Vt + (dc * 8) * 72 + key;
            vt[0] = (bf16)(vv.x & 0xffff); vt[72] = (bf16)(vv.x >> 16); vt[144] = (bf16)(vv.y & 0xffff); vt[216] = (bf16)(vv.y >> 16);
            vt[288] = (bf16)(vv.z & 0xffff); vt[360] = (bf16)(vv.z >> 16); vt[432] = (bf16)(vv.w & 0xffff); vt[504] = (bf16)(vv.w >> 16);
        }
        __syncthreads();
        f32x4 s[4];
#pragma unroll
        for (int t = 0; t < 4; ++t) { s[t] = (f32x4){0.f, 0.f, 0.f, 0.f};
#pragma unroll
            for (int ks = 0; ks < 2; ++ks) s[t] = mma16(qf[ks], ldfrag(Ks + 16 * t * 72, 72, lane, ks), s[t]); }
        if (lat && ti < 8) { const int dr = rs + ti - r + 7;
#pragma unroll
            for (int t = 0; t < 4; ++t)
#pragma unroll
                for (int rr = 0; rr < 4; ++rr) { const int qc = 16 * w + 4 * fq + rr, kc = 16 * t + fr; const int cs = min(max(qc - 8, 0), 48); const bool ok = (kc >= cs) && (kc < cs + 16);
                    const int bi = min(max(kc - qc + 15, 0), 30); s[t][rr] = ok ? s[t][rr] + rp[dr * 31 + bi] : -1e30f; } }
#pragma unroll
        for (int rr = 0; rr < 4; ++rr) {
            float mx = fmaxf(fmaxf(s[0][rr], s[1][rr]), fmaxf(s[2][rr], s[3][rr]));
            mx = fmaxf(mx, __shfl_xor(mx, 1)); mx = fmaxf(mx, __shfl_xor(mx, 2)); mx = fmaxf(mx, __shfl_xor(mx, 4)); mx = fmaxf(mx, __shfl_xor(mx, 8));
            const float mn = fmaxf(m[rr], mx); const float al = __expf(m[rr] - mn); m[rr] = mn; float sum = 0.f;
#pragma unroll
            for (int t = 0; t < 4; ++t) { const float p = __expf(s[t][rr] - mn); s[t][rr] = p; sum += p; }
            sum += __shfl_xor(sum, 1); sum += __shfl_xor(sum, 2); sum += __shfl_xor(sum, 4); sum += __shfl_xor(sum, 8);
            l[rr] = l[rr] * al + sum;
#pragma unroll
            for (int q = 0; q < 4; ++q) o[q][rr] *= al;
        }
#pragma unroll
        for (int t = 0; t < 4; ++t)
#pragma unroll
            for (int rr = 0; rr < 4; ++rr) Ps[(4 * fq + rr) * 72 + 16 * t + fr] = (bf16)f2bf(s[t][rr]);
        __syncthreads();
#pragma unroll
        for (int ks = 0; ks < 2; ++ks) { const bf16x8 pa = ldfrag(Ps, 72, lane, ks);
#pragma unroll
            for (int q = 0; q < 4; ++q) o[q] = mma16(pa, ldfrag(Vt + 16 * q * 72, 72, lane, ks), o[q]); }
    }
#pragma unroll
    for (int rr = 0; rr < 4; ++rr) { const float inv = 1.f / l[rr]; bf16* op = PROJ + (size_t)(qtok0 + 16 * w + 4 * fq + rr) * PLD + PQ + h * 64 + fr;
#pragma unroll
        for (int q = 0; q < 4; ++q) op[16 * q] = (bf16)f2bf(o[q][rr] * inv); }
}

__device__ __forceinline__ void s5_scan_phase(const Args& A) {
    const int gt = blockIdx.x * 512 + threadIdx.x, NGT = gridDim.x * 512;
    const float* Sloc = (const float*)(A.ws + WS_R1); bf16* A2 = (bf16*)(A.ws + WS_R2 + R2_A2);
    for (int idx = gt; idx < 163840; idx += NGT) {
        const bool lat = idx < 32768; const int i2 = lat ? idx : idx - 32768;
        const int b = i2 >> 12, rem = i2 & 4095, g = rem >> 7, d = (rem >> 6) & 1, p = rem & 63;
        const int nch = lat ? 128 : 16, chunk0 = lat ? 512 + b * 128 : b * 16, rowbase = g * 1536 + chunk0;
        const float step = __expf(A.in[28][d * 32 + g]); const float lre = A.in[26][(d * 32 + g) * 64 + p], lim = A.in[27][(d * 32 + g) * 64 + p];
        float ar, ai; cpow(lre, lim, step, 16.f, ar, ai);
        float sr = 0.f, si = 0.f;
        if (lat) { const float* s0 = A.in[5] + ((size_t)((b * 2 + d) * 32 + g) * 64 + p) * 2; sr = s0[0]; si = s0[1]; }
        for (int n0 = 0; n0 < nch; n0 += 16) {
            float xr[16], xi[16];
#pragma unroll
            for (int u = 0; u < 16; ++u) { const int n = d == 0 ? n0 + u : nch - 1 - (n0 + u); const float* sp = Sloc + (size_t)(rowbase + n) * 256 + d * 128 + p; xr[u] = sp[0]; xi[u] = sp[64]; }
#pragma unroll
            for (int u = 0; u < 16; ++u) { const int n = d == 0 ? n0 + u : nch - 1 - (n0 + u); bf16* ap = A2 + (size_t)(rowbase + n) * 512 + 256 + d * 128 + p;
                ap[0] = (bf16)f2bf(sr); ap[64] = (bf16)f2bf(si);
                const float nr = ar * sr - ai * si + xr[u], ni = ar * si + ai * sr + xi[u]; sr = nr; si = ni; }
        }
        if (!lat) { float* o = A.out + O_S5 + ((size_t)((b * 2 + d) * 32 + g) * 64 + p) * 2; o[0] = sr; o[1] = si; }
    }
}


#define XB_TMO      128
#define XB_XCNT(j)  (256  + 64 * (j))
#define XB_XSUB(j)  (1280 + 64 * (j))
#define XB_XGEN(j)  (2304 + 64 * (j))
#define XB_TOP      3328
#define XB_TOPGEN   3392
#define XB_SPIN_CAP (1u << 22)
__device__ __forceinline__ unsigned xb_ld(unsigned* p)              { return __hip_atomic_load(p, __ATOMIC_RELAXED, __HIP_MEMORY_SCOPE_AGENT); }
__device__ __forceinline__ unsigned xb_add(unsigned* p, unsigned v) { return __hip_atomic_fetch_add(p, v, __ATOMIC_RELAXED, __HIP_MEMORY_SCOPE_AGENT); }
__device__ __forceinline__ unsigned xb_xcc_id() { return (unsigned)__builtin_amdgcn_s_getreg((3 << 11) | 20) & 0xFu; }
#define XB_SPIN(cond, bar) do { unsigned _sp = 0; while (cond) { __builtin_amdgcn_s_sleep(1); \
    if ((++_sp & 255u) == 0u) { if (xb_ld(&(bar)[XB_TMO])) break; if (_sp > XB_SPIN_CAP) { atomicAdd(&(bar)[XB_TMO], 1u); break; } } } } while (0)
struct XcdBarrier { unsigned* bar; unsigned x; volatile unsigned* st; };
__device__ __forceinline__ XcdBarrier xcd_barrier_post(unsigned* bar, volatile unsigned* st) {
    XcdBarrier b; b.bar = bar; b.x = xb_xcc_id(); b.st = st;
    if (threadIdx.x == 0) (void)xb_add(&bar[XB_XCNT(b.x)], 1u);
    return b;
}
__device__ __forceinline__ void xcd_barrier_complete(unsigned* bar, unsigned x, unsigned& nloc, unsigned& nx) {
    const unsigned G = gridDim.x;
    unsigned sum, cnt, mine, sp = 0u;
    for (;;) {
        sum = 0u; cnt = 0u; mine = 0u;
#pragma unroll
        for (unsigned j = 0; j < 16; ++j) { const unsigned c = xb_ld(&bar[XB_XCNT(j)]); sum += c; cnt += (c > 0u) ? 1u : 0u; mine = (j == x) ? c : mine; }
        if (sum == G) break;
        __builtin_amdgcn_s_sleep(1);
        if ((++sp & 255u) == 0u) { if (xb_ld(&bar[XB_TMO])) break; if (sp > XB_SPIN_CAP) { atomicAdd(&bar[XB_TMO], 1u); break; } }
    }
    nloc = mine > 0u ? mine : 1u; nx = cnt > 0u ? cnt : 1u;
}
__device__ __forceinline__ void xcd_barrier(const XcdBarrier& b) {
    asm volatile("s_waitcnt vmcnt(0)" ::: "memory");
    __syncthreads();
    if (threadIdx.x == 0) {
        unsigned* bar = b.bar;
        __builtin_amdgcn_s_waitcnt(0);
        unsigned nloc = b.st[0], nx = b.st[1];
        if (nloc == 0u) { xcd_barrier_complete(bar, b.x, nloc, nx); b.st[0] = nloc; b.st[1] = nx; }
        const unsigned old = xb_add(&bar[XB_XSUB(b.x)], 1u);
        const unsigned gen = old / nloc;
        if (old + 1u == (gen + 1u) * nloc) {
            __builtin_amdgcn_fence(__ATOMIC_RELEASE, "agent");
            asm volatile("s_waitcnt vmcnt(0)" ::: "memory");
            const unsigned og = xb_add(&bar[XB_TOP], 1u);
            const unsigned tg = og / nx;
            if (og + 1u == (tg + 1u) * nx) xb_add(&bar[XB_TOPGEN], 1u);
            else XB_SPIN(xb_ld(&bar[XB_TOPGEN]) == tg, bar);
            __builtin_amdgcn_fence(__ATOMIC_ACQUIRE, "agent");
            xb_add(&bar[XB_XGEN(b.x)], 1u);
            asm volatile("s_waitcnt vmcnt(0)" ::: "memory");
        } else {
            XB_SPIN(xb_ld(&bar[XB_XGEN(b.x)]) == gen, bar);
            __builtin_amdgcn_fence(__ATOMIC_ACQUIRE, "agent");
            asm volatile("s_waitcnt vmcnt(0)" ::: "memory");
        }
    }
    __syncthreads();
}

__global__ void __launch_bounds__(512, 2) mk_fwd(Args A) {
    extern __shared__ __attribute__((aligned(16))) unsigned char lds[];
    cg::grid_group grid = cg::this_grid();
    const int tid = threadIdx.x, G = gridDim.x, bx = blockIdx.x;
    unsigned char* ws = A.ws;
    LAS unsigned char* ldsl = (LAS unsigned char*)lds;
    const int lo = A.ph_lo, hi = A.ph_hi;
#define IN(k) (lo <= (k) && (k) < hi)
#define SEAM(k) do { if (IN(k) && IN((k) + 1)) { if ((k) == 0) grid.sync(); else xcd_barrier(xb); } } while (0)
    volatile unsigned* xst = (volatile unsigned*)(lds + SLOT_OFF + 16);
    if (tid == 0) { xst[0] = 0u; xst[1] = 0u; }
    __syncthreads();
    XcdBarrier xb; xb.bar = (unsigned*)(ws + WS_BAR); xb.x = 0; xb.st = xst;
    if (hi - lo > 1) xb = xcd_barrier_post((unsigned*)(ws + WS_BAR), xst);
    float* XR = A.out;
    const float* MODV = (const float*)(ws + WS_MODV);
    bf16* H = (bf16*)(ws + WS_R1); bf16* PROJ = (bf16*)(ws + WS_R2); bf16* Gb = (bf16*)(ws + WS_R2);
    bf16* MIX2 = (bf16*)(ws + WS_R1); bf16* A2 = (bf16*)(ws + WS_R2 + R2_A2); bf16* ZTL = (bf16*)(ws + WS_R2 + R2_ZTL); bf16* ZTC = (bf16*)(ws + WS_R2 + R2_ZTC); bf16* G5 = (bf16*)(ws + WS_R2 + R2_G5);

    if (IN(0)) { prologue(A, lds); } SEAM(0);
    if (IN(1)) { norm_phase(A.in[0], A.in[1], XR, 1, A.in[10], MODV, MODV + 1024, H); } SEAM(1);
    if (IN(2)) { pg8::Gemm g{H, (const bf16*)(ws + WS_WEVIN), 1024, 1024, 1024}; pg8::StaticOrder S; S.init(T, 3072, G, bx);
        pg8::Epi8<EInProj0> E{{PROJ, (float*)(ws + WS_DT), A.out + O_K, A.out + O_V}}; pg8::gemm_phase(ldsl, g, S, E); } SEAM(2);
    if (IN(3)) {
        unsigned* ctr = (unsigned*)(ws + WS_CTL); volatile int* slot = (volatile int*)(lds + SLOT_OFF);
        for (;;) { __syncthreads(); if (tid == 0) *slot = (int)atomicAdd(ctr, 1u); __syncthreads(); const int it = *slot;
            if (it >= 640 + 1536) break; if (it < 640) ssd_item(A, lds, it); else attn_pair(A, lds, it - 640); }
    } SEAM(3);
    if (IN(4)) { gate_phase((const bf16*)(ws + WS_R1), PROJ, A.in[22]); } SEAM(4);
    if (IN(5)) { pg8::Gemm g{PROJ, (const bf16*)(ws + WS_WEVOUT), 1024, PLD, 1024}; pg8::StaticOrder S; S.init(T, 1024, G, bx);
        pg8::Epi8<EResid> E{{A.in[0], A.in[1], XR, MODV + 2048, 1}}; pg8::gemm_phase(ldsl, g, S, E); } SEAM(5);
    if (IN(6)) { norm_phase(A.in[0], A.in[1], XR, 0, A.in[11], MODV + 3072, MODV + 4096, H); } SEAM(6);
    if (IN(7)) { pg8::Gemm g{H, (const bf16*)(ws + WS_WFUP), 1024, 1024, 1024}; pg8::StaticOrder S; S.init(T, 5632, G, bx);
        pg8::Epi8<ESwiglu> E{{Gb}}; pg8::gemm_phase(ldsl, g, S, E); } SEAM(7);
    if (IN(8)) { pg8::Gemm g{Gb, (const bf16*)(ws + WS_WFDN), 2816, 2816, 2816}; pg8::StaticOrder S; S.init(T, 1024, G, bx);
        pg8::Epi8<EResid> E{{A.in[0], A.in[1], XR, MODV + 5120, 0}}; pg8::gemm_phase(ldsl, g, S, E); } SEAM(8);
    const float* MODV1 = MODV + 9 * 6144;
    if (IN(9)) { norm_phase(A.in[0], A.in[1], XR, 0, A.in[10] + 1024, MODV1, MODV1 + 1024, H);
        __syncthreads();
        float* scr = (float*)(lds + (tid >> 6) * 17408); const int gw = bx * 8 + (tid >> 6), NGW = G * 8, lane = tid & 63;
        transpose_all<2>(A.in[12] + (size_t)1024 * 2816, 1024, 2816, 2816, (bf16*)(ws + WS_WFUP), scr, gw, NGW, lane);
        transpose_all<3>(A.in[13] + (size_t)1024 * 2816, 1024, 2816, 2816, (bf16*)(ws + WS_WFUP), scr, gw, NGW, lane);
        transpose_all<0>(A.in[14] + (size_t)2816 * 1024, 2816, 1024, 1024, (bf16*)(ws + WS_WFDN), scr, gw, NGW, lane);
        __syncthreads(); } SEAM(9);
    if (IN(10)) { pg8::Gemm g{H, (const bf16*)(ws + WS_WODIN), 1024, 1024, 1024}; pg8::StaticOrder S; S.init(T, 1536, G, bx);
        pg8::Epi8<EInProj1> E{{A2, ZTL, ZTC}}; pg8::gemm_phase(ldsl, g, S, E); } SEAM(10);
    if (IN(11)) { pg8::Gemm g{A2, (const bf16*)(ws + WS_WBS), 256, 512, 256}; pg8::SchedS5 S{G, bx, 192};
        pg8::Epi8<ESloc> E{{(float*)(ws + WS_R1)}}; pg8::gemm_phase(ldsl, g, S, E); } SEAM(11);
    if (IN(12)) { s5_scan_phase(A); } SEAM(12);
    if (IN(13)) {
        { pg8::Gemm g{(const bf16*)(ws + WS_DFTL), ZTL, 4096, 4096, 4096}; pg8::StaticOrder S; S.init(2048, 4096, 128, bx < 128 ? bx : (1 << 30));
          pg8::Epi8<EFnetL> E{{MIX2}}; pg8::gemm_phase(ldsl, g, S, E); }
        { pg8::Gemm g{A2, (const bf16*)(ws + WS_WWY), 512, 512, 512}; pg8::SchedS5 S{128, bx >= 128 ? bx - 128 : (1 << 30), 192};
          pg8::Epi8<EY> E{{G5}}; pg8::gemm_phase(ldsl, g, S, E); }
        { pg8::Gemm g{(const bf16*)(ws + WS_DFTC), ZTC, 512, 512, 512}; pg8::StaticOrder S; S.init(256, 16384, 64, bx >= 192 ? bx - 192 : (1 << 30));
          pg8::Epi8<EFnetC> E{{MIX2}}; pg8::gemm_phase(ldsl, g, S, E); }
    } SEAM(13);
    if (IN(14)) { pg8::Gemm g{G5, (const bf16*)(ws + WS_WGLU), 512, 512, 512}; pg8::StaticOrder S; S.init(T, 512, G, bx);
        pg8::Epi8<EGlu> E{{G5, A.in[35], MIX2}}; pg8::gemm_phase(ldsl, g, S, E); } SEAM(14);
    if (IN(15)) { pg8::Gemm g{MIX2, (const bf16*)(ws + WS_WODOUT), 1024, 1024, 1024}; pg8::StaticOrder S; S.init(T, 1024, G, bx);
        pg8::Epi8<EResid> E{{A.in[0], A.in[1], XR, MODV1 + 2048, 0}}; pg8::gemm_phase(ldsl, g, S, E); } SEAM(15);
    if (IN(16)) { norm_phase(A.in[0], A.in[1], XR, 0, A.in[11] + 1024, MODV1 + 3072, MODV1 + 4096, H); } SEAM(16);
    if (IN(17)) { pg8::Gemm g{H, (const bf16*)(ws + WS_WFUP), 1024, 1024, 1024}; pg8::StaticOrder S; S.init(T, 5632, G, bx);
        pg8::Epi8<ESwiglu> E{{Gb}}; pg8::gemm_phase(ldsl, g, S, E); } SEAM(17);
    if (IN(18)) { pg8::Gemm g{Gb, (const bf16*)(ws + WS_WFDN), 2816, 2816, 2816}; pg8::StaticOrder S; S.init(T, 1024, G, bx);
        pg8::Epi8<EResid> E{{A.in[0], A.in[1], XR, MODV1 + 5120, 0}}; pg8::gemm_phase(ldsl, g, S, E); } SEAM(18);
    if (IN(19)) { final_norm_phase(XR, A.in[15]); }
#undef IN
#undef SEAM
}

extern "C" void kernel_launch(void* const* d_in, const int* in_sizes, int n_in, void* d_out, int out_size, void* d_ws, size_t ws_size, hipStream_t stream) {
    static int grid = 0;
    if (grid == 0) {
        if (n_in != 37 || ws_size < WS_END) { fprintf(stderr, "kernel_launch: unexpected n_in %d / ws %zu\n", n_in, ws_size); grid = -1; return; }
        int dev = 0, cus = 0, per_cu = 0;
        hipGetDevice(&dev); hipDeviceGetAttribute(&cus, hipDeviceAttributeMultiprocessorCount, dev);
        if (hipFuncSetAttribute((const void*)mk_fwd, hipFuncAttributeMaxDynamicSharedMemorySize, LDS_BYTES) != hipSuccess) { fprintf(stderr, "kernel_launch: hipFuncSetAttribute failed\n"); grid = -1; return; }
        hipOccupancyMaxActiveBlocksPerMultiprocessor(&per_cu, (const void*)mk_fwd, 512, LDS_BYTES);
        (void)hipGetLastError();
        if (per_cu < 1) per_cu = 1;
        grid = cus * 1;
        if (grid <= 0) grid = 256;
    }
    if (grid < 0) return;
    hipMemsetAsync((char*)d_ws + WS_CTL, 0, CTL_BYTES, stream);
    Args a{};
    for (int i = 0; i < 37; ++i) a.in[i] = (const float*)d_in[i];
    a.out = (float*)d_out; a.ws = (unsigned char*)d_ws;
#if MK_MODE == 1
    for (int ph = 0; ph < NPH; ++ph) { a.ph_lo = ph; a.ph_hi = ph + 1; hipLaunchKernelGGL(mk_fwd, dim3(grid), dim3(512), LDS_BYTES, stream, a); }
#else
    a.ph_lo = 0; a.ph_hi = NPH;
    void* params[] = {&a};
    hipError_t e = hipLaunchCooperativeKernel((const void*)mk_fwd, dim3(grid), dim3(512), params, LDS_BYTES, stream);
    if (e != hipSuccess) fprintf(stderr, "cooperative launch failed: %s (grid %d)\n", hipGetErrorString(e), grid);
#endif
}
```

```cpp
#include <hip/hip_runtime.h>
#include <hip/hip_cooperative_groups.h>
#include <cstdio>
#include <cstdint>
namespace cg = cooperative_groups;

#ifndef MK_MODE
#define MK_MODE 0
#endif

#define LAS __attribute__((address_space(3)))
typedef unsigned short bf16;
typedef short bf16x8 __attribute__((ext_vector_type(8)));
typedef float f32x4 __attribute__((ext_vector_type(4)));
typedef unsigned u32x4 __attribute__((ext_vector_type(4)));
typedef unsigned u32x2 __attribute__((ext_vector_type(2)));

constexpr int D = 1024, TC = 8192, TL = 16384, T = 24576, FF = 2816;
constexpr int PLD = 2816;
constexpr int PZ = 0, PQ = 512, PX = 1024, PK = 1792, PV = 2304;
constexpr int NPH = 20;
constexpr int LDS_BYTES = 147456;
constexpr int SLOT_OFF = LDS_BYTES - 64;
constexpr size_t MiB = 1u << 20;
constexpr size_t WS_CTL = 0, CTL_BYTES = 524288, WS_BAR = 4096;
constexpr size_t WS_MODV = 64 * 1024;
constexpr size_t WS_DT = 1 * MiB;
constexpr size_t WS_WEVIN = 2 * MiB;
constexpr size_t WS_WEVOUT = 8 * MiB;
constexpr size_t WS_WODIN = 10 * MiB;
constexpr size_t WS_WODOUT = 13 * MiB;
constexpr size_t WS_WGLU = 15 * MiB;
constexpr size_t WS_DFTC = 15 * MiB + 512 * 1024;
constexpr size_t WS_WFUP = 16 * MiB;
constexpr size_t WS_WFDN = 27 * MiB;
constexpr size_t WS_WBS = 33 * MiB;
constexpr size_t WS_WWY = 37 * MiB;
constexpr size_t WS_DFTL = 45 * MiB;
constexpr size_t WS_R1 = 62 * MiB;
constexpr size_t WS_R2 = 110 * MiB;
constexpr size_t WS_END = 242 * MiB;
constexpr size_t R2_A2 = 0, R2_ZTL = 48 * MiB, R2_ZTC = 80 * MiB, R2_G5 = 96 * MiB;
constexpr size_t O_K = 25165824, O_V = 29360128, O_SSD = 33554432, O_S5 = 35651584;

struct Args { const float* in[37]; float* out; unsigned char* ws; int ph_lo, ph_hi; };

__device__ __forceinline__ unsigned f2bf(float f) { unsigned u = __builtin_bit_cast(unsigned, f); return (u + 0x7fffu + ((u >> 16) & 1u)) >> 16; }
__device__ __forceinline__ unsigned pk2(float lo, float hi) { return f2bf(lo) | (f2bf(hi) << 16); }
__device__ __forceinline__ float bflo(unsigned u) { return __builtin_bit_cast(float, u << 16); }
__device__ __forceinline__ float bfhi(unsigned u) { return __builtin_bit_cast(float, u & 0xffff0000u); }
__device__ __forceinline__ unsigned cvt_pk_bf16(float lo, float hi) { unsigned r; asm volatile("v_cvt_pk_bf16_f32 %0, %1, %2" : "=v"(r) : "v"(lo), "v"(hi)); return r; }
__device__ __forceinline__ u32x4 pack8(f32x4 a, f32x4 b) { u32x4 w; w.x = cvt_pk_bf16(a[0], a[1]); w.y = cvt_pk_bf16(a[2], a[3]); w.z = cvt_pk_bf16(b[0], b[1]); w.w = cvt_pk_bf16(b[2], b[3]); return w; }
__device__ __forceinline__ float silu_f(float x) { return x / (1.f + __expf(-x)); }
__device__ __forceinline__ float sigmoid_f(float x) { return 1.f / (1.f + __expf(-x)); }
__device__ __forceinline__ float gelu_tanh(float x) { const float u = 0.7978845608028654f * (x + 0.044715f * x * x * x); const float t = 1.f - 2.f / (__expf(2.f * u) + 1.f); return 0.5f * x * (1.f + t); }
__device__ __forceinline__ float wave_sum(float v) {
#pragma unroll
    for (int o = 1; o < 64; o <<= 1) v += __shfl_xor(v, o);
    return v;
}
__device__ __forceinline__ int mod_row(int row) { return row < TC ? 0 : 1 + ((row - TC) >> 11); }
#define LDS_WAIT() asm volatile("s_waitcnt lgkmcnt(0)" ::: "memory")
__device__ __forceinline__ int opaque_tid() { int t = threadIdx.x; asm volatile("" : "+v"(t)); return t; }
__device__ __forceinline__ f32x4 mma16(bf16x8 a, bf16x8 b, f32x4 c) { return __builtin_amdgcn_mfma_f32_16x16x32_bf16(a, b, c, 0, 0, 0); }
__device__ __forceinline__ bf16x8 ldfrag(const bf16* base, int stride, int lane, int ks) { return *(const bf16x8*)(base + (lane & 15) * stride + ks * 32 + (lane >> 4) * 8); }

namespace pg8 {
constexpr int BM = 256, BK = 64, HALF = 128, HTB = HALF * BK * 2, NXCD = 8, WGM = 8;
__host__ __device__ __forceinline__ int lds_byte(int r, int c) { const int st = (r >> 4) * 2 + (c >> 5), rr = r & 15, cc = c & 31, ob = rr * 64 + cc * 2; return st * 1024 + (ob ^ (((ob >> 9) & 1) << 5)); }
__host__ __device__ __forceinline__ void stage_rc(int b, int& R, int& C) { const int st = b / 1024, sb = b % 1024, swz = sb ^ (((sb >> 9) & 1) << 5); R = (st >> 1) * 16 + swz / 64; C = (st & 1) * 32 + (swz % 64) / 2; }
__host__ __device__ __forceinline__ int perm32(int rho) { const int n = rho >> 4, i = rho & 15; return 8 * (i >> 2) + 4 * n + (i & 3); }
struct Unit { int pm, pn; };
struct Gemm { const bf16* A; const bf16* Bt; int K, lda, ldb; };
struct StaticOrder {
    int nM, nN, nwg, G, c;
    __device__ void init(int M, int N, int G_, int c_) { nM = M / BM; nN = N / BM; nwg = nM * nN; G = G_; c = c_; }
    __device__ bool next(int i, Unit& u) const {
        const long L = (long)i * G + c; if (L >= nwg) return false;
        int wgid = (int)L; { const int q = nwg / NXCD, r = nwg % NXCD, xcd = wgid % NXCD, off = wgid / NXCD; wgid = (xcd < r ? xcd * (q + 1) : r * (q + 1) + (xcd - r) * q) + off; }
        const int nig = WGM * nN, gid = wgid / nig, fm = gid * WGM, gsz = (nM - fm) < WGM ? (nM - fm) : WGM;
        u.pm = fm + ((wgid % nig) % gsz); u.pn = (wgid % nig) / gsz; return true;
    }
};
struct SchedS5 {
    int G, c, nunits;
    __device__ bool next(int i, Unit& u) const { const long L = (long)i * G + c; if (L >= nunits) return false; u.pm = (int)L; u.pn = (int)L / 6; return true; }
};
template <class F> struct Epi8 {
    static constexpr bool PERM = true;
    F f;
    __device__ __forceinline__ void operator()(const f32x4 (&acc)[2][2][4][2], const Unit& u, int wr, int wc, int fr, int fq) const {
#pragma unroll
        for (int ai = 0; ai < 2; ++ai)
#pragma unroll
            for (int m = 0; m < 4; ++m) { const int row = u.pm * BM + ai * HALF + wr * 64 + m * 16 + fr;
#pragma unroll
                for (int bj = 0; bj < 2; ++bj) { const int col0 = u.pn * BM + bj * HALF + wc * 32 + 8 * fq; f(row, col0, acc[ai][bj][m][0], acc[ai][bj][m][1]); } }
    }
};

template <class Epi, class Sched>
__device__ __forceinline__ void gemm_phase(LAS unsigned char* lds, const Gemm g, const Sched& S, const Epi& E) {
    const int tid = opaque_tid(), wid = __builtin_amdgcn_readfirstlane(tid >> 6), lane = tid & 63, wr = wid >> 2, wc = wid & 3, fr = lane & 15, fq = lane >> 4;
    const int K = g.K, nt = K / BK;
    unsigned voffA[2], voffB[2];
#pragma unroll
    for (int i = 0; i < 2; ++i) { int R, C; stage_rc(tid * 16 + i * 8192, R, C); const int Rb = (R & ~31) + perm32(R & 31);
        voffA[i] = (unsigned)(R * g.lda + C) * 2u; voffB[i] = (unsigned)(Rb * g.ldb + C) * 2u; }
    const size_t kstep = (size_t)(BK * 2);
    const size_t hstepA = (size_t)HALF * g.lda * 2, hstepB = (size_t)HALF * g.ldb * 2;
    const size_t tstepA = 2 * hstepA, tstepB = 2 * hstepB;
    const unsigned ldsw = (unsigned)wid * 1024u;
    const int aoff = lds_byte(wr * 64 + fr, fq * 8), boff = lds_byte(wc * 32 + fr, fq * 8);
#define PG8_SA(b, h) (((b) * 2 + (h)) * HTB)
#define PG8_SB(b, h) ((4 + (b) * 2 + (h)) * HTB)
#define PG8_STAGE(bufoff, gbase, voff) do { _Pragma("unroll") for (int _i = 0; _i < 2; ++_i) \
        __builtin_amdgcn_global_load_lds((const unsigned*)((const char*)(gbase) + (voff)[_i]), (LAS unsigned*)(lds + (bufoff) + ldsw + _i * 8192), 16, 0, 0); } while (0)
#define PG8_LDA(dst, b, h) do { _Pragma("unroll") for (int m = 0; m < 4; ++m) _Pragma("unroll") for (int k = 0; k < 2; ++k) dst[m][k] = *(const LAS bf16x8*)(lds + PG8_SA(b, h) + aoff + m * 2048 + k * 1024); } while (0)
#define PG8_LDB(dst, b, h) do { _Pragma("unroll") for (int n = 0; n < 2; ++n) _Pragma("unroll") for (int k = 0; k < 2; ++k) dst[n][k] = *(const LAS bf16x8*)(lds + PG8_SB(b, h) + boff + n * 2048 + k * 1024); } while (0)
#define PG8_MMA(ai, bj, At, Bt) do { __builtin_amdgcn_s_setprio(1); _Pragma("unroll") for (int m = 0; m < 4; ++m) _Pragma("unroll") for (int n = 0; n < 2; ++n) _Pragma("unroll") for (int k = 0; k < 2; ++k) \
        acc[ai][bj][m][n] = __builtin_amdgcn_mfma_f32_16x16x32_bf16(Bt[n][k], At[m][k], acc[ai][bj][m][n], 0, 0, 0); __builtin_amdgcn_s_setprio(0); } while (0)
#define PG8_WAIT_V(n) asm volatile("s_waitcnt vmcnt(" #n ")" ::: "memory")
#define PG8_WAIT_L(n) asm volatile("s_waitcnt lgkmcnt(" #n ")" ::: "memory")
#define PG8_BAR __builtin_amdgcn_s_barrier()
#define PG8_SCHED __builtin_amdgcn_sched_barrier(0)
    Unit cur, nxt; int ui = 0;
    if (!S.next(0, cur)) return;
    f32x4 acc[2][2][4][2];
#pragma unroll
    for (int a = 0; a < 2; ++a)
#pragma unroll
        for (int b = 0; b < 2; ++b)
#pragma unroll
            for (int m = 0; m < 4; ++m)
#pragma unroll
                for (int n = 0; n < 2; ++n) acc[a][b][m][n] = (f32x4){0.f, 0.f, 0.f, 0.f};
    bf16x8 At[4][2], B0[2][2], B1[2][2];
    const char* cA = (const char*)g.A + (size_t)cur.pm * tstepA; const char* cB = (const char*)g.Bt + (size_t)cur.pn * tstepB;
    PG8_STAGE(PG8_SB(0, 0), cB, voffB); PG8_STAGE(PG8_SB(0, 1), cB + hstepB, voffB); PG8_STAGE(PG8_SA(0, 0), cA, voffA); PG8_STAGE(PG8_SA(0, 1), cA + hstepA, voffA);
    if (wr == 1) PG8_BAR;
    PG8_WAIT_V(2); PG8_BAR;
    PG8_STAGE(PG8_SB(1, 0), cB + kstep, voffB); PG8_STAGE(PG8_SA(1, 0), cA + kstep, voffA); PG8_STAGE(PG8_SB(1, 1), cB + hstepB + kstep, voffB);
    PG8_WAIT_V(6); PG8_BAR;
    for (;;) {
        const bool has_next = S.next(ui + 1, nxt);
        const char* nA = has_next ? (const char*)g.A + (size_t)nxt.pm * tstepA : cA; const char* nB = has_next ? (const char*)g.Bt + (size_t)nxt.pn * tstepB : cB;
        for (int t = 0; t < nt; t += 2) {
            const bool last = (t == nt - 2);
            const char* a1 = cA + (size_t)(t + 1) * kstep;
            const char* a2 = last ? nA : cA + (size_t)(t + 2) * kstep; const char* b2 = last ? nB : cB + (size_t)(t + 2) * kstep;
            const char* a3 = a2 + kstep; const char* b3 = b2 + kstep;
            PG8_LDB(B0, 0, 0); PG8_LDB(B1, 0, 1); PG8_SCHED; PG8_LDA(At, 0, 0); PG8_STAGE(PG8_SA(1, 1), a1 + hstepA, voffA);
            PG8_WAIT_V(8); PG8_WAIT_L(0); PG8_BAR; PG8_MMA(0, 0, At, B0); PG8_MMA(0, 1, At, B1); PG8_BAR; PG8_SCHED;
            PG8_LDA(At, 0, 1); PG8_STAGE(PG8_SB(0, 0), b2, voffB); PG8_STAGE(PG8_SB(0, 1), b2 + hstepB, voffB); PG8_STAGE(PG8_SA(0, 0), a2, voffA);
            PG8_WAIT_V(8); PG8_WAIT_L(0); PG8_BAR; PG8_MMA(1, 0, At, B0); PG8_MMA(1, 1, At, B1); PG8_BAR; PG8_SCHED;
            PG8_LDB(B0, 1, 0); PG8_LDB(B1, 1, 1); PG8_SCHED; PG8_LDA(At, 1, 0); PG8_STAGE(PG8_SA(0, 1), a2 + hstepA, voffA);
            PG8_WAIT_V(8); PG8_WAIT_L(0); PG8_BAR; PG8_MMA(0, 0, At, B0); PG8_MMA(0, 1, At, B1); PG8_BAR; PG8_SCHED;
            PG8_LDA(At, 1, 1); PG8_STAGE(PG8_SB(1, 0), b3, voffB); PG8_STAGE(PG8_SB(1, 1), b3 + hstepB, voffB); PG8_STAGE(PG8_SA(1, 0), a3, voffA);
            PG8_WAIT_V(8); PG8_WAIT_L(0); PG8_BAR; PG8_MMA(1, 0, At, B0); PG8_MMA(1, 1, At, B1); PG8_BAR; PG8_SCHED;
        }
        if (wr == 0) PG8_BAR;
        { const int t2 = opaque_tid(); const int w2 = __builtin_amdgcn_readfirstlane(t2 >> 6); E(acc, cur, w2 >> 2, w2 & 3, t2 & 15, (t2 & 63) >> 4); }
        if (!has_next) break;
#pragma unroll
        for (int a = 0; a < 2; ++a)
#pragma unroll
            for (int b = 0; b < 2; ++b)
#pragma unroll
                for (int m = 0; m < 4; ++m)
#pragma unroll
                    for (int n = 0; n < 2; ++n) acc[a][b][m][n] = (f32x4){0.f, 0.f, 0.f, 0.f};
        cur = nxt; cA = nA; cB = nB; ++ui;
        if (wr == 1) PG8_BAR;
    }
    PG8_WAIT_V(0);
    PG8_BAR;
#undef PG8_SA
#undef PG8_SB
#undef PG8_STAGE
#undef PG8_LDA
#undef PG8_LDB
#undef PG8_MMA
#undef PG8_WAIT_V
#undef PG8_WAIT_L
#undef PG8_BAR
#undef PG8_SCHED
}
}

struct EInProj0 { bf16* PROJ; float* DT; float* outk; float* outv;
    __device__ __forceinline__ void operator()(int row, int col, f32x4 v0, f32x4 v1) const {
        if (col < 2816) {
            if (col >= PQ && col < PX) { v0 = v0 * 0.125f; v1 = v1 * 0.125f; }
            *(u32x4*)(PROJ + (size_t)row * PLD + col) = pack8(v0, v1);
            if (row < TC && col >= PK) { float* o = (col < PV) ? outk + (size_t)row * 512 + (col - PK) : outv + (size_t)row * 512 + (col - PV); *(f32x4*)o = v0; *(f32x4*)(o + 4) = v1; }
        } else if (col == 2816) { float* o = DT + (size_t)row * 8; *(f32x4*)o = v0; *(f32x4*)(o + 4) = v1; }
    } };
struct EResid { const float* xp; const float* xs; float* XR; const float* gate; int first;
    __device__ __forceinline__ void operator()(int row, int col, f32x4 v0, f32x4 v1) const {
        const float* g = gate + mod_row(row) * 6144 + col;
        const float* b = first ? (row < TC ? xp + (size_t)row * D : xs + (size_t)(row - TC) * D) + col : XR + (size_t)row * D + col;
        const f32x4 g0 = *(const f32x4*)g, g1 = *(const f32x4*)(g + 4), b0 = *(const f32x4*)b, b1 = *(const f32x4*)(b + 4);
        float* o = XR + (size_t)row * D + col; *(f32x4*)o = b0 + g0 * v0; *(f32x4*)(o + 4) = b1 + g1 * v1;
    } };
struct ESwiglu { bf16* G;
    __device__ __forceinline__ void operator()(int row, int col, f32x4 v0, f32x4 v1) const {
        u32x2 w; w.x = cvt_pk_bf16(silu_f(v0[0]) * v1[0], silu_f(v0[1]) * v1[1]); w.y = cvt_pk_bf16(silu_f(v0[2]) * v1[2], silu_f(v0[3]) * v1[3]);
        *(u32x2*)(G + (size_t)row * FF + (col >> 1)) = w;
    } };
struct EInProj1 { bf16* A2; bf16* ZTL; bf16* ZTC;
    __device__ __forceinline__ void operator()(int row, int col, f32x4 v0, f32x4 v1) const {
        if (col < 512) { const int g = col >> 4, cc = col & 15, ch = row >> 4, j = row & 15;
            *(u32x4*)(A2 + ((size_t)(g * 1536 + ch)) * 512 + j * 16 + cc) = pack8(v0, v1);
        } else { const int cs = (col - 512) >> 9, n = (col - 512) & 511; bf16* p; size_t st;
            if (row < TC) { const int b = row >> 8, l = row & 255; p = ZTC + ((size_t)(b * 512 + n)) * 512 + cs * 256 + l; st = 512; }
            else { const int r2 = row - TC, b = r2 >> 11, l = r2 & 2047; p = ZTL + ((size_t)(b * 512 + n)) * 4096 + cs * 2048 + l; st = 4096; }
#pragma unroll
            for (int e = 0; e < 4; ++e) { p[(size_t)e * st] = (bf16)f2bf(v0[e]); p[(size_t)(e + 4) * st] = (bf16)f2bf(v1[e]); }
        }
    } };
struct ESloc { float* S;
    __device__ __forceinline__ void operator()(int row, int col, f32x4 v0, f32x4 v1) const { float* o = S + (size_t)row * 256 + (col & 255); *(f32x4*)o = v0; *(f32x4*)(o + 4) = v1; } };
struct EY { bf16* G5;
    __device__ __forceinline__ void operator()(int row, int col, f32x4 v0, f32x4 v1) const {
        const int g = row / 1536, ch = row - g * 1536, c2 = col & 255, i = c2 >> 4, cc = c2 & 15;
        f32x4 a, b;
#pragma unroll
        for (int e = 0; e < 4; ++e) { a[e] = gelu_tanh(v0[e]); b[e] = gelu_tanh(v1[e]); }
        *(u32x4*)(G5 + (size_t)(ch * 16 + i) * 512 + g * 16 + cc) = pack8(a, b);
    } };
struct EGlu { const bf16* G5; const float* bias; bf16* MIX2;
    __device__ __forceinline__ void operator()(int row, int col, f32x4 v0, f32x4 v1) const {
        const u32x4 gr = *(const u32x4*)(G5 + (size_t)row * 512 + col); const f32x4 b0 = *(const f32x4*)(bias + col), b1 = *(const f32x4*)(bias + col + 4);
        f32x4 a, b;
        a[0] = bflo(gr.x) * sigmoid_f(v0[0] + b0[0]); a[1] = bfhi(gr.x) * sigmoid_f(v0[1] + b0[1]); a[2] = bflo(gr.y) * sigmoid_f(v0[2] + b0[2]); a[3] = bfhi(gr.y) * sigmoid_f(v0[3] + b0[3]);
        b[0] = bflo(gr.z) * sigmoid_f(v1[0] + b1[0]); b[1] = bfhi(gr.z) * sigmoid_f(v1[1] + b1[1]); b[2] = bflo(gr.w) * sigmoid_f(v1[2] + b1[2]); b[3] = bfhi(gr.w) * sigmoid_f(v1[3] + b1[3]);
        *(u32x4*)(MIX2 + (size_t)row * D + col) = pack8(a, b);
    } };
struct EFnetL { bf16* MIX2;
    __device__ __forceinline__ void operator()(int row, int col, f32x4 v0, f32x4 v1) const { const int b = col >> 9, n = col & 511; *(u32x4*)(MIX2 + (size_t)(TC + b * 2048 + row) * D + 512 + n) = pack8(v0, v1); } };
struct EFnetC { bf16* MIX2;
    __device__ __forceinline__ void operator()(int row, int col, f32x4 v0, f32x4 v1) const { const int b = col >> 9, n = col & 511; *(u32x4*)(MIX2 + (size_t)(b * 256 + row) * D + 512 + n) = pack8(v0, v1); } };

__device__ __forceinline__ int evin_dst(int n) {
    if (n < 512) return n;
    if (n < 1280) return n - 512 + PX;
    if (n < 1288) return n - 1280 + 2816;
    if (n < 1800) return n - 1288 + PQ;
    if (n < 2312) return n - 1800 + PK;
    return n - 2312 + PV;
}
template <int MODE> __device__ __forceinline__ int dst_row(int n) {
    if (MODE == 0) return n;
    if (MODE == 1) return evin_dst(n);
    if (MODE == 2) return 8 * (n >> 2) + (n & 3);
    return 8 * (n >> 2) + 4 + (n & 3);
}
template <int MODE> __device__ __forceinline__ void transpose_item(const float* W, int K, int N, int ldw, bf16* WT, float* scr, int item, int lane) {
    const int nblk = (N + 127) >> 7, kb = item / nblk, nb = item - kb * nblk, k0 = 32 * kb, n0 = 128 * nb;
    const int nn = n0 + 4 * (lane & 31); const bool ok = nn < N;
    f32x4 v[16];
#pragma unroll
    for (int i = 0; i < 16; ++i) { const int kk = 2 * i + (lane >> 5); v[i] = ok ? *(const f32x4*)(W + (size_t)(k0 + kk) * ldw + nn) : (f32x4){0.f, 0.f, 0.f, 0.f}; }
#pragma unroll
    for (int i = 0; i < 16; ++i) { const int kk = 2 * i + (lane >> 5); float* s = scr + kk * 129 + 4 * (lane & 31); s[0] = v[i][0]; s[1] = v[i][1]; s[2] = v[i][2]; s[3] = v[i][3]; }
    LDS_WAIT(); asm volatile("" ::: "memory");
#pragma unroll
    for (int j = 0; j < 2; ++j) { const int n = lane + 64 * j;
        if (n0 + n < N) { const float* s = scr + n; bf16* o = WT + (size_t)dst_row<MODE>(n0 + n) * K + k0;
#pragma unroll
            for (int q = 0; q < 4; ++q) { u32x4 w; w.x = pk2(s[(8 * q) * 129], s[(8 * q + 1) * 129]); w.y = pk2(s[(8 * q + 2) * 129], s[(8 * q + 3) * 129]); w.z = pk2(s[(8 * q + 4) * 129], s[(8 * q + 5) * 129]); w.w = pk2(s[(8 * q + 6) * 129], s[(8 * q + 7) * 129]);
                *(u32x4*)(o + 8 * q) = w; } } }
    LDS_WAIT(); asm volatile("" ::: "memory");
}
template <int MODE> __device__ __forceinline__ void transpose_all(const float* W, int K, int N, int ldw, bf16* WT, float* scr, int gw, int NGW, int lane) {
    const int nitems = (K >> 5) * ((N + 127) >> 7);
    for (int it = gw; it < nitems; it += NGW) transpose_item<MODE>(W, K, N, ldw, WT, scr, it, lane);
}
__device__ __forceinline__ void fold_item(const float* W, bf16* WT, float* scr, int item, int lane) {
    const int g = item >> 6, k0 = (item & 63) * 16;
    for (int i = 0; i < 16; ++i) scr[i * 65 + lane] = W[(size_t)(k0 + i) * 1024 + 512 + g * 64 + lane];
    scr[16 * 65 + lane] = cospif(lane * (1.f / 32.f)) * 0.125f; scr[16 * 65 + 64 + lane] = sinpif(lane * (1.f / 32.f)) * 0.125f;
    LDS_WAIT(); asm volatile("" ::: "memory");
    float ac[16], as[16];
#pragma unroll
    for (int kk = 0; kk < 16; ++kk) { ac[kk] = 0.f; as[kk] = 0.f; }
    for (int c = 0; c < 64; ++c) { const int idx = (c * lane) & 63; const float ct = scr[16 * 65 + idx], st = scr[16 * 65 + 64 + idx];
#pragma unroll
        for (int kk = 0; kk < 16; ++kk) { const float w = scr[kk * 65 + c]; ac[kk] += w * ct; as[kk] += w * st; } }
    bf16* oc = WT + (size_t)(512 + g * 64 + lane) * 1024 + k0; bf16* os = WT + (size_t)(1024 + g * 64 + lane) * 1024 + k0;
#pragma unroll
    for (int q = 0; q < 2; ++q) {
        u32x4 a, b; a.x = pk2(ac[8 * q], ac[8 * q + 1]); a.y = pk2(ac[8 * q + 2], ac[8 * q + 3]); a.z = pk2(ac[8 * q + 4], ac[8 * q + 5]); a.w = pk2(ac[8 * q + 6], ac[8 * q + 7]);
        b.x = pk2(as[8 * q], as[8 * q + 1]); b.y = pk2(as[8 * q + 2], as[8 * q + 3]); b.z = pk2(as[8 * q + 4], as[8 * q + 5]); b.w = pk2(as[8 * q + 6], as[8 * q + 7]);
        *(u32x4*)(oc + 8 * q) = a; *(u32x4*)(os + 8 * q) = b; }
    LDS_WAIT(); asm volatile("" ::: "memory");
}
__device__ __forceinline__ void cpow(float lre, float lim, float step, float e, float& re, float& im) {
    const float mag = __expf(e * lre * step); float tr = e * (lim * step * 0.15915494309189535f); tr -= floorf(tr);
    re = mag * cospif(2.f * tr); im = mag * sinpif(2.f * tr);
}
__device__ __forceinline__ void s5_k(float lre, float lim, float step, float& kr, float& ki) {
    const float zr = lre * step, zi = lim * step;
    if (zr * zr + zi * zi < 0.01f) {
        float pr = 1.f, pi = 0.f, sr = 1.f, si = 0.f; const float inv[4] = {0.5f, 1.f / 6.f, 1.f / 24.f, 1.f / 120.f};
#pragma unroll
        for (int q = 0; q < 4; ++q) { const float nr = pr * zr - pi * zi, ni = pr * zi + pi * zr; pr = nr; pi = ni; sr += pr * inv[q]; si += pi * inv[q]; }
        kr = step * sr; ki = step * si;
    } else { float ar, ai; cpow(lre, lim, step, 1.f, ar, ai); ar -= 1.f; const float den = lre * lre + lim * lim; kr = (ar * lre + ai * lim) / den; ki = (ai * lre - ar * lim) / den; }
}

__device__ __forceinline__ void prologue(const Args& A, unsigned char* lds) {
    const int tid = opaque_tid(), lane = tid & 63, wave = tid >> 6, G = gridDim.x;
    const int gw = blockIdx.x * 8 + wave, NGW = G * 8;
    const int gt = blockIdx.x * 512 + tid, NGT = G * 512;
    unsigned char* ws = A.ws;
    float* scr = (float*)(lds + wave * 17408);
    for (int item = blockIdx.x; item < 384; item += G) {
        const int layer = item / 192, rem = item - layer * 192, n0 = (rem >> 2) * 128, kq = rem & 3;
        float* sc = (float*)lds;
        float* red = (float*)(lds + 9216);
        __syncthreads();
        for (int i = tid; i < 9 * 256; i += 512) { const int r = i >> 8, k = kq * 256 + (i & 255); const float v = r == 0 ? A.in[7][k] : A.in[6][(r - 1) * 1024 + k]; sc[i] = silu_f(v); }
        const float* W = A.in[8] + ((size_t)layer * 1024 + kq * 256 + wave * 32) * 6144 + n0 + 2 * lane;
        float wx[32], wy[32];
#pragma unroll
        for (int u = 0; u < 32; ++u) { const float* p = W + (size_t)u * 6144; wx[u] = p[0]; wy[u] = p[1]; }
        __syncthreads();
        float ax[9], ay[9];
#pragma unroll
        for (int r = 0; r < 9; ++r) { ax[r] = 0.f; ay[r] = 0.f; }
#pragma unroll
        for (int u = 0; u < 32; ++u)
#pragma unroll
            for (int r = 0; r < 9; ++r) { const float s = sc[r * 256 + wave * 32 + u]; ax[r] += s * wx[u]; ay[r] += s * wy[u]; }
#pragma unroll
        for (int r = 0; r < 9; ++r) { red[(wave * 9 + r) * 128 + 2 * lane] = ax[r]; red[(wave * 9 + r) * 128 + 2 * lane + 1] = ay[r]; }
        __syncthreads();
        for (int i = tid; i < 9 * 128; i += 512) { const int r = i >> 7, l = i & 127; float s = kq == 0 ? A.in[9][layer * 6144 + n0 + l] : 0.f;
#pragma unroll
            for (int w = 0; w < 8; ++w) s += red[(w * 9 + r) * 128 + l];
            atomicAdd(((float*)(ws + WS_MODV)) + (layer * 9 + r) * 6144 + n0 + l, s); }
    }
    __syncthreads();
    transpose_all<1>(A.in[16], 1024, 2824, 2824, (bf16*)(ws + WS_WEVIN), scr, gw, NGW, lane);
    transpose_all<0>(A.in[24], 1024, 1024, 1024, (bf16*)(ws + WS_WEVOUT), scr, gw, NGW, lane);
    transpose_all<0>(A.in[25], 1024, 512, 1024, (bf16*)(ws + WS_WODIN), scr, gw, NGW, lane);
    transpose_all<0>(A.in[36], 1024, 1024, 1024, (bf16*)(ws + WS_WODOUT), scr, gw, NGW, lane);
    transpose_all<0>(A.in[34], 512, 512, 512, (bf16*)(ws + WS_WGLU), scr, gw, NGW, lane);
    transpose_all<2>(A.in[12], 1024, 2816, 2816, (bf16*)(ws + WS_WFUP), scr, gw, NGW, lane);
    transpose_all<3>(A.in[13], 1024, 2816, 2816, (bf16*)(ws + WS_WFUP), scr, gw, NGW, lane);
    transpose_all<0>(A.in[14], 2816, 1024, 1024, (bf16*)(ws + WS_WFDN), scr, gw, NGW, lane);
    for (int it = gw; it < 512; it += NGW) fold_item(A.in[25], (bf16*)(ws + WS_WODIN), scr, it, lane);
    { u32x4* z = (u32x4*)(ws + WS_WEVIN + (size_t)2824 * 1024 * 2); const int n16 = 248 * 1024 * 2 / 16; for (int i = gt; i < n16; i += NGT) z[i] = (u32x4){0u, 0u, 0u, 0u}; }
    { bf16* DL = (bf16*)(ws + WS_DFTL); const float sc = 0.02209708691207961f;
      for (int i = gt; i < 2048 * 256; i += NGT) { const int k = i >> 8, l0 = (i & 255) * 8; float c[8], s[8];
#pragma unroll
        for (int e = 0; e < 8; ++e) { const int m = (k * (l0 + e)) & 2047; const float x = m * (1.f / 1024.f); c[e] = cospif(x) * sc; s[e] = -sinpif(x) * sc; }
        u32x4 a, b; a.x = pk2(c[0], c[1]); a.y = pk2(c[2], c[3]); a.z = pk2(c[4], c[5]); a.w = pk2(c[6], c[7]); b.x = pk2(s[0], s[1]); b.y = pk2(s[2], s[3]); b.z = pk2(s[4], s[5]); b.w = pk2(s[6], s[7]);
        *(u32x4*)(DL + (size_t)k * 4096 + l0) = a; *(u32x4*)(DL + (size_t)k * 4096 + 2048 + l0) = b; }
      bf16* DC = (bf16*)(ws + WS_DFTC); const float sc2 = 0.0625f;
      for (int i = gt; i < 256 * 32; i += NGT) { const int k = i >> 5, l0 = (i & 31) * 8; float c[8], s[8];
#pragma unroll
        for (int e = 0; e < 8; ++e) { const int m = (k * (l0 + e)) & 255; const float x = m * (1.f / 128.f); c[e] = cospif(x) * sc2; s[e] = -sinpif(x) * sc2; }
        u32x4 a, b; a.x = pk2(c[0], c[1]); a.y = pk2(c[2], c[3]); a.z = pk2(c[4], c[5]); a.w = pk2(c[6], c[7]); b.x = pk2(s[0], s[1]); b.y = pk2(s[2], s[3]); b.z = pk2(s[4], s[5]); b.w = pk2(s[6], s[7]);
        *(u32x4*)(DC + (size_t)k * 512 + l0) = a; *(u32x4*)(DC + (size_t)k * 512 + 256 + l0) = b; } }
    { const float* lamr = A.in[26]; const float* lami = A.in[27]; const float* lstep = A.in[28];
      const float* bre = A.in[29]; const float* bim = A.in[30]; const float* cre = A.in[31]; const float* cim = A.in[32]; const float* dsk = A.in[33];
      bf16* WY = (bf16*)(ws + WS_WWY); bf16* BS = (bf16*)(ws + WS_WBS);
      { float* Qr = (float*)lds; float* Qi = Qr + 2048; float* Tt = Qi + 2048;
        for (int item = blockIdx.x; item < 512; item += G) {
          const int g = item >> 4, tau = item & 15;
          __syncthreads();
#pragma unroll
          for (int q = 0; q < 4; ++q) { const int e = tid + 512 * q, d = e >> 10, p = (e >> 4) & 63, cp = e & 15;
              const float step = __expf(lstep[d * 32 + g]); const float lre = lamr[(d * 32 + g) * 64 + p], lim = lami[(d * 32 + g) * 64 + p];
              float kr, ki; s5_k(lre, lim, step, kr, ki); float pr, pi; cpow(lre, lim, step, (float)tau, pr, pi);
              const float br = bre[(g * 64 + p) * 16 + cp], bi = bim[(g * 64 + p) * 16 + cp];
              const float tbr = kr * br - ki * bi, tbi = kr * bi + ki * br;
              Qr[e] = pr * tbr - pi * tbi; Qi[e] = pr * tbi + pi * tbr; }
          __syncthreads();
          { const int d = tid >> 8, c = (tid >> 4) & 15, cp = tid & 15; float acc = 0.f;
            for (int p = 0; p < 64; ++p) acc += cre[(g * 16 + c) * 64 + p] * Qr[(d * 64 + p) * 16 + cp] - cim[(g * 16 + c) * 64 + p] * Qi[(d * 64 + p) * 16 + cp];
            Tt[tid] = acc; }
          __syncthreads();
          if (tid < 256) { const int c = tid >> 4, cp = tid & 15; const float t0 = Tt[tid], t1 = Tt[256 + tid];
              bf16* base = WY + (size_t)g * 256 * 512;
              if (tau == 0) { const float v = t0 + t1 + (c == cp ? dsk[g * 16 + c] : 0.f); for (int ii = 0; ii < 16; ++ii) base[(size_t)(ii * 16 + c) * 512 + ii * 16 + cp] = (bf16)f2bf(v); }
              else { for (int ii = tau; ii < 16; ++ii) base[(size_t)(ii * 16 + c) * 512 + (ii - tau) * 16 + cp] = (bf16)f2bf(t0);
                     for (int ii = 0; ii < 16 - tau; ++ii) base[(size_t)(ii * 16 + c) * 512 + (ii + tau) * 16 + cp] = (bf16)f2bf(t1); } }
        }
        __syncthreads(); }
      for (int i = gt; i < 32 * 16 * 16 * 128; i += NGT) {
          const int p = i & 63, d = (i >> 6) & 1, c = (i >> 7) & 15, ii = (i >> 11) & 15, g = i >> 15;
          const float step = __expf(lstep[d * 32 + g]); const float lre = lamr[(d * 32 + g) * 64 + p], lim = lami[(d * 32 + g) * 64 + p];
          float pr, pi; cpow(lre, lim, step, d == 0 ? (float)(ii + 1) : (float)(16 - ii), pr, pi);
          const float cr = cre[(g * 16 + c) * 64 + p], ci = cim[(g * 16 + c) * 64 + p];
          const float vr = cr * pr - ci * pi, vi = cr * pi + ci * pr;
          bf16* rowp = WY + ((size_t)g * 256 + ii * 16 + c) * 512 + 256 + d * 128;
          rowp[p] = (bf16)f2bf(vr); rowp[64 + p] = (bf16)f2bf(-vi);
      }
      for (int i = gt; i < 32 * 2 * 64 * 256; i += NGT) {
          const int cp = i & 15, j = (i >> 4) & 15, p = (i >> 8) & 63, d = (i >> 14) & 1, g = i >> 15;
          const float step = __expf(lstep[d * 32 + g]); const float lre = lamr[(d * 32 + g) * 64 + p], lim = lami[(d * 32 + g) * 64 + p];
          float kr, ki; s5_k(lre, lim, step, kr, ki); float pr, pi; cpow(lre, lim, step, d == 0 ? (float)(15 - j) : (float)j, pr, pi);
          const float br = bre[(g * 64 + p) * 16 + cp], bi = bim[(g * 64 + p) * 16 + cp];
          const float tbr = kr * br - ki * bi, tbi = kr * bi + ki * br;
          bf16* o = BS + ((size_t)g * 256 + d * 128 + p) * 256 + j * 16 + cp;
          o[0] = (bf16)f2bf(pr * tbr - pi * tbi); o[(size_t)64 * 256] = (bf16)f2bf(pr * tbi + pi * tbr);
      }
    }
}

__device__ __forceinline__ void norm_phase(const float* xp, const float* xs, const float* XR, int first, const float* gam, const float* shift, const float* scale, bf16* H) {
    const int tid_ = opaque_tid(); const int lane = tid_ & 63, gw = blockIdx.x * 8 + (tid_ >> 6), NGW = gridDim.x * 8;
    for (int row = gw; row < T; row += NGW) {
        const float* xr = first ? (row < TC ? xp + (size_t)row * D : xs + (size_t)(row - TC) * D) : XR + (size_t)row * D;
        f32x4 v[4]; float s = 0.f;
#pragma unroll
        for (int j = 0; j < 4; ++j) { v[j] = *(const f32x4*)(xr + 4 * lane + 256 * j); s += (v[j][0] * v[j][0] + v[j][1] * v[j][1]) + (v[j][2] * v[j][2] + v[j][3] * v[j][3]); }
        const float rstd = rsqrtf(wave_sum(s) * (1.f / D) + 1e-6f);
        const int mr = mod_row(row);
#pragma unroll
        for (int j = 0; j < 4; ++j) { const int c = 4 * lane + 256 * j; const f32x4 g = *(const f32x4*)(gam + c), sh = *(const f32x4*)(shift + mr * 6144 + c), sc = *(const f32x4*)(scale + mr * 6144 + c);
            const f32x4 y = v[j] * rstd * g * (sc + 1.f) + sh; u32x2 w; w.x = cvt_pk_bf16(y[0], y[1]); w.y = cvt_pk_bf16(y[2], y[3]); *(u32x2*)(H + (size_t)row * D + c) = w; }
    }
}
__device__ __forceinline__ void final_norm_phase(float* XR, const float* gam) {
    const int tid_ = opaque_tid(); const int lane = tid_ & 63, gw = blockIdx.x * 8 + (tid_ >> 6), NGW = gridDim.x * 8;
    for (int row = gw; row < T; row += NGW) {
        float* xr = XR + (size_t)row * D; f32x4 v[4]; float s = 0.f;
#pragma unroll
        for (int j = 0; j < 4; ++j) { v[j] = *(const f32x4*)(xr + 4 * lane + 256 * j); s += (v[j][0] * v[j][0] + v[j][1] * v[j][1]) + (v[j][2] * v[j][2] + v[j][3] * v[j][3]); }
        const float rstd = rsqrtf(wave_sum(s) * (1.f / D) + 1e-6f);
#pragma unroll
        for (int j = 0; j < 4; ++j) { const int c = 4 * lane + 256 * j; const f32x4 g = *(const f32x4*)(gam + c); *(f32x4*)(xr + c) = v[j] * rstd * g; }
    }
}
__device__ __forceinline__ void gate_phase(const bf16* YD, bf16* PROJ, const float* gam) {
    const int tid_ = opaque_tid(); const int lane = tid_ & 63, gw = blockIdx.x * 8 + (tid_ >> 6), NGW = gridDim.x * 8;
    for (int row = gw; row < T; row += NGW) {
        const u32x4 a = *(const u32x4*)(YD + (size_t)row * 512 + 8 * lane), b = *(const u32x4*)(YD + ((size_t)T + row) * 512 + 8 * lane), z = *(const u32x4*)(PROJ + (size_t)row * PLD + 8 * lane);
        float y[8];
        y[0] = (bflo(a.x) + bflo(b.x)) * silu_f(bflo(z.x)); y[1] = (bfhi(a.x) + bfhi(b.x)) * silu_f(bfhi(z.x));
        y[2] = (bflo(a.y) + bflo(b.y)) * silu_f(bflo(z.y)); y[3] = (bfhi(a.y) + bfhi(b.y)) * silu_f(bfhi(z.y));
        y[4] = (bflo(a.z) + bflo(b.z)) * silu_f(bflo(z.z)); y[5] = (bfhi(a.z) + bfhi(b.z)) * silu_f(bfhi(z.z));
        y[6] = (bflo(a.w) + bflo(b.w)) * silu_f(bflo(z.w)); y[7] = (bfhi(a.w) + bfhi(b.w)) * silu_f(bfhi(z.w));
        float s = 0.f;
#pragma unroll
        for (int e = 0; e < 8; ++e) s += y[e] * y[e];
        const float rstd = rsqrtf(wave_sum(s) * (1.f / 512.f) + 1e-6f);
        const f32x4 g0 = *(const f32x4*)(gam + 8 * lane), g1 = *(const f32x4*)(gam + 8 * lane + 4);
        u32x4 o; o.x = cvt_pk_bf16(y[0] * rstd * g0[0], y[1] * rstd * g0[1]); o.y = cvt_pk_bf16(y[2] * rstd * g0[2], y[3] * rstd * g0[3]);
        o.z = cvt_pk_bf16(y[4] * rstd * g1[0], y[5] * rstd * g1[1]); o.w = cvt_pk_bf16(y[6] * rstd * g1[2], y[7] * rstd * g1[3]);
        *(u32x4*)(PROJ + (size_t)row * PLD + 8 * lane) = o;
    }
}

__device__ __forceinline__ void ssd_item(const Args& A, unsigned char* lds, int item) {
    const int tid = opaque_tid(), lane = tid & 63, w = __builtin_amdgcn_readfirstlane(tid >> 6), fr = lane & 15, fq = lane >> 4;
    int seq, dir, h, L, tok0, nch; bool lat;
    if (item < 128) { lat = true; seq = item >> 4; dir = (item >> 3) & 1; h = item & 7; L = 2048; tok0 = TC + seq * 2048; nch = 16; }
    else { const int it = item - 128; lat = false; seq = it >> 4; dir = (it >> 3) & 1; h = it & 7; L = 256; tok0 = seq * 256; nch = 2; }
    const int g = h >> 2;
    bf16* Cm = (bf16*)lds; bf16* Bm = Cm + 128 * 72; bf16* XT = Bm + 128 * 72; bf16* BT = XT + 64 * 136; bf16* Mm = BT + 64 * 136; bf16* ST = Mm + 128 * 136;
    float* cum = (float*)(ST + 64 * 72); float* dtv = cum + 128; float* da = dtv + 128;
    const bf16* PROJ = (const bf16*)(A.ws + WS_R2); const float* DT = (const float*)(A.ws + WS_DT); bf16* YD = (bf16*)(A.ws + WS_R1);
    const float* convw = A.in[17]; const float* convb = A.in[18];
    const int pt = w >> 1, nt0 = 2 * (w & 1);
    f32x4 st[2];
#pragma unroll
    for (int q = 0; q < 2; ++q)
#pragma unroll
        for (int r = 0; r < 4; ++r) { const int p = 16 * pt + 4 * fq + r, n = 16 * (nt0 + q) + fr; st[q][r] = lat ? A.in[4][(size_t)((seq * 2 + dir) * 8 + h) * 4096 + p * 64 + n] : 0.f; }
    const float Aneg = -__expf(A.in[19][dir * 8 + h]); const float dtb = A.in[20][dir * 8 + h]; const float Dh = A.in[21][h];
    float* cwl = da + 128;
    for (int i = tid; i < 6 * 192; i += 512) { const int wv = i / 192, cc = i - wv * 192; const int ch = cc < 64 ? h * 64 + cc : (cc < 128 ? 512 + g * 64 + (cc - 64) : 640 + g * 64 + (cc - 128));
        cwl[i] = wv < 5 ? convw[wv * 768 + ch] : convb[ch]; }
    for (int c = 0; c < nch; ++c) {
        int tl = tid; asm volatile("" : "+v"(tl));
        float dav = 0.f;
        if (tid < 128) { const int j = tid; const int t = dir ? (L - 1 - (c * 128 + j)) : (c * 128 + j); const float x = DT[(size_t)(tok0 + t) * 8 + h] + dtb; const float dt = x > 20.f ? x : log1pf(__expf(x)); dtv[j] = dt; dav = dt * Aneg;
#pragma unroll
            for (int o = 1; o < 64; o <<= 1) { const float tv = __shfl_up(dav, o); if (lane >= o) dav += tv; }
            if (tid == 63) da[0] = dav; }
#pragma unroll
        for (int q = 0; q < 2; ++q)
#pragma unroll
            for (int r = 0; r < 4; ++r) ST[(16 * pt + 4 * fq + r) * 72 + 16 * (nt0 + q) + fr] = (bf16)f2bf(st[q][r]);
        u32x4 raw[2][5];
#define SSD_ISSUE(B0) do { _Pragma("unroll") for (int it = 0; it < 2; ++it) { const int idx = tl + 512 * (it + (B0)); const int j = idx / 24, cgp = idx - j * 24; const int t = dir ? (L - 1 - (c * 128 + j)) : (c * 128 + j); \
            const int ch = cgp < 8 ? h * 64 + cgp * 8 : (cgp < 16 ? 512 + g * 64 + (cgp - 8) * 8 : 640 + g * 64 + (cgp - 16) * 8); \
            _Pragma("unroll") for (int wv = 0; wv < 5; ++wv) { const int tt = min(max(t + wv - 2, 0), L - 1); raw[it][wv] = *(const u32x4*)(PROJ + (size_t)(tok0 + tt) * PLD + PX + ch); } } } while (0)
        SSD_ISSUE(0);
        __syncthreads();
        if (tid < 128) { if (tid >= 64) dav += da[0]; cum[tid] = dav; }
        __syncthreads();
        const float cl = cum[127];
        for (int bt = 0; bt < 3; ++bt) {
#pragma unroll
        for (int it = 0; it < 2; ++it) { const int idx = tl + 512 * (it + 2 * bt); const int j = idx / 24, cgp = idx - j * 24; const int t = dir ? (L - 1 - (c * 128 + j)) : (c * 128 + j);
            const int cc0 = cgp * 8;
            float acc[8];
            { const f32x4 b0 = *(const f32x4*)(cwl + 5 * 192 + cc0), b1 = *(const f32x4*)(cwl + 5 * 192 + cc0 + 4); acc[0] = b0[0]; acc[1] = b0[1]; acc[2] = b0[2]; acc[3] = b0[3]; acc[4] = b1[0]; acc[5] = b1[1]; acc[6] = b1[2]; acc[7] = b1[3]; }
#pragma unroll
            for (int wv = 0; wv < 5; ++wv) { const int tt = t + wv - 2; const float mk = (tt >= 0 && tt < L) ? 1.f : 0.f; const u32x4 rw = raw[it][wv];
                const f32x4 w0 = *(const f32x4*)(cwl + wv * 192 + cc0) * mk, w1 = *(const f32x4*)(cwl + wv * 192 + cc0 + 4) * mk;
                acc[0] += w0[0] * bflo(rw.x); acc[1] += w0[1] * bfhi(rw.x); acc[2] += w0[2] * bflo(rw.y); acc[3] += w0[3] * bfhi(rw.y);
                acc[4] += w1[0] * bflo(rw.z); acc[5] += w1[1] * bfhi(rw.z); acc[6] += w1[2] * bflo(rw.w); acc[7] += w1[3] * bfhi(rw.w); }
#pragma unroll
            for (int e = 0; e < 8; ++e) acc[e] = silu_f(acc[e]);
            if (cgp < 8) { const float dt = dtv[j];
#pragma unroll
                for (int e = 0; e < 8; ++e) XT[(cgp * 8 + e) * 136 + j] = (bf16)f2bf(acc[e] * dt); }
            else if (cgp < 16) { const float te = __expf(cl - cum[j]); const int n0 = (cgp - 8) * 8;
                u32x4 o; o.x = pk2(acc[0], acc[1]); o.y = pk2(acc[2], acc[3]); o.z = pk2(acc[4], acc[5]); o.w = pk2(acc[6], acc[7]); *(u32x4*)(Bm + j * 72 + n0) = o;
#pragma unroll
                for (int e = 0; e < 8; ++e) BT[(n0 + e) * 136 + j] = (bf16)f2bf(acc[e] * te); }
            else { const int n0 = (cgp - 16) * 8; u32x4 o; o.x = pk2(acc[0], acc[1]); o.y = pk2(acc[2], acc[3]); o.z = pk2(acc[4], acc[5]); o.w = pk2(acc[6], acc[7]); *(u32x4*)(Cm + j * 72 + n0) = o; }
        }
        if (bt < 2) SSD_ISSUE(2 * bt + 2);
        }
#undef SSD_ISSUE
        __syncthreads();
        {
            const bf16x8 af0 = ldfrag(Cm + 16 * w * 72, 72, lane, 0), af1 = ldfrag(Cm + 16 * w * 72, 72, lane, 1);
            for (int jt = 0; jt < 8; ++jt) { f32x4 acc = (f32x4){0.f, 0.f, 0.f, 0.f};
                acc = mma16(af0, ldfrag(Bm + 16 * jt * 72, 72, lane, 0), acc); acc = mma16(af1, ldfrag(Bm + 16 * jt * 72, 72, lane, 1), acc);
#pragma unroll
                for (int r = 0; r < 4; ++r) { const int i = 16 * w + 4 * fq + r, j = 16 * jt + fr; float v = (j <= i) ? acc[r] * __expf(cum[i] - cum[j]) : 0.f; if (dir == 0 && i == j) v += Dh / dtv[i]; Mm[i * 136 + j] = (bf16)f2bf(v); } }
        }
        __syncthreads();
        {
            f32x4 yd[4], yo[4];
#pragma unroll
            for (int q = 0; q < 4; ++q) { yd[q] = (f32x4){0.f, 0.f, 0.f, 0.f}; yo[q] = (f32x4){0.f, 0.f, 0.f, 0.f}; }
#pragma unroll
            for (int ks = 0; ks < 4; ++ks) { if (32 * ks <= 16 * w + 15) { const bf16x8 am = ldfrag(Mm + 16 * w * 136, 136, lane, ks);
#pragma unroll
                for (int q = 0; q < 4; ++q) yd[q] = mma16(am, ldfrag(XT + 16 * q * 136, 136, lane, ks), yd[q]); } }
#pragma unroll
            for (int ks = 0; ks < 2; ++ks) { const bf16x8 ac = ldfrag(Cm + 16 * w * 72, 72, lane, ks);
#pragma unroll
                for (int q = 0; q < 4; ++q) yo[q] = mma16(ac, ldfrag(ST + 16 * q * 72, 72, lane, ks), yo[q]); }
#pragma unroll
            for (int r = 0; r < 4; ++r) { const int i = 16 * w + 4 * fq + r; const float ec = __expf(cum[i]); const int t = dir ? (L - 1 - (c * 128 + i)) : (c * 128 + i);
                bf16* yp = YD + ((size_t)dir * T + tok0 + t) * 512 + h * 64 + fr;
#pragma unroll
                for (int q = 0; q < 4; ++q) yp[16 * q] = (bf16)f2bf(yd[q][r] + ec * yo[q][r]); }
        }
        {
            const float cd = __expf(cl);
#pragma unroll
            for (int q = 0; q < 2; ++q) st[q] = st[q] * cd;
#pragma unroll
            for (int ks = 0; ks < 4; ++ks) { const bf16x8 ax = ldfrag(XT + 16 * pt * 136, 136, lane, ks);
#pragma unroll
                for (int q = 0; q < 2; ++q) st[q] = mma16(ax, ldfrag(BT + 16 * (nt0 + q) * 136, 136, lane, ks), st[q]); }
        }
        __syncthreads();
    }
    if (!lat) {
#pragma unroll
        for (int q = 0; q < 2; ++q)
#pragma unroll
            for (int r = 0; r < 4; ++r) { const int p = 16 * pt + 4 * fq + r, n = 16 * (nt0 + q) + fr; A.out[O_SSD + (size_t)((seq * 2 + dir) * 8 + h) * 4096 + p * 64 + n] = st[q][r]; }
    }
}

template <int CTRL> __device__ __forceinline__ float dpp_f(float v) { return __builtin_bit_cast(float, __builtin_amdgcn_update_dpp(0, __builtin_bit_cast(int, v), CTRL, 0xF, 0xF, true)); }
__device__ __forceinline__ float red16_max(float v) { v = fmaxf(v, dpp_f<0xB1>(v)); v = fmaxf(v, dpp_f<0x4E>(v)); v = fmaxf(v, dpp_f<0x141>(v)); v = fmaxf(v, dpp_f<0x140>(v)); return v; }
__device__ __forceinline__ float red16_sum(float v) { v += dpp_f<0xB1>(v); v += dpp_f<0x4E>(v); v += dpp_f<0x141>(v); v += dpp_f<0x140>(v); return v; }
__device__ __forceinline__ void attn_pair(const Args& A, unsigned char* lds, int pairidx) {
    const int tid = opaque_tid(), half = __builtin_amdgcn_readfirstlane(tid >> 8), ht = tid & 255, lane = tid & 63, w = __builtin_amdgcn_readfirstlane((tid >> 6) & 3), fr = lane & 15, fq = lane >> 4;
    unsigned char* hl = lds + half * 49152;
    bf16* Ksb = (bf16*)hl; bf16* Vtb = Ksb + 2 * 64 * 72; bf16* Ps = Vtb + 2 * 64 * 72 + w * 16 * 72; float* rp = (float*)(hl + 46080);
    bf16* PROJ = (bf16*)(A.ws + WS_R2);
    const int item = pairidx * 2 + half;
    const bool lat = item < 2048;
    int b, h, r = 0, rs = 0, qtok0, ntiles;
    if (lat) { b = item >> 8; h = (item >> 5) & 7; r = item & 31; qtok0 = TC + b * 2048 + r * 64; rs = min(max(r - 4, 0), 24); ntiles = 12; }
    else { const int it = item - 2048; b = it >> 5; h = (it >> 2) & 7; const int qb = it & 3; qtok0 = b * 256 + qb * 64; ntiles = 4; }
    for (int i = ht; i < 465; i += 256) rp[i] = A.in[23][h * 465 + i];
    bf16x8 qf[2];
    { const bf16* qp = PROJ + (size_t)(qtok0 + 16 * w + fr) * PLD + PQ + h * 64 + fq * 8; qf[0] = *(const bf16x8*)qp; qf[1] = *(const bf16x8*)(qp + 32); }
    f32x4 o[4]; float m[4], l[4];
#pragma unroll
    for (int q = 0; q < 4; ++q) { o[q] = (f32x4){0.f, 0.f, 0.f, 0.f}; m[q] = -1e30f; l[q] = 0.f; }
    f32x4 pf[2][4];
#define ATT_PREFETCH(TI) do { _Pragma("unroll") for (int u_ = 0; u_ < 2; ++u_) { const int idx_ = ht + 256 * u_; const int key_ = idx_ >> 3, dc_ = idx_ & 7; \
        if (lat && (TI) >= 8) { const size_t off_ = (((size_t)b * 256 + ((TI) - 8) * 64 + key_) * 8 + h) * 64 + dc_ * 8; \
            pf[u_][0] = *(const f32x4*)(A.in[2] + off_); pf[u_][1] = *(const f32x4*)(A.in[2] + off_ + 4); pf[u_][2] = *(const f32x4*)(A.in[3] + off_); pf[u_][3] = *(const f32x4*)(A.in[3] + off_ + 4); } \
        else { const size_t tok_ = lat ? (size_t)(TC + b * 2048 + (rs + (TI)) * 64 + key_) : (size_t)(b * 256 + (TI) * 64 + key_); \
            pf[u_][0] = *(const f32x4*)(PROJ + tok_ * PLD + PK + h * 64 + dc_ * 8); pf[u_][1] = *(const f32x4*)(PROJ + tok_ * PLD + PV + h * 64 + dc_ * 8); } } } while (0)
    ATT_PREFETCH(0);
    for (int ti = 0; ti < ntiles; ++ti) {
        bf16* Ks = Ksb + (ti & 1) * 64 * 72; bf16* Vt = Vtb + (ti & 1) * 64 * 72;
#pragma unroll
        for (int u = 0; u < 2; ++u) { const int idx = ht + 256 * u; const int key = idx >> 3, dc = idx & 7; u32x4 kv, vv;
            if (lat && ti >= 8) { kv.x = pk2(pf[u][0][0], pf[u][0][1]); kv.y = pk2(pf[u][0][2], pf[u][0][3]); kv.z = pk2(pf[u][1][0], pf[u][1][1]); kv.w = pk2(pf[u][1][2], pf[u][1][3]);
                vv.x = pk2(pf[u][2][0], pf[u][2][1]); vv.y = pk2(pf[u][2][2], pf[u][2][3]); vv.z = pk2(pf[u][3][0], pf[u][3][1]); vv.w = pk2(pf[u][3][2], pf[u][3][3]); }
            else { kv = __builtin_bit_cast(u32x4, pf[u][0]); vv = __builtin_bit_cast(u32x4, pf[u][1]); }
            *(u32x4*)(Ks + key * 72 + dc * 8) = kv;
            bf16* vt = Vt + (dc * 8) * 72 + key;
            vt[0] = (bf16)(vv.x & 0xffff); vt[72] = (bf16)(vv.x >> 16); vt[144] = (bf16)(vv.y & 0xffff); vt[216] = (bf16)(vv.y >> 16);
            vt[288] = (bf16)(vv.z & 0xffff); vt[360] = (bf16)(vv.z >> 16); vt[432] = (bf16)(vv.w & 0xffff); vt[504] = (bf16)(vv.w >> 16); }
        if (ti + 1 < ntiles) ATT_PREFETCH(ti + 1);
        __syncthreads();
        f32x4 s[4];
#pragma unroll
        for (int t = 0; t < 4; ++t) { s[t] = (f32x4){0.f, 0.f, 0.f, 0.f};
#pragma unroll
            for (int ks = 0; ks < 2; ++ks) s[t] = mma16(qf[ks], ldfrag(Ks + 16 * t * 72, 72, lane, ks), s[t]); }
        if (lat && ti < 8) { const int dr = rs + ti - r + 7;
#pragma unroll
            for (int t = 0; t < 4; ++t)
#pragma unroll
                for (int rr = 0; rr < 4; ++rr) { const int qc = 16 * w + 4 * fq + rr, kc = 16 * t + fr; const int cs = min(max(qc - 8, 0), 48); const bool ok = (kc >= cs) && (kc < cs + 16);
                    const int bi = min(max(kc - qc + 15, 0), 30); s[t][rr] = ok ? s[t][rr] + rp[dr * 31 + bi] : -1e30f; } }
#pragma unroll
        for (int rr = 0; rr < 4; ++rr) {
            float mx = red16_max(fmaxf(fmaxf(s[0][rr], s[1][rr]), fmaxf(s[2][rr], s[3][rr])));
            const float mn = fmaxf(m[rr], mx); const float al = __expf(m[rr] - mn); m[rr] = mn; float sum = 0.f;
#pragma unroll
            for (int t = 0; t < 4; ++t) { const float p = __expf(s[t][rr] - mn); s[t][rr] = p; sum += p; }
            sum = red16_sum(sum);
            l[rr] = l[rr] * al + sum;
#pragma unroll
            for (int q = 0; q < 4; ++q) o[q][rr] *= al;
        }
#pragma unroll
        for (int t = 0; t < 4; ++t)
#pragma unroll
            for (int rr = 0; rr < 4; ++rr) Ps[(4 * fq + rr) * 72 + 16 * t + fr] = (bf16)f2bf(s[t][rr]);
        LDS_WAIT(); asm volatile("" ::: "memory");
#pragma unroll
        for (int ks = 0; ks < 2; ++ks) { const bf16x8 pa = ldfrag(Ps, 72, lane, ks);
#pragma unroll
            for (int q = 0; q < 4; ++q) o[q] = mma16(pa, ldfrag(Vt + 16 * q * 72, 72, lane, ks), o[q]); }
    }
#undef ATT_PREFETCH
#pragma unroll
    for (int rr = 0; rr < 4; ++rr) { const float inv = 1.f / l[rr]; bf16* op = PROJ + (size_t)(qtok0 + 16 * w + 4 * fq + rr) * PLD + PQ + h * 64 + fr;
#pragma unroll
        for (int q = 0; q < 4; ++q) op[16 * q] = (bf16)f2bf(o[q][rr] * inv); }
}

__device__ __forceinline__ void s5_scan_phase(const Args& A) {
    const int gt = blockIdx.x * 512 + opaque_tid(), NGT = gridDim.x * 512;
    const float* Sloc = (const float*)(A.ws + WS_R1); bf16* A2 = (bf16*)(A.ws + WS_R2 + R2_A2);
    for (int idx = gt; idx < 163840; idx += NGT) {
        const bool lat = idx < 32768; const int i2 = lat ? idx : idx - 32768;
        const int b = i2 >> 12, rem = i2 & 4095, g = rem >> 7, d = (rem >> 6) & 1, p = rem & 63;
        const int nch = lat ? 128 : 16, chunk0 = lat ? 512 + b * 128 : b * 16, rowbase = g * 1536 + chunk0;
        const float step = __expf(A.in[28][d * 32 + g]); const float lre = A.in[26][(d * 32 + g) * 64 + p], lim = A.in[27][(d * 32 + g) * 64 + p];
        float ar, ai; cpow(lre, lim, step, 16.f, ar, ai);
        float sr = 0.f, si = 0.f;
        if (lat) { const float* s0 = A.in[5] + ((size_t)((b * 2 + d) * 32 + g) * 64 + p) * 2; sr = s0[0]; si = s0[1]; }
        for (int n0 = 0; n0 < nch; n0 += 16) {
            float xr[16], xi[16];
#pragma unroll
            for (int u = 0; u < 16; ++u) { const int n = d == 0 ? n0 + u : nch - 1 - (n0 + u); const float* sp = Sloc + (size_t)(rowbase + n) * 256 + d * 128 + p; xr[u] = sp[0]; xi[u] = sp[64]; }
#pragma unroll
            for (int u = 0; u < 16; ++u) { const int n = d == 0 ? n0 + u : nch - 1 - (n0 + u); bf16* ap = A2 + (size_t)(rowbase + n) * 512 + 256 + d * 128 + p;
                ap[0] = (bf16)f2bf(sr); ap[64] = (bf16)f2bf(si);
                const float nr = ar * sr - ai * si + xr[u], ni = ar * si + ai * sr + xi[u]; sr = nr; si = ni; }
        }
        if (!lat) { float* o = A.out + O_S5 + ((size_t)((b * 2 + d) * 32 + g) * 64 + p) * 2; o[0] = sr; o[1] = si; }
    }
}


#define XB_TMO      128
#define XB_XCNT(j)  (256  + 64 * (j))
#define XB_XSUB(j)  (1280 + 64 * (j))
#define XB_XGEN(j)  (2304 + 64 * (j))
#define XB_TOP      3328
#define XB_TOPGEN   3392
#define XB_SPIN_CAP (1u << 22)
__device__ __forceinline__ unsigned xb_ld(unsigned* p)              { return __hip_atomic_load(p, __ATOMIC_RELAXED, __HIP_MEMORY_SCOPE_AGENT); }
__device__ __forceinline__ unsigned xb_add(unsigned* p, unsigned v) { return __hip_atomic_fetch_add(p, v, __ATOMIC_RELAXED, __HIP_MEMORY_SCOPE_AGENT); }
__device__ __forceinline__ unsigned xb_xcc_id() { return (unsigned)__builtin_amdgcn_s_getreg((3 << 11) | 20) & 0xFu; }
#define XB_SPIN(cond, bar) do { unsigned _sp = 0; while (cond) { __builtin_amdgcn_s_sleep(1); \
    if ((++_sp & 255u) == 0u) { if (xb_ld(&(bar)[XB_TMO])) break; if (_sp > XB_SPIN_CAP) { atomicAdd(&(bar)[XB_TMO], 1u); break; } } } } while (0)
struct XcdBarrier { unsigned* bar; unsigned x; volatile unsigned* st; };
__device__ __forceinline__ XcdBarrier xcd_barrier_post(unsigned* bar, volatile unsigned* st) {
    XcdBarrier b; b.bar = bar; b.x = xb_xcc_id(); b.st = st;
    if (threadIdx.x == 0) (void)xb_add(&bar[XB_XCNT(b.x)], 1u);
    return b;
}
__device__ __forceinline__ void xcd_barrier_complete(unsigned* bar, unsigned x, unsigned& nloc, unsigned& nx) {
    const unsigned G = gridDim.x;
    unsigned sum, cnt, mine, sp = 0u;
    for (;;) {
        sum = 0u; cnt = 0u; mine = 0u;
#pragma unroll
        for (unsigned j = 0; j < 16; ++j) { const unsigned c = xb_ld(&bar[XB_XCNT(j)]); sum += c; cnt += (c > 0u) ? 1u : 0u; mine = (j == x) ? c : mine; }
        if (sum == G) break;
        __builtin_amdgcn_s_sleep(1);
        if ((++sp & 255u) == 0u) { if (xb_ld(&bar[XB_TMO])) break; if (sp > XB_SPIN_CAP) { atomicAdd(&bar[XB_TMO], 1u); break; } }
    }
    nloc = mine > 0u ? mine : 1u; nx = cnt > 0u ? cnt : 1u;
}
__device__ __forceinline__ void xcd_barrier(const XcdBarrier& b) {
    asm volatile("s_waitcnt vmcnt(0)" ::: "memory");
    __syncthreads();
    if (threadIdx.x == 0) {
        unsigned* bar = b.bar;
        __builtin_amdgcn_s_waitcnt(0);
        unsigned nloc = b.st[0], nx = b.st[1];
        if (nloc == 0u) { xcd_barrier_complete(bar, b.x, nloc, nx); b.st[0] = nloc; b.st[1] = nx; }
        const unsigned old = xb_add(&bar[XB_XSUB(b.x)], 1u);
        const unsigned gen = old / nloc;
        if (old + 1u == (gen + 1u) * nloc) {
            __builtin_amdgcn_fence(__ATOMIC_RELEASE, "agent");
            asm volatile("s_waitcnt vmcnt(0)" ::: "memory");
            const unsigned og = xb_add(&bar[XB_TOP], 1u);
            const unsigned tg = og / nx;
            if (og + 1u == (tg + 1u) * nx) xb_add(&bar[XB_TOPGEN], 1u);
            else XB_SPIN(xb_ld(&bar[XB_TOPGEN]) == tg, bar);
            __builtin_amdgcn_fence(__ATOMIC_ACQUIRE, "agent");
            xb_add(&bar[XB_XGEN(b.x)], 1u);
            asm volatile("s_waitcnt vmcnt(0)" ::: "memory");
        } else {
            XB_SPIN(xb_ld(&bar[XB_XGEN(b.x)]) == gen, bar);
            __builtin_amdgcn_fence(__ATOMIC_ACQUIRE, "agent");
            asm volatile("s_waitcnt vmcnt(0)" ::: "memory");
        }
    }
    __syncthreads();
}

__global__ void __launch_bounds__(512, 2) mk_fwd(Args A) {
    extern __shared__ __attribute__((aligned(16))) unsigned char lds[];
    cg::grid_group grid = cg::this_grid();
    const int G = gridDim.x, bx = blockIdx.x;
    unsigned char* ws = A.ws;
    LAS unsigned char* ldsl = (LAS unsigned char*)lds;
    const int lo = A.ph_lo, hi = A.ph_hi;
#define IN(k) (lo <= (k) && (k) < hi)
#define SEAM(k) do { if (IN(k) && IN((k) + 1)) { if ((k) == 0) grid.sync(); else xcd_barrier(xb); } } while (0)
    volatile unsigned* xst = (volatile unsigned*)(lds + SLOT_OFF + 16);
    if (threadIdx.x == 0) { xst[0] = 0u; xst[1] = 0u; }
    __syncthreads();
    XcdBarrier xb; xb.bar = (unsigned*)(ws + WS_BAR); xb.x = 0; xb.st = xst;
    if (hi - lo > 1) xb = xcd_barrier_post((unsigned*)(ws + WS_BAR), xst);
    float* XR = A.out;
    const float* MODV = (const float*)(ws + WS_MODV);
    bf16* H = (bf16*)(ws + WS_R1); bf16* PROJ = (bf16*)(ws + WS_R2); bf16* Gb = (bf16*)(ws + WS_R2);
    bf16* MIX2 = (bf16*)(ws + WS_R1); bf16* A2 = (bf16*)(ws + WS_R2 + R2_A2); bf16* ZTL = (bf16*)(ws + WS_R2 + R2_ZTL); bf16* ZTC = (bf16*)(ws + WS_R2 + R2_ZTC); bf16* G5 = (bf16*)(ws + WS_R2 + R2_G5);

    if (IN(0)) { prologue(A, lds); } SEAM(0);
    if (IN(1)) { norm_phase(A.in[0], A.in[1], XR, 1, A.in[10], MODV, MODV + 1024, H); } SEAM(1);
    if (IN(2)) { pg8::Gemm g{H, (const bf16*)(ws + WS_WEVIN), 1024, 1024, 1024}; pg8::StaticOrder S; S.init(T, 3072, G, bx);
        pg8::Epi8<EInProj0> E{{PROJ, (float*)(ws + WS_DT), A.out + O_K, A.out + O_V}}; pg8::gemm_phase(ldsl, g, S, E); } SEAM(2);
    if (IN(3)) {
        unsigned* ctr = (unsigned*)(ws + WS_CTL); volatile int* slot = (volatile int*)(lds + SLOT_OFF);
        for (;;) { __syncthreads(); if (opaque_tid() == 0) *slot = (int)atomicAdd(ctr, 1u); __syncthreads(); const int it = *slot; if (it >= 640) break; ssd_item(A, lds, it); }
        for (;;) { __syncthreads(); if (opaque_tid() == 0) *slot = (int)atomicAdd(ctr + 64, 1u); __syncthreads(); const int it = *slot; if (it >= 1536) break; attn_pair(A, lds, it); }
    } SEAM(3);
    if (IN(4)) { gate_phase((const bf16*)(ws + WS_R1), PROJ, A.in[22]); } SEAM(4);
    if (IN(5)) { pg8::Gemm g{PROJ, (const bf16*)(ws + WS_WEVOUT), 1024, PLD, 1024}; pg8::StaticOrder S; S.init(T, 1024, G, bx);
        pg8::Epi8<EResid> E{{A.in[0], A.in[1], XR, MODV + 2048, 1}}; pg8::gemm_phase(ldsl, g, S, E); } SEAM(5);
    if (IN(6)) { norm_phase(A.in[0], A.in[1], XR, 0, A.in[11], MODV + 3072, MODV + 4096, H); } SEAM(6);
    if (IN(7)) { pg8::Gemm g{H, (const bf16*)(ws + WS_WFUP), 1024, 1024, 1024}; pg8::StaticOrder S; S.init(T, 5632, G, bx);
        pg8::Epi8<ESwiglu> E{{Gb}}; pg8::gemm_phase(ldsl, g, S, E); } SEAM(7);
    if (IN(8)) { pg8::Gemm g{Gb, (const bf16*)(ws + WS_WFDN), 2816, 2816, 2816}; pg8::StaticOrder S; S.init(T, 1024, G, bx);
        pg8::Epi8<EResid> E{{A.in[0], A.in[1], XR, MODV + 5120, 0}}; pg8::gemm_phase(ldsl, g, S, E); } SEAM(8);
    const float* MODV1 = MODV + 9 * 6144;
    if (IN(9)) { norm_phase(A.in[0], A.in[1], XR, 0, A.in[10] + 1024, MODV1, MODV1 + 1024, H);
        __syncthreads();
        const int tid = opaque_tid(); float* scr = (float*)(lds + (tid >> 6) * 17408); const int gw = bx * 8 + (tid >> 6), NGW = G * 8, lane = tid & 63;
        transpose_all<2>(A.in[12] + (size_t)1024 * 2816, 1024, 2816, 2816, (bf16*)(ws + WS_WFUP), scr, gw, NGW, lane);
        transpose_all<3>(A.in[13] + (size_t)1024 * 2816, 1024, 2816, 2816, (bf16*)(ws + WS_WFUP), scr, gw, NGW, lane);
        transpose_all<0>(A.in[14] + (size_t)2816 * 1024, 2816, 1024, 1024, (bf16*)(ws + WS_WFDN), scr, gw, NGW, lane);
        __syncthreads(); } SEAM(9);
    if (IN(10)) { pg8::Gemm g{H, (const bf16*)(ws + WS_WODIN), 1024, 1024, 1024}; pg8::StaticOrder S; S.init(T, 1536, G, bx);
        pg8::Epi8<EInProj1> E{{A2, ZTL, ZTC}}; pg8::gemm_phase(ldsl, g, S, E); } SEAM(10);
    if (IN(11)) { pg8::Gemm g{A2, (const bf16*)(ws + WS_WBS), 256, 512, 256}; pg8::SchedS5 S{G, bx, 192};
        pg8::Epi8<ESloc> E{{(float*)(ws + WS_R1)}}; pg8::gemm_phase(ldsl, g, S, E); } SEAM(11);
    if (IN(12)) { s5_scan_phase(A); } SEAM(12);
    if (IN(13)) {
        { pg8::Gemm g{(const bf16*)(ws + WS_DFTL), ZTL, 4096, 4096, 4096}; pg8::StaticOrder S; S.init(2048, 4096, 128, bx < 128 ? bx : (1 << 30));
          pg8::Epi8<EFnetL> E{{MIX2}}; pg8::gemm_phase(ldsl, g, S, E); }
        { pg8::Gemm g{A2, (const bf16*)(ws + WS_WWY), 512, 512, 512}; pg8::SchedS5 S{128, bx >= 128 ? bx - 128 : (1 << 30), 192};
          pg8::Epi8<EY> E{{G5}}; pg8::gemm_phase(ldsl, g, S, E); }
        { pg8::Gemm g{(const bf16*)(ws + WS_DFTC), ZTC, 512, 512, 512}; pg8::StaticOrder S; S.init(256, 16384, 64, bx >= 192 ? bx - 192 : (1 << 30));
          pg8::Epi8<EFnetC> E{{MIX2}}; pg8::gemm_phase(ldsl, g, S, E); }
    } SEAM(13);
    if (IN(14)) { pg8::Gemm g{G5, (const bf16*)(ws + WS_WGLU), 512, 512, 512}; pg8::StaticOrder S; S.init(T, 512, G, bx);
        pg8::Epi8<EGlu> E{{G5, A.in[35], MIX2}}; pg8::gemm_phase(ldsl, g, S, E); } SEAM(14);
    if (IN(15)) { pg8::Gemm g{MIX2, (const bf16*)(ws + WS_WODOUT), 1024, 1024, 1024}; pg8::StaticOrder S; S.init(T, 1024, G, bx);
        pg8::Epi8<EResid> E{{A.in[0], A.in[1], XR, MODV1 + 2048, 0}}; pg8::gemm_phase(ldsl, g, S, E); } SEAM(15);
    if (IN(16)) { norm_phase(A.in[0], A.in[1], XR, 0, A.in[11] + 1024, MODV1 + 3072, MODV1 + 4096, H); } SEAM(16);
    if (IN(17)) { pg8::Gemm g{H, (const bf16*)(ws + WS_WFUP), 1024, 1024, 1024}; pg8::StaticOrder S; S.init(T, 5632, G, bx);
        pg8::Epi8<ESwiglu> E{{Gb}}; pg8::gemm_phase(ldsl, g, S, E); } SEAM(17);
    if (IN(18)) { pg8::Gemm g{Gb, (const bf16*)(ws + WS_WFDN), 2816, 2816, 2816}; pg8::StaticOrder S; S.init(T, 1024, G, bx);
        pg8::Epi8<EResid> E{{A.in[0], A.in[1], XR, MODV1 + 5120, 0}}; pg8::gemm_phase(ldsl, g, S, E); } SEAM(18);
    if (IN(19)) { final_norm_phase(XR, A.in[15]); }
#undef IN
#undef SEAM
}

extern "C" void kernel_launch(void* const* d_in, const int* in_sizes, int n_in, void* d_out, int out_size, void* d_ws, size_t ws_size, hipStream_t stream) {
    static int grid = 0;
    if (grid == 0) {
        if (n_in != 37 || ws_size < WS_END) { fprintf(stderr, "kernel_launch: unexpected n_in %d / ws %zu\n", n_in, ws_size); grid = -1; return; }
        int dev = 0, cus = 0, per_cu = 0;
        hipGetDevice(&dev); hipDeviceGetAttribute(&cus, hipDeviceAttributeMultiprocessorCount, dev);
        if (hipFuncSetAttribute((const void*)mk_fwd, hipFuncAttributeMaxDynamicSharedMemorySize, LDS_BYTES) != hipSuccess) { fprintf(stderr, "kernel_launch: hipFuncSetAttribute failed\n"); grid = -1; return; }
        hipOccupancyMaxActiveBlocksPerMultiprocessor(&per_cu, (const void*)mk_fwd, 512, LDS_BYTES);
        (void)hipGetLastError();
        if (per_cu < 1) per_cu = 1;
        grid = cus * 1;
        if (grid <= 0) grid = 256;
    }
    if (grid < 0) return;
    hipMemsetAsync((char*)d_ws + WS_CTL, 0, CTL_BYTES, stream);
    Args a{};
    for (int i = 0; i < 37; ++i) a.in[i] = (const float*)d_in[i];
    a.out = (float*)d_out; a.ws = (unsigned char*)d_ws;
#if MK_MODE == 1
    for (int ph = 0; ph < NPH; ++ph) { a.ph_lo = ph; a.ph_hi = ph + 1; hipLaunchKernelGGL(mk_fwd, dim3(grid), dim3(512), LDS_BYTES, stream, a); }
#else
    a.ph_lo = 0; a.ph_hi = NPH;
    void* params[] = {&a};
    hipError_t e = hipLaunchCooperativeKernel((const void*)mk_fwd, dim3(grid), dim3(512), params, LDS_BYTES, stream);
    if (e != hipSuccess) fprintf(stderr, "cooperative launch failed: %s (grid %d)\n", hipGetErrorString(e), grid);
#endif
}
```

```cpp
#include <hip/hip_runtime.h>
#include <hip/hip_cooperative_groups.h>
#include <cstdio>
#include <cstdint>
namespace cg = cooperative_groups;

#ifndef MK_MODE
#define MK_MODE 0
#endif

#define LAS __attribute__((address_space(3)))
typedef unsigned short bf16;
typedef short bf16x8 __attribute__((ext_vector_type(8)));
typedef float f32x4 __attribute__((ext_vector_type(4)));
typedef unsigned u32x4 __attribute__((ext_vector_type(4)));
typedef unsigned u32x2 __attribute__((ext_vector_type(2)));

constexpr int D = 1024, TC = 8192, TL = 16384, T = 24576, FF = 2816;
constexpr int PLD = 2816;
constexpr int PZ = 0, PQ = 512, PX = 1024, PK = 1792, PV = 2304;
constexpr int NPH = 20;
constexpr int LDS_BYTES = 147456;
constexpr int SLOT_OFF = LDS_BYTES - 64;
constexpr size_t MiB = 1u << 20;
constexpr size_t WS_CTL = 0, CTL_BYTES = 1048576, WS_BAR = 4096;
constexpr size_t WS_MODV = 64 * 1024;
constexpr size_t WS_RSS = 512 * 1024;
constexpr size_t WS_SW = 249 * MiB;
constexpr size_t WS_DT = 1 * MiB;
constexpr size_t WS_WEVIN = 2 * MiB;
constexpr size_t WS_WEVOUT = 8 * MiB;
constexpr size_t WS_WODIN = 10 * MiB;
constexpr size_t WS_WODOUT = 13 * MiB;
constexpr size_t WS_WGLU = 15 * MiB;
constexpr size_t WS_DFTC = 15 * MiB + 512 * 1024;
constexpr size_t WS_WFUP = 16 * MiB;
constexpr size_t WS_WFDN = 27 * MiB;
constexpr size_t WS_WBS = 33 * MiB;
constexpr size_t WS_WWY = 37 * MiB;
constexpr size_t WS_DFTL = 45 * MiB;
constexpr size_t WS_XC = 33 * MiB;
constexpr size_t WS_R1 = 69 * MiB;
constexpr size_t WS_R2 = 117 * MiB;
constexpr size_t WS_END = 250 * MiB;
constexpr size_t SW0_OFF = 0, SW1_OFF = 9 * 3072, SW2_OFF = SW1_OFF + 9 * 5632, SW3_OFF = SW2_OFF + 9 * 1536;
constexpr size_t R2_A2 = 0, R2_ZTL = 48 * MiB, R2_ZTC = 80 * MiB, R2_G5 = 96 * MiB;
constexpr size_t O_K = 25165824, O_V = 29360128, O_SSD = 33554432, O_S5 = 35651584;

struct Args { const float* in[37]; float* out; unsigned char* ws; int ph_lo, ph_hi; };
typedef const __attribute__((address_space(4))) Args CArgs;
__device__ __forceinline__ CArgs* kargs() { CArgs* p = (CArgs*)__builtin_amdgcn_kernarg_segment_ptr(); asm volatile("" : "+s"(p)); return p; }

__device__ __forceinline__ unsigned f2bf(float f) { unsigned u = __builtin_bit_cast(unsigned, f); return (u + 0x7fffu + ((u >> 16) & 1u)) >> 16; }
__device__ __forceinline__ unsigned pk2(float lo, float hi) { return f2bf(lo) | (f2bf(hi) << 16); }
__device__ __forceinline__ float bflo(unsigned u) { return __builtin_bit_cast(float, u << 16); }
__device__ __forceinline__ float bfhi(unsigned u) { return __builtin_bit_cast(float, u & 0xffff0000u); }
__device__ __forceinline__ unsigned cvt_pk_bf16(float lo, float hi) { unsigned r; asm volatile("v_cvt_pk_bf16_f32 %0, %1, %2" : "=v"(r) : "v"(lo), "v"(hi)); return r; }
__device__ __forceinline__ u32x4 pack8(f32x4 a, f32x4 b) { u32x4 w; w.x = cvt_pk_bf16(a[0], a[1]); w.y = cvt_pk_bf16(a[2], a[3]); w.z = cvt_pk_bf16(b[0], b[1]); w.w = cvt_pk_bf16(b[2], b[3]); return w; }
__device__ __forceinline__ float silu_f(float x) { return x / (1.f + __expf(-x)); }
__device__ __forceinline__ float sigmoid_f(float x) { return 1.f / (1.f + __expf(-x)); }
__device__ __forceinline__ float gelu_tanh(float x) { const float u = 0.7978845608028654f * (x + 0.044715f * x * x * x); const float t = 1.f - 2.f / (__expf(2.f * u) + 1.f); return 0.5f * x * (1.f + t); }
__device__ __forceinline__ float wave_sum(float v) {
#pragma unroll
    for (int o = 1; o < 64; o <<= 1) v += __shfl_xor(v, o);
    return v;
}
__device__ __forceinline__ int mod_row(int row) { return row < TC ? 0 : 1 + ((row - TC) >> 11); }
#define LDS_WAIT() asm volatile("s_waitcnt lgkmcnt(0)" ::: "memory")
__device__ __forceinline__ int opaque_tid() { int t = threadIdx.x; asm volatile("" : "+v"(t)); return t; }
__device__ __forceinline__ f32x4 mma16(bf16x8 a, bf16x8 b, f32x4 c) { return __builtin_amdgcn_mfma_f32_16x16x32_bf16(a, b, c, 0, 0, 0); }
__device__ __forceinline__ bf16x8 ldfrag(const bf16* base, int stride, int lane, int ks) { return *(const bf16x8*)(base + (lane & 15) * stride + ks * 32 + (lane >> 4) * 8); }

namespace pg8 {
constexpr int BM = 256, BK = 64, HALF = 128, HTB = HALF * BK * 2, NXCD = 8, WGM = 8;
__host__ __device__ __forceinline__ int lds_byte(int r, int c) { const int st = (r >> 4) * 2 + (c >> 5), rr = r & 15, cc = c & 31, ob = rr * 64 + cc * 2; return st * 1024 + (ob ^ (((ob >> 9) & 1) << 5)); }
__host__ __device__ __forceinline__ void stage_rc(int b, int& R, int& C) { const int st = b / 1024, sb = b % 1024, swz = sb ^ (((sb >> 9) & 1) << 5); R = (st >> 1) * 16 + swz / 64; C = (st & 1) * 32 + (swz % 64) / 2; }
__host__ __device__ __forceinline__ int perm32(int rho) { const int n = rho >> 4, i = rho & 15; return 8 * (i >> 2) + 4 * n + (i & 3); }
struct Unit { int pm, pn; };
struct Gemm { const bf16* A; const bf16* Bt; int K, lda, ldb; };
struct StaticOrder {
    int nM, nN, nwg, G, c;
    __device__ void init(int M, int N, int G_, int c_) { nM = M / BM; nN = N / BM; nwg = nM * nN; G = G_; c = c_; }
    __device__ bool next(int i, Unit& u) const {
        const long L = (long)i * G + c; if (L >= nwg) return false;
        int wgid = (int)L; { const int q = nwg / NXCD, r = nwg % NXCD, xcd = wgid % NXCD, off = wgid / NXCD; wgid = (xcd < r ? xcd * (q + 1) : r * (q + 1) + (xcd - r) * q) + off; }
        const int nig = WGM * nN, gid = wgid / nig, fm = gid * WGM, gsz = (nM - fm) < WGM ? (nM - fm) : WGM;
        u.pm = fm + ((wgid % nig) % gsz); u.pn = (wgid % nig) / gsz; return true;
    }
};
struct SchedS5 {
    int G, c, nunits;
    __device__ bool next(int i, Unit& u) const { const long L = (long)i * G + c; if (L >= nunits) return false; u.pm = (int)L; u.pn = (int)L / 6; return true; }
};
template <class F> struct Epi8 {
    static constexpr bool PERM = true;
    F f;
    __device__ __forceinline__ void operator()(const f32x4 (&acc)[2][2][4][2], const Unit& u, int wr, int wc, int fr, int fq) const {
#pragma unroll
        for (int ai = 0; ai < 2; ++ai)
#pragma unroll
            for (int m = 0; m < 4; ++m) { const int row = u.pm * BM + ai * HALF + wr * 64 + m * 16 + fr;
#pragma unroll
                for (int bj = 0; bj < 2; ++bj) { const int col0 = u.pn * BM + bj * HALF + wc * 32 + 8 * fq; f(row, col0, acc[ai][bj][m][0], acc[ai][bj][m][1]); } }
    }
};

template <class F> struct Epi8N {
    static constexpr bool PERM = true;
    F f; const float* rss; const float* sw; int n;
    __device__ __forceinline__ void operator()(const f32x4 (&acc)[2][2][4][2], const Unit& u, int wr, int wc, int fr, int fq) const {
        const int row0 = u.pm * BM + wr * 64 + fr, colb = u.pn * BM + wc * 32 + 8 * fq;
        const float* s = sw + mod_row(u.pm * BM) * n + colb;
        float rs[2][4]; f32x4 sv[2][2];
#pragma unroll
        for (int ai = 0; ai < 2; ++ai)
#pragma unroll
            for (int m = 0; m < 4; ++m) rs[ai][m] = rss[row0 + ai * HALF + m * 16];
#pragma unroll
        for (int bj = 0; bj < 2; ++bj) { sv[bj][0] = *(const f32x4*)(s + bj * HALF); sv[bj][1] = *(const f32x4*)(s + bj * HALF + 4); }
#pragma unroll
        for (int ai = 0; ai < 2; ++ai)
#pragma unroll
            for (int m = 0; m < 4; ++m) { const float rstd = rsqrtf(rs[ai][m] * (1.f / 1024.f) + 1e-6f);
#pragma unroll
                for (int bj = 0; bj < 2; ++bj) f(row0 + ai * HALF + m * 16, colb + bj * HALF, acc[ai][bj][m][0] * rstd + sv[bj][0], acc[ai][bj][m][1] * rstd + sv[bj][1]); }
    }
};
struct EpiResid {
    static constexpr bool PERM = true;
    const float* xp; const float* xs; float* XR; const float* gate; int first; bf16* Hn; const float* gam; const float* scale; float* rss;
    __device__ __forceinline__ void operator()(const f32x4 (&acc)[2][2][4][2], const Unit& u, int wr, int wc, int fr, int fq) const {
        const int row0 = u.pm * BM + wr * 64 + fr, colb = u.pn * BM + wc * 32 + 8 * fq, mr = mod_row(u.pm * BM);
        f32x4 gv[2][2], qv[2][2];
#pragma unroll
        for (int bj = 0; bj < 2; ++bj)
#pragma unroll
            for (int h = 0; h < 2; ++h) { const int c = colb + bj * HALF + 4 * h; gv[bj][h] = *(const f32x4*)(gate + mr * 6144 + c);
                qv[bj][h] = Hn ? *(const f32x4*)(gam + c) * (*(const f32x4*)(scale + mr * 6144 + c) + 1.f) : (f32x4){0.f, 0.f, 0.f, 0.f}; }
#pragma unroll
        for (int am = 0; am < 8; ++am) { const int ai = am >> 2, m = am & 3; const int row = row0 + ai * HALF + m * 16;
            f32x4 bv[2][2];
            { const float* b = first ? (row < TC ? xp + (size_t)row * D : xs + (size_t)(row - TC) * D) : XR + (size_t)row * D;
#pragma unroll
              for (int bj = 0; bj < 2; ++bj) { bv[bj][0] = *(const f32x4*)(b + colb + bj * HALF); bv[bj][1] = *(const f32x4*)(b + colb + bj * HALF + 4); } }
            float ss = 0.f;
#pragma unroll
            for (int bj = 0; bj < 2; ++bj) { const f32x4 o0 = bv[bj][0] + gv[bj][0] * acc[ai][bj][m][0], o1 = bv[bj][1] + gv[bj][1] * acc[ai][bj][m][1];
                float* o = XR + (size_t)row * D + colb + bj * HALF; *(f32x4*)o = o0; *(f32x4*)(o + 4) = o1;
                ss += (o0[0] * o0[0] + o0[1] * o0[1]) + (o0[2] * o0[2] + o0[3] * o0[3]) + (o1[0] * o1[0] + o1[1] * o1[1]) + (o1[2] * o1[2] + o1[3] * o1[3]);
                if (Hn) *(u32x4*)(Hn + (size_t)row * D + colb + bj * HALF) = pack8(o0 * qv[bj][0], o1 * qv[bj][1]); }
            ss += __shfl_xor(ss, 16); ss += __shfl_xor(ss, 32);
            if (fq == 0) atomicAdd(rss + row, ss);
        }
    }
};

template <class Epi, class Sched>
__device__ __forceinline__ void gemm_phase(LAS unsigned char* lds, const Gemm g, const Sched& S, const Epi& E) {
    const int tid = opaque_tid(), wid = __builtin_amdgcn_readfirstlane(tid >> 6), lane = tid & 63, wr = wid >> 2, wc = wid & 3, fr = lane & 15, fq = lane >> 4;
    const int K = g.K, nt = K / BK;
    unsigned voffA[2], voffB[2];
#pragma unroll
    for (int i = 0; i < 2; ++i) { int R, C; stage_rc(tid * 16 + i * 8192, R, C); const int Rb = (R & ~31) + perm32(R & 31);
        voffA[i] = (unsigned)(R * g.lda + C) * 2u; voffB[i] = (unsigned)(Rb * g.ldb + C) * 2u; }
    const size_t kstep = (size_t)(BK * 2);
    const size_t hstepA = (size_t)HALF * g.lda * 2, hstepB = (size_t)HALF * g.ldb * 2;
    const size_t tstepA = 2 * hstepA, tstepB = 2 * hstepB;
    const unsigned ldsw = (unsigned)wid * 1024u;
    const int aoff = lds_byte(wr * 64 + fr, fq * 8), boff = lds_byte(wc * 32 + fr, fq * 8);
#define PG8_SA(b, h) (((b) * 2 + (h)) * HTB)
#define PG8_SB(b, h) ((4 + (b) * 2 + (h)) * HTB)
#define PG8_STAGE(bufoff, gbase, voff) do { _Pragma("unroll") for (int _i = 0; _i < 2; ++_i) \
        __builtin_amdgcn_global_load_lds((const unsigned*)((const char*)(gbase) + (voff)[_i]), (LAS unsigned*)(lds + (bufoff) + ldsw + _i * 8192), 16, 0, 0); } while (0)
#define PG8_LDA(dst, b, h) do { _Pragma("unroll") for (int m = 0; m < 4; ++m) _Pragma("unroll") for (int k = 0; k < 2; ++k) dst[m][k] = *(const LAS bf16x8*)(lds + PG8_SA(b, h) + aoff + m * 2048 + k * 1024); } while (0)
#define PG8_LDB(dst, b, h) do { _Pragma("unroll") for (int n = 0; n < 2; ++n) _Pragma("unroll") for (int k = 0; k < 2; ++k) dst[n][k] = *(const LAS bf16x8*)(lds + PG8_SB(b, h) + boff + n * 2048 + k * 1024); } while (0)
#define PG8_MMA(ai, bj, At, Bt) do { __builtin_amdgcn_s_setprio(1); _Pragma("unroll") for (int m = 0; m < 4; ++m) _Pragma("unroll") for (int n = 0; n < 2; ++n) _Pragma("unroll") for (int k = 0; k < 2; ++k) \
        acc[ai][bj][m][n] = __builtin_amdgcn_mfma_f32_16x16x32_bf16(Bt[n][k], At[m][k], acc[ai][bj][m][n], 0, 0, 0); __builtin_amdgcn_s_setprio(0); } while (0)
#define PG8_WAIT_V(n) asm volatile("s_waitcnt vmcnt(" #n ")" ::: "memory")
#define PG8_WAIT_L(n) asm volatile("s_waitcnt lgkmcnt(" #n ")" ::: "memory")
#define PG8_BAR __builtin_amdgcn_s_barrier()
#define PG8_SCHED __builtin_amdgcn_sched_barrier(0)
    Unit cur, nxt; int ui = 0;
    if (!S.next(0, cur)) return;
    f32x4 acc[2][2][4][2];
#pragma unroll
    for (int a = 0; a < 2; ++a)
#pragma unroll
        for (int b = 0; b < 2; ++b)
#pragma unroll
            for (int m = 0; m < 4; ++m)
#pragma unroll
                for (int n = 0; n < 2; ++n) acc[a][b][m][n] = (f32x4){0.f, 0.f, 0.f, 0.f};
    bf16x8 At[4][2], B0[2][2], B1[2][2];
    const char* cA = (const char*)g.A + (size_t)cur.pm * tstepA; const char* cB = (const char*)g.Bt + (size_t)cur.pn * tstepB;
    PG8_STAGE(PG8_SB(0, 0), cB, voffB); PG8_STAGE(PG8_SB(0, 1), cB + hstepB, voffB); PG8_STAGE(PG8_SA(0, 0), cA, voffA); PG8_STAGE(PG8_SA(0, 1), cA + hstepA, voffA);
    if (wr == 1) PG8_BAR;
    PG8_WAIT_V(2); PG8_BAR;
    PG8_STAGE(PG8_SB(1, 0), cB + kstep, voffB); PG8_STAGE(PG8_SA(1, 0), cA + kstep, voffA); PG8_STAGE(PG8_SB(1, 1), cB + hstepB + kstep, voffB);
    PG8_WAIT_V(6); PG8_BAR;
    for (;;) {
        const bool has_next = S.next(ui + 1, nxt);
        const char* nA = has_next ? (const char*)g.A + (size_t)nxt.pm * tstepA : cA; const char* nB = has_next ? (const char*)g.Bt + (size_t)nxt.pn * tstepB : cB;
        for (int t = 0; t < nt; t += 2) {
            const bool last = (t == nt - 2);
            const char* a1 = cA + (size_t)(t + 1) * kstep;
            const char* a2 = last ? nA : cA + (size_t)(t + 2) * kstep; const char* b2 = last ? nB : cB + (size_t)(t + 2) * kstep;
            const char* a3 = a2 + kstep; const char* b3 = b2 + kstep;
            PG8_LDB(B0, 0, 0); PG8_LDB(B1, 0, 1); PG8_SCHED; PG8_LDA(At, 0, 0); PG8_STAGE(PG8_SA(1, 1), a1 + hstepA, voffA);
            PG8_WAIT_V(8); PG8_WAIT_L(0); PG8_BAR; PG8_MMA(0, 0, At, B0); PG8_MMA(0, 1, At, B1); PG8_BAR; PG8_SCHED;
            PG8_LDA(At, 0, 1); PG8_STAGE(PG8_SB(0, 0), b2, voffB); PG8_STAGE(PG8_SB(0, 1), b2 + hstepB, voffB); PG8_STAGE(PG8_SA(0, 0), a2, voffA);
            PG8_WAIT_V(8); PG8_WAIT_L(0); PG8_BAR; PG8_MMA(1, 0, At, B0); PG8_MMA(1, 1, At, B1); PG8_BAR; PG8_SCHED;
            PG8_LDB(B0, 1, 0); PG8_LDB(B1, 1, 1); PG8_SCHED; PG8_LDA(At, 1, 0); PG8_STAGE(PG8_SA(0, 1), a2 + hstepA, voffA);
            PG8_WAIT_V(8); PG8_WAIT_L(0); PG8_BAR; PG8_MMA(0, 0, At, B0); PG8_MMA(0, 1, At, B1); PG8_BAR; PG8_SCHED;
            PG8_LDA(At, 1, 1); PG8_STAGE(PG8_SB(1, 0), b3, voffB); PG8_STAGE(PG8_SB(1, 1), b3 + hstepB, voffB); PG8_STAGE(PG8_SA(1, 0), a3, voffA);
            PG8_WAIT_V(8); PG8_WAIT_L(0); PG8_BAR; PG8_MMA(1, 0, At, B0); PG8_MMA(1, 1, At, B1); PG8_BAR; PG8_SCHED;
        }
        if (wr == 0) PG8_BAR;
        { const int t2 = opaque_tid(); const int w2 = __builtin_amdgcn_readfirstlane(t2 >> 6); E(acc, cur, w2 >> 2, w2 & 3, t2 & 15, (t2 & 63) >> 4); }
        if (!has_next) break;
#pragma unroll
        for (int a = 0; a < 2; ++a)
#pragma unroll
            for (int b = 0; b < 2; ++b)
#pragma unroll
                for (int m = 0; m < 4; ++m)
#pragma unroll
                    for (int n = 0; n < 2; ++n) acc[a][b][m][n] = (f32x4){0.f, 0.f, 0.f, 0.f};
        cur = nxt; cA = nA; cB = nB; ++ui;
        if (wr == 1) PG8_BAR;
    }
    PG8_WAIT_V(0);
    PG8_BAR;
#undef PG8_SA
#undef PG8_SB
#undef PG8_STAGE
#undef PG8_LDA
#undef PG8_LDB
#undef PG8_MMA
#undef PG8_WAIT_V
#undef PG8_WAIT_L
#undef PG8_BAR
#undef PG8_SCHED
}
}

struct EInProj0 { bf16* PROJ; float* DT; float* outk; float* outv;
    __device__ __forceinline__ void operator()(int row, int col, f32x4 v0, f32x4 v1) const {
        if (col < 2816) {
            if (col >= PQ && col < PX) { v0 = v0 * 0.125f; v1 = v1 * 0.125f; }
            *(u32x4*)(PROJ + (size_t)row * PLD + col) = pack8(v0, v1);
            if (row < TC && col >= PK) { float* o = (col < PV) ? outk + (size_t)row * 512 + (col - PK) : outv + (size_t)row * 512 + (col - PV); *(f32x4*)o = v0; *(f32x4*)(o + 4) = v1; }
        } else if (col == 2816) { float* o = DT + (size_t)row * 8; *(f32x4*)o = v0; *(f32x4*)(o + 4) = v1; }
    } };
struct ESwiglu { bf16* G;
    __device__ __forceinline__ void operator()(int row, int col, f32x4 v0, f32x4 v1) const {
        u32x2 w; w.x = cvt_pk_bf16(silu_f(v0[0]) * v1[0], silu_f(v0[1]) * v1[1]); w.y = cvt_pk_bf16(silu_f(v0[2]) * v1[2], silu_f(v0[3]) * v1[3]);
        *(u32x2*)(G + (size_t)row * FF + (col >> 1)) = w;
    } };
struct EInProj1 { bf16* A2; bf16* ZTL; bf16* ZTC;
    __device__ __forceinline__ void operator()(int row, int col, f32x4 v0, f32x4 v1) const {
        if (col < 512) { const int g = col >> 4, cc = col & 15, ch = row >> 4, j = row & 15;
            *(u32x4*)(A2 + ((size_t)(g * 1536 + ch)) * 512 + j * 16 + cc) = pack8(v0, v1);
        } else { const int cs = (col - 512) >> 9, n = (col - 512) & 511; bf16* p; size_t st;
            if (row < TC) { const int b = row >> 8, l = row & 255; p = ZTC + ((size_t)(b * 512 + n)) * 512 + cs * 256 + l; st = 512; }
            else { const int r2 = row - TC, b = r2 >> 11, l = r2 & 2047; p = ZTL + ((size_t)(b * 512 + n)) * 4096 + cs * 2048 + l; st = 4096; }
#pragma unroll
            for (int e = 0; e < 4; ++e) { p[(size_t)e * st] = (bf16)f2bf(v0[e]); p[(size_t)(e + 4) * st] = (bf16)f2bf(v1[e]); }
        }
    } };
struct ESloc { float* S;
    __device__ __forceinline__ void operator()(int row, int col, f32x4 v0, f32x4 v1) const { float* o = S + (size_t)row * 256 + (col & 255); *(f32x4*)o = v0; *(f32x4*)(o + 4) = v1; } };
struct EY { bf16* G5;
    __device__ __forceinline__ void operator()(int row, int col, f32x4 v0, f32x4 v1) const {
        const int g = row / 1536, ch = row - g * 1536, c2 = col & 255, i = c2 >> 4, cc = c2 & 15;
        f32x4 a, b;
#pragma unroll
        for (int e = 0; e < 4; ++e) { a[e] = gelu_tanh(v0[e]); b[e] = gelu_tanh(v1[e]); }
        *(u32x4*)(G5 + (size_t)(ch * 16 + i) * 512 + g * 16 + cc) = pack8(a, b);
    } };
struct EGlu { const bf16* G5; const float* bias; bf16* MIX2;
    __device__ __forceinline__ void operator()(int row, int col, f32x4 v0, f32x4 v1) const {
        const u32x4 gr = *(const u32x4*)(G5 + (size_t)row * 512 + col); const f32x4 b0 = *(const f32x4*)(bias + col), b1 = *(const f32x4*)(bias + col + 4);
        f32x4 a, b;
        a[0] = bflo(gr.x) * sigmoid_f(v0[0] + b0[0]); a[1] = bfhi(gr.x) * sigmoid_f(v0[1] + b0[1]); a[2] = bflo(gr.y) * sigmoid_f(v0[2] + b0[2]); a[3] = bfhi(gr.y) * sigmoid_f(v0[3] + b0[3]);
        b[0] = bflo(gr.z) * sigmoid_f(v1[0] + b1[0]); b[1] = bfhi(gr.z) * sigmoid_f(v1[1] + b1[1]); b[2] = bflo(gr.w) * sigmoid_f(v1[2] + b1[2]); b[3] = bfhi(gr.w) * sigmoid_f(v1[3] + b1[3]);
        *(u32x4*)(MIX2 + (size_t)row * D + col) = pack8(a, b);
    } };
struct EFnetL { bf16* MIX2;
    __device__ __forceinline__ void operator()(int row, int col, f32x4 v0, f32x4 v1) const { const int b = col >> 9, n = col & 511; *(u32x4*)(MIX2 + (size_t)(TC + b * 2048 + row) * D + 512 + n) = pack8(v0, v1); } };
struct EFnetC { bf16* MIX2;
    __device__ __forceinline__ void operator()(int row, int col, f32x4 v0, f32x4 v1) const { const int b = col >> 9, n = col & 511; *(u32x4*)(MIX2 + (size_t)(b * 256 + row) * D + 512 + n) = pack8(v0, v1); } };

__device__ __forceinline__ int evin_dst(int n) {
    if (n < 512) return n;
    if (n < 1280) return n - 512 + PX;
    if (n < 1288) return n - 1280 + 2816;
    if (n < 1800) return n - 1288 + PQ;
    if (n < 2312) return n - 1800 + PK;
    return n - 2312 + PV;
}
template <int MODE> __device__ __forceinline__ int dst_row(int n) {
    if (MODE == 0) return n;
    if (MODE == 1) return evin_dst(n);
    if (MODE == 2) return 8 * (n >> 2) + (n & 3);
    return 8 * (n >> 2) + 4 + (n & 3);
}
template <int MODE> __device__ __forceinline__ void transpose_item(const float* W, int K, int N, int ldw, bf16* WT, float* scr, int item, int lane) {
    const int nblk = (N + 127) >> 7, kb = item / nblk, nb = item - kb * nblk, k0 = 32 * kb, n0 = 128 * nb;
    const int nn = n0 + 4 * (lane & 31); const bool ok = nn < N;
    f32x4 v[16];
#pragma unroll
    for (int i = 0; i < 16; ++i) { const int kk = 2 * i + (lane >> 5); v[i] = ok ? *(const f32x4*)(W + (size_t)(k0 + kk) * ldw + nn) : (f32x4){0.f, 0.f, 0.f, 0.f}; }
#pragma unroll
    for (int i = 0; i < 16; ++i) { const int kk = 2 * i + (lane >> 5); float* s = scr + kk * 129 + 4 * (lane & 31); s[0] = v[i][0]; s[1] = v[i][1]; s[2] = v[i][2]; s[3] = v[i][3]; }
    LDS_WAIT(); asm volatile("" ::: "memory");
#pragma unroll
    for (int j = 0; j < 2; ++j) { const int n = lane + 64 * j;
        if (n0 + n < N) { const float* s = scr + n; bf16* o = WT + (size_t)dst_row<MODE>(n0 + n) * K + k0;
#pragma unroll
            for (int q = 0; q < 4; ++q) { u32x4 w; w.x = pk2(s[(8 * q) * 129], s[(8 * q + 1) * 129]); w.y = pk2(s[(8 * q + 2) * 129], s[(8 * q + 3) * 129]); w.z = pk2(s[(8 * q + 4) * 129], s[(8 * q + 5) * 129]); w.w = pk2(s[(8 * q + 6) * 129], s[(8 * q + 7) * 129]);
                *(u32x4*)(o + 8 * q) = w; } } }
    LDS_WAIT(); asm volatile("" ::: "memory");
}
template <int MODE> __device__ __forceinline__ void transpose_all(const float* W, int K, int N, int ldw, bf16* WT, float* scr, int gw, int NGW, int lane) {
    const int nitems = (K >> 5) * ((N + 127) >> 7);
    for (int it = gw; it < nitems; it += NGW) transpose_item<MODE>(W, K, N, ldw, WT, scr, it, lane);
}
__device__ __forceinline__ void fold_item(const float* W, bf16* WT, float* scr, int item, int lane) {
    const int g = item >> 6, k0 = (item & 63) * 16;
    for (int i = 0; i < 16; ++i) scr[i * 65 + lane] = W[(size_t)(k0 + i) * 1024 + 512 + g * 64 + lane];
    scr[16 * 65 + lane] = cospif(lane * (1.f / 32.f)) * 0.125f; scr[16 * 65 + 64 + lane] = sinpif(lane * (1.f / 32.f)) * 0.125f;
    LDS_WAIT(); asm volatile("" ::: "memory");
    float ac[16], as[16];
#pragma unroll
    for (int kk = 0; kk < 16; ++kk) { ac[kk] = 0.f; as[kk] = 0.f; }
    for (int c = 0; c < 64; ++c) { const int idx = (c * lane) & 63; const float ct = scr[16 * 65 + idx], st = scr[16 * 65 + 64 + idx];
#pragma unroll
        for (int kk = 0; kk < 16; ++kk) { const float w = scr[kk * 65 + c]; ac[kk] += w * ct; as[kk] += w * st; } }
    bf16* oc = WT + (size_t)(512 + g * 64 + lane) * 1024 + k0; bf16* os = WT + (size_t)(1024 + g * 64 + lane) * 1024 + k0;
#pragma unroll
    for (int q = 0; q < 2; ++q) {
        u32x4 a, b; a.x = pk2(ac[8 * q], ac[8 * q + 1]); a.y = pk2(ac[8 * q + 2], ac[8 * q + 3]); a.z = pk2(ac[8 * q + 4], ac[8 * q + 5]); a.w = pk2(ac[8 * q + 6], ac[8 * q + 7]);
        b.x = pk2(as[8 * q], as[8 * q + 1]); b.y = pk2(as[8 * q + 2], as[8 * q + 3]); b.z = pk2(as[8 * q + 4], as[8 * q + 5]); b.w = pk2(as[8 * q + 6], as[8 * q + 7]);
        *(u32x4*)(oc + 8 * q) = a; *(u32x4*)(os + 8 * q) = b; }
    LDS_WAIT(); asm volatile("" ::: "memory");
}
__device__ __forceinline__ void cpow(float lre, float lim, float step, float e, float& re, float& im) {
    const float mag = __expf(e * lre * step); float tr = e * (lim * step * 0.15915494309189535f); tr -= floorf(tr);
    re = mag * cospif(2.f * tr); im = mag * sinpif(2.f * tr);
}
__device__ __forceinline__ void s5_k(float lre, float lim, float step, float& kr, float& ki) {
    const float zr = lre * step, zi = lim * step;
    if (zr * zr + zi * zi < 0.01f) {
        float pr = 1.f, pi = 0.f, sr = 1.f, si = 0.f; const float inv[4] = {0.5f, 1.f / 6.f, 1.f / 24.f, 1.f / 120.f};
#pragma unroll
        for (int q = 0; q < 4; ++q) { const float nr = pr * zr - pi * zi, ni = pr * zi + pi * zr; pr = nr; pi = ni; sr += pr * inv[q]; si += pi * inv[q]; }
        kr = step * sr; ki = step * si;
    } else { float ar, ai; cpow(lre, lim, step, 1.f, ar, ai); ar -= 1.f; const float den = lre * lre + lim * lim; kr = (ar * lre + ai * lim) / den; ki = (ai * lre - ar * lim) / den; }
}

__device__ __forceinline__ void prologue(CArgs& A, unsigned char* lds) {
    const int tid = opaque_tid(), lane = tid & 63, wave = tid >> 6, G = gridDim.x;
    const int gw = blockIdx.x * 8 + wave, NGW = G * 8;
    const int gt = blockIdx.x * 512 + tid, NGT = G * 512;
    unsigned char* ws = A.ws;
    float* scr = (float*)(lds + wave * 17408);
    for (int item = blockIdx.x; item < 384; item += G) {
        const int layer = item / 192, rem = item - layer * 192, n0 = (rem >> 2) * 128, kq = rem & 3;
        float* sc = (float*)lds;
        float* red = (float*)(lds + 9216);
        __syncthreads();
        for (int i = tid; i < 9 * 256; i += 512) { const int r = i >> 8, k = kq * 256 + (i & 255); const float v = r == 0 ? A.in[7][k] : A.in[6][(r - 1) * 1024 + k]; sc[i] = silu_f(v); }
        const float* W = A.in[8] + ((size_t)layer * 1024 + kq * 256 + wave * 32) * 6144 + n0 + 2 * lane;
        float wx[32], wy[32];
#pragma unroll
        for (int u = 0; u < 32; ++u) { const float* p = W + (size_t)u * 6144; wx[u] = p[0]; wy[u] = p[1]; }
        __syncthreads();
        float ax[9], ay[9];
#pragma unroll
        for (int r = 0; r < 9; ++r) { ax[r] = 0.f; ay[r] = 0.f; }
#pragma unroll
        for (int u = 0; u < 32; ++u)
#pragma unroll
            for (int r = 0; r < 9; ++r) { const float s = sc[r * 256 + wave * 32 + u]; ax[r] += s * wx[u]; ay[r] += s * wy[u]; }
#pragma unroll
        for (int r = 0; r < 9; ++r) { red[(wave * 9 + r) * 128 + 2 * lane] = ax[r]; red[(wave * 9 + r) * 128 + 2 * lane + 1] = ay[r]; }
        __syncthreads();
        for (int i = tid; i < 9 * 128; i += 512) { const int r = i >> 7, l = i & 127; float s = kq == 0 ? A.in[9][layer * 6144 + n0 + l] : 0.f;
#pragma unroll
            for (int w = 0; w < 8; ++w) s += red[(w * 9 + r) * 128 + l];
            atomicAdd(((float*)(ws + WS_MODV)) + (layer * 9 + r) * 6144 + n0 + l, s); }
    }
    __syncthreads();
    transpose_all<1>(A.in[16], 1024, 2824, 2824, (bf16*)(ws + WS_WEVIN), scr, gw, NGW, lane);
    transpose_all<0>(A.in[24], 1024, 1024, 1024, (bf16*)(ws + WS_WEVOUT), scr, gw, NGW, lane);
    transpose_all<0>(A.in[25], 1024, 512, 1024, (bf16*)(ws + WS_WODIN), scr, gw, NGW, lane);
    transpose_all<0>(A.in[36], 1024, 1024, 1024, (bf16*)(ws + WS_WODOUT), scr, gw, NGW, lane);
    transpose_all<0>(A.in[34], 512, 512, 512, (bf16*)(ws + WS_WGLU), scr, gw, NGW, lane);
    transpose_all<2>(A.in[12], 1024, 2816, 2816, (bf16*)(ws + WS_WFUP), scr, gw, NGW, lane);
    transpose_all<3>(A.in[13], 1024, 2816, 2816, (bf16*)(ws + WS_WFUP), scr, gw, NGW, lane);
    transpose_all<0>(A.in[14], 2816, 1024, 1024, (bf16*)(ws + WS_WFDN), scr, gw, NGW, lane);
    for (int it = gw; it < 512; it += NGW) fold_item(A.in[25], (bf16*)(ws + WS_WODIN), scr, it, lane);
    { u32x4* z = (u32x4*)(ws + WS_WEVIN + (size_t)2824 * 1024 * 2); const int n16 = 248 * 1024 * 2 / 16; for (int i = gt; i < n16; i += NGT) z[i] = (u32x4){0u, 0u, 0u, 0u}; }
    { bf16* DC = (bf16*)(ws + WS_DFTC); const float sc2 = 0.0625f;
      for (int i = gt; i < 256 * 32; i += NGT) { const int k = i >> 5, l0 = (i & 31) * 8; float c[8], s[8];
#pragma unroll
        for (int e = 0; e < 8; ++e) { const int m = (k * (l0 + e)) & 255; const float x = m * (1.f / 128.f); c[e] = cospif(x) * sc2; s[e] = -sinpif(x) * sc2; }
        u32x4 a, b; a.x = pk2(c[0], c[1]); a.y = pk2(c[2], c[3]); a.z = pk2(c[4], c[5]); a.w = pk2(c[6], c[7]); b.x = pk2(s[0], s[1]); b.y = pk2(s[2], s[3]); b.z = pk2(s[4], s[5]); b.w = pk2(s[6], s[7]);
        *(u32x4*)(DC + (size_t)k * 512 + l0) = a; *(u32x4*)(DC + (size_t)k * 512 + 256 + l0) = b; } }
}

__device__ __forceinline__ void gen_dftl(unsigned char* ws, int vb, int VG) {
    const int gt = vb * 512 + opaque_tid(), NGT = VG * 512;
    bf16* DL = (bf16*)(ws + WS_DFTL); const float sc = 0.02209708691207961f;
    for (int i = gt; i < 2048 * 256; i += NGT) { const int k = i >> 8, l0 = (i & 255) * 8; float c[8], s[8];
#pragma unroll
        for (int e = 0; e < 8; ++e) { const int m = (k * (l0 + e)) & 2047; const float x = m * (1.f / 1024.f); c[e] = cospif(x) * sc; s[e] = -sinpif(x) * sc; }
        u32x4 a, b; a.x = pk2(c[0], c[1]); a.y = pk2(c[2], c[3]); a.z = pk2(c[4], c[5]); a.w = pk2(c[6], c[7]); b.x = pk2(s[0], s[1]); b.y = pk2(s[2], s[3]); b.z = pk2(s[4], s[5]); b.w = pk2(s[6], s[7]);
        *(u32x4*)(DL + (size_t)k * 4096 + l0) = a; *(u32x4*)(DL + (size_t)k * 4096 + 2048 + l0) = b; }
}

__device__ __forceinline__ void gen_s5(CArgs& A, unsigned char* lds, int vb, int VG) {
    const int tid = opaque_tid(); const int gt = vb * 512 + tid, NGT = VG * 512; unsigned char* ws = A.ws;
    { const float* lamr = A.in[26]; const float* lami = A.in[27]; const float* lstep = A.in[28];
      const float* bre = A.in[29]; const float* bim = A.in[30]; const float* cre = A.in[31]; const float* cim = A.in[32]; const float* dsk = A.in[33];
      bf16* WY = (bf16*)(ws + WS_WWY); bf16* BS = (bf16*)(ws + WS_WBS);
      { float* Qr = (float*)lds; float* Qi = Qr + 2048; float* Tt = Qi + 2048;
        for (int item = vb; item < 512; item += VG) {
          const int g = item >> 4, tau = item & 15;
          __syncthreads();
#pragma unroll
          for (int q = 0; q < 4; ++q) { const int e = tid + 512 * q, d = e >> 10, p = (e >> 4) & 63, cp = e & 15;
              const float step = __expf(lstep[d * 32 + g]); const float lre = lamr[(d * 32 + g) * 64 + p], lim = lami[(d * 32 + g) * 64 + p];
              float kr, ki; s5_k(lre, lim, step, kr, ki); float pr, pi; cpow(lre, lim, step, (float)tau, pr, pi);
              const float br = bre[(g * 64 + p) * 16 + cp], bi = bim[(g * 64 + p) * 16 + cp];
              const float tbr = kr * br - ki * bi, tbi = kr * bi + ki * br;
              Qr[e] = pr * tbr - pi * tbi; Qi[e] = pr * tbi + pi * tbr; }
          __syncthreads();
          { const int d = tid >> 8, c = (tid >> 4) & 15, cp = tid & 15; float acc = 0.f;
            for (int p = 0; p < 64; ++p) acc += cre[(g * 16 + c) * 64 + p] * Qr[(d * 64 + p) * 16 + cp] - cim[(g * 16 + c) * 64 + p] * Qi[(d * 64 + p) * 16 + cp];
            Tt[tid] = acc; }
          __syncthreads();
          if (tid < 256) { const int c = tid >> 4, cp = tid & 15; const float t0 = Tt[tid], t1 = Tt[256 + tid];
              bf16* base = WY + (size_t)g * 256 * 512;
              if (tau == 0) { const float v = t0 + t1 + (c == cp ? dsk[g * 16 + c] : 0.f); for (int ii = 0; ii < 16; ++ii) base[(size_t)(ii * 16 + c) * 512 + ii * 16 + cp] = (bf16)f2bf(v); }
              else { for (int ii = tau; ii < 16; ++ii) base[(size_t)(ii * 16 + c) * 512 + (ii - tau) * 16 + cp] = (bf16)f2bf(t0);
                     for (int ii = 0; ii < 16 - tau; ++ii) base[(size_t)(ii * 16 + c) * 512 + (ii + tau) * 16 + cp] = (bf16)f2bf(t1); } }
        }
        __syncthreads(); }
      for (int i = gt; i < 32 * 16 * 16 * 128; i += NGT) {
          const int p = i & 63, d = (i >> 6) & 1, c = (i >> 7) & 15, ii = (i >> 11) & 15, g = i >> 15;
          const float step = __expf(lstep[d * 32 + g]); const float lre = lamr[(d * 32 + g) * 64 + p], lim = lami[(d * 32 + g) * 64 + p];
          float pr, pi; cpow(lre, lim, step, d == 0 ? (float)(ii + 1) : (float)(16 - ii), pr, pi);
          const float cr = cre[(g * 16 + c) * 64 + p], ci = cim[(g * 16 + c) * 64 + p];
          const float vr = cr * pr - ci * pi, vi = cr * pi + ci * pr;
          bf16* rowp = WY + ((size_t)g * 256 + ii * 16 + c) * 512 + 256 + d * 128;
          rowp[p] = (bf16)f2bf(vr); rowp[64 + p] = (bf16)f2bf(-vi);
      }
      for (int i = gt; i < 32 * 2 * 64 * 256; i += NGT) {
          const int cp = i & 15, j = (i >> 4) & 15, p = (i >> 8) & 63, d = (i >> 14) & 1, g = i >> 15;
          const float step = __expf(lstep[d * 32 + g]); const float lre = lamr[(d * 32 + g) * 64 + p], lim = lami[(d * 32 + g) * 64 + p];
          float kr, ki; s5_k(lre, lim, step, kr, ki); float pr, pi; cpow(lre, lim, step, d == 0 ? (float)(15 - j) : (float)j, pr, pi);
          const float br = bre[(g * 64 + p) * 16 + cp], bi = bim[(g * 64 + p) * 16 + cp];
          const float tbr = kr * br - ki * bi, tbi = kr * bi + ki * br;
          bf16* o = BS + ((size_t)g * 256 + d * 128 + p) * 256 + j * 16 + cp;
          o[0] = (bf16)f2bf(pr * tbr - pi * tbi); o[(size_t)64 * 256] = (bf16)f2bf(pr * tbi + pi * tbr);
      }
    }
}

__device__ __forceinline__ void normpass0(const float* xp, const float* xs, const float* gam, const float* scale, bf16* H, float* rss) {
    const int tid_ = opaque_tid(); const int lane = tid_ & 63, gw = blockIdx.x * 8 + (tid_ >> 6), NGW = gridDim.x * 8;
    for (int row = gw; row < T; row += NGW) {
        const float* xr = row < TC ? xp + (size_t)row * D : xs + (size_t)(row - TC) * D;
        f32x4 v[4]; float s = 0.f;
#pragma unroll
        for (int j = 0; j < 4; ++j) { v[j] = *(const f32x4*)(xr + 4 * lane + 256 * j); s += (v[j][0] * v[j][0] + v[j][1] * v[j][1]) + (v[j][2] * v[j][2] + v[j][3] * v[j][3]); }
        s = wave_sum(s); if (lane == 0) rss[row] = s;
        const int mr = mod_row(row);
#pragma unroll
        for (int j = 0; j < 4; ++j) { const int c = 4 * lane + 256 * j; const f32x4 g = *(const f32x4*)(gam + c), sc = *(const f32x4*)(scale + mr * 6144 + c);
            const f32x4 y = v[j] * g * (sc + 1.f); u32x2 w; w.x = cvt_pk_bf16(y[0], y[1]); w.y = cvt_pk_bf16(y[2], y[3]); *(u32x2*)(H + (size_t)row * D + c) = w; }
    }
}
__device__ __forceinline__ void sw_compute(const bf16* WT, int N, const float* shift, float* SWo, float* sh, int gw0, int NGW0) {
    const int tid = opaque_tid(), lane = tid & 63;
    __syncthreads();
    for (int i = tid; i < 9 * 1024; i += 512) sh[i] = shift[(i >> 10) * 6144 + (i & 1023)];
    __syncthreads();
    for (int n = gw0; n < N; n += NGW0) {
        float w[16];
#pragma unroll
        for (int j = 0; j < 4; ++j) { const u32x2 a = *(const u32x2*)(WT + (size_t)n * 1024 + 4 * lane + 256 * j); w[4 * j] = bflo(a.x); w[4 * j + 1] = bfhi(a.x); w[4 * j + 2] = bflo(a.y); w[4 * j + 3] = bfhi(a.y); }
#pragma unroll
        for (int r = 0; r < 9; ++r) { float s = 0.f;
#pragma unroll
            for (int j = 0; j < 4; ++j) { const f32x4 q = *(const f32x4*)(sh + r * 1024 + 4 * lane + 256 * j); s += (w[4 * j] * q[0] + w[4 * j + 1] * q[1]) + (w[4 * j + 2] * q[2] + w[4 * j + 3] * q[3]); }
            s = wave_sum(s); if (lane == 0) SWo[r * N + n] = s; }
    }
    __syncthreads();
}
__device__ __forceinline__ void final_norm_phase(float* XR, const float* gam, const float* rss) {
    const int tid_ = opaque_tid(); const int lane = tid_ & 63, gw = blockIdx.x * 8 + (tid_ >> 6), NGW = gridDim.x * 8;
    for (int row = gw; row < T; row += NGW) {
        float* xr = XR + (size_t)row * D; const float rstd = rsqrtf(rss[row] * (1.f / D) + 1e-6f);
#pragma unroll
        for (int j = 0; j < 4; ++j) { const int c = 4 * lane + 256 * j; const f32x4 g = *(const f32x4*)(gam + c); *(f32x4*)(xr + c) = *(const f32x4*)(xr + c) * rstd * g; }
    }
}
__device__ __forceinline__ void gate_phase(const bf16* YD, bf16* PROJ, const float* gam) {
    const int tid_ = opaque_tid(); const int lane = tid_ & 63, gw = blockIdx.x * 8 + (tid_ >> 6), NGW = gridDim.x * 8;
    for (int row = gw; row < T; row += NGW) {
        const u32x4 a = *(const u32x4*)(YD + (size_t)row * 512 + 8 * lane), b = *(const u32x4*)(YD + ((size_t)T + row) * 512 + 8 * lane), z = *(const u32x4*)(PROJ + (size_t)row * PLD + 8 * lane);
        float y[8];
        y[0] = (bflo(a.x) + bflo(b.x)) * silu_f(bflo(z.x)); y[1] = (bfhi(a.x) + bfhi(b.x)) * silu_f(bfhi(z.x));
        y[2] = (bflo(a.y) + bflo(b.y)) * silu_f(bflo(z.y)); y[3] = (bfhi(a.y) + bfhi(b.y)) * silu_f(bfhi(z.y));
        y[4] = (bflo(a.z) + bflo(b.z)) * silu_f(bflo(z.z)); y[5] = (bfhi(a.z) + bfhi(b.z)) * silu_f(bfhi(z.z));
        y[6] = (bflo(a.w) + bflo(b.w)) * silu_f(bflo(z.w)); y[7] = (bfhi(a.w) + bfhi(b.w)) * silu_f(bfhi(z.w));
        float s = 0.f;
#pragma unroll
        for (int e = 0; e < 8; ++e) s += y[e] * y[e];
        const float rstd = rsqrtf(wave_sum(s) * (1.f / 512.f) + 1e-6f);
        const f32x4 g0 = *(const f32x4*)(gam + 8 * lane), g1 = *(const f32x4*)(gam + 8 * lane + 4);
        u32x4 o; o.x = cvt_pk_bf16(y[0] * rstd * g0[0], y[1] * rstd * g0[1]); o.y = cvt_pk_bf16(y[2] * rstd * g0[2], y[3] * rstd * g0[3]);
        o.z = cvt_pk_bf16(y[4] * rstd * g1[0], y[5] * rstd * g1[1]); o.w = cvt_pk_bf16(y[6] * rstd * g1[2], y[7] * rstd * g1[3]);
        *(u32x4*)(PROJ + (size_t)row * PLD + 8 * lane) = o;
    }
}

__device__ __forceinline__ void conv_phase(CArgs& A) {
    const int gt = blockIdx.x * 512 + opaque_tid(), NGT = gridDim.x * 512;
    const bf16* PROJ = (const bf16*)(A.ws + WS_R2); bf16* XC = (bf16*)(A.ws + WS_XC); const float* cw = A.in[17]; const float* cb = A.in[18];
    for (int i = gt; i < (T / 4) * 96; i += NGT) {
        const int tq = i / 96, cg8 = i - tq * 96, t0 = tq * 4, ch = cg8 * 8;
        const int L = t0 < TC ? 256 : 2048, tl = t0 < TC ? (t0 & 255) : ((t0 - TC) & 2047);
        u32x4 raw[8];
#pragma unroll
        for (int q = 0; q < 8; ++q) { const int dt = q - 2; const int tt = min(max(tl + dt, 0), L - 1); raw[q] = *(const u32x4*)(PROJ + (size_t)(t0 - tl + tt) * PLD + PX + ch); }
        f32x4 w0[5], w1[5];
#pragma unroll
        for (int wv = 0; wv < 5; ++wv) { w0[wv] = *(const f32x4*)(cw + wv * 768 + ch); w1[wv] = *(const f32x4*)(cw + wv * 768 + ch + 4); }
        const f32x4 b0 = *(const f32x4*)(cb + ch), b1 = *(const f32x4*)(cb + ch + 4);
#pragma unroll
        for (int o = 0; o < 4; ++o) { f32x4 a0 = b0, a1 = b1;
#pragma unroll
            for (int wv = 0; wv < 5; ++wv) { const int tt = tl + o + wv - 2; const float mk = (tt >= 0 && tt < L) ? 1.f : 0.f; const u32x4 rw = raw[o + wv];
                const f32x4 x0 = {bflo(rw.x), bfhi(rw.x), bflo(rw.y), bfhi(rw.y)}, x1 = {bflo(rw.z), bfhi(rw.z), bflo(rw.w), bfhi(rw.w)};
                a0 = a0 + w0[wv] * x0 * mk; a1 = a1 + w1[wv] * x1 * mk; }
            f32x4 s0, s1;
#pragma unroll
            for (int e = 0; e < 4; ++e) { s0[e] = silu_f(a0[e]); s1[e] = silu_f(a1[e]); }
            *(u32x4*)(XC + (size_t)(t0 + o) * 768 + ch) = pack8(s0, s1); }
    }
}

__device__ __forceinline__ void ssd_item(CArgs& A, unsigned char* lds, int item) {
    const int tid = opaque_tid(), lane = tid & 63, w = __builtin_amdgcn_readfirstlane(tid >> 6), fr = lane & 15, fq = lane >> 4;
    int seq, dir, h, L, tok0, nch; bool lat;
    if (item < 128) { lat = true; seq = item >> 4; dir = (item >> 3) & 1; h = item & 7; L = 2048; tok0 = TC + seq * 2048; nch = 16; }
    else { const int it = item - 128; lat = false; seq = it >> 4; dir = (it >> 3) & 1; h = it & 7; L = 256; tok0 = seq * 256; nch = 2; }
    const int g = h >> 2;
    bf16* Cm = (bf16*)lds; bf16* Bm = Cm + 128 * 72; bf16* XT = Bm + 128 * 72; bf16* BT = XT + 64 * 136; bf16* Mm = BT + 64 * 136; bf16* ST = Mm + 128 * 136;
    float* cum = (float*)(ST + 64 * 72); float* dtv = cum + 128; float* da = dtv + 128;
    const bf16* PROJ = (const bf16*)(A.ws + WS_R2); const float* DT = (const float*)(A.ws + WS_DT); bf16* YD = (bf16*)(A.ws + WS_R1);
    const int pt = w >> 1, nt0 = 2 * (w & 1);
    f32x4 st[2];
#pragma unroll
    for (int q = 0; q < 2; ++q)
#pragma unroll
        for (int r = 0; r < 4; ++r) { const int p = 16 * pt + 4 * fq + r, n = 16 * (nt0 + q) + fr; st[q][r] = lat ? A.in[4][(size_t)((seq * 2 + dir) * 8 + h) * 4096 + p * 64 + n] : 0.f; }
    const float Aneg = -__expf(A.in[19][dir * 8 + h]); const float dtb = A.in[20][dir * 8 + h]; const float Dh = A.in[21][h];
    const bf16* XC = (const bf16*)(A.ws + WS_XC);
    u32x4 raw[6]; float dtr = 0.f;
#define SSD_FETCH(C_) do { int tl_ = tid; asm volatile("" : "+v"(tl_)); \
        _Pragma("unroll") for (int it = 0; it < 6; ++it) { const int idx = tl_ + 512 * it; const int j = idx & 127, cgp = idx >> 7; const int t = dir ? (L - 1 - ((C_) * 128 + j)) : ((C_) * 128 + j); \
            const int ch = cgp < 8 ? h * 64 + cgp * 8 : (cgp < 16 ? 512 + g * 64 + (cgp - 8) * 8 : 640 + g * 64 + (cgp - 16) * 8); \
            raw[it] = *(const u32x4*)(XC + (size_t)(tok0 + t) * 768 + ch); } \
        if (tl_ < 128) { const int t = dir ? (L - 1 - ((C_) * 128 + tl_)) : ((C_) * 128 + tl_); dtr = DT[(size_t)(tok0 + t) * 8 + h]; } } while (0)
    SSD_FETCH(0);
    for (int c = 0; c < nch; ++c) {
        int tl = tid; asm volatile("" : "+v"(tl));
        float dav = 0.f;
        if (tid < 128) { const float x = dtr + dtb; const float dt = x > 20.f ? x : log1pf(__expf(x)); dtv[tid] = dt; dav = dt * Aneg;
#pragma unroll
            for (int o = 1; o < 64; o <<= 1) { const float tv = __shfl_up(dav, o); if (lane >= o) dav += tv; }
            if (tid == 63) da[0] = dav; }
#pragma unroll
        for (int q = 0; q < 2; ++q)
#pragma unroll
            for (int r = 0; r < 4; ++r) ST[(16 * pt + 4 * fq + r) * 72 + 16 * (nt0 + q) + fr] = (bf16)f2bf(st[q][r]);
        __syncthreads();
        if (tid < 128) { if (tid >= 64) dav += da[0]; cum[tid] = dav; }
        __syncthreads();
        const float cl = cum[127];
#pragma unroll
        for (int it = 0; it < 6; ++it) { const int idx = tl + 512 * it; const int j = idx & 127, cgp = idx >> 7; const u32x4 rw = raw[it];
            if (cgp < 8) { const float dt = dtv[j];
                const float v[8] = {bflo(rw.x) * dt, bfhi(rw.x) * dt, bflo(rw.y) * dt, bfhi(rw.y) * dt, bflo(rw.z) * dt, bfhi(rw.z) * dt, bflo(rw.w) * dt, bfhi(rw.w) * dt};
#pragma unroll
                for (int e = 0; e < 8; ++e) XT[(cgp * 8 + e) * 136 + j] = (bf16)f2bf(v[e]); }
            else if (cgp < 16) { const float te = __expf(cl - cum[j]); const int n0 = (cgp - 8) * 8;
                *(u32x4*)(Bm + j * 72 + n0) = rw;
                const float v[8] = {bflo(rw.x) * te, bfhi(rw.x) * te, bflo(rw.y) * te, bfhi(rw.y) * te, bflo(rw.z) * te, bfhi(rw.z) * te, bflo(rw.w) * te, bfhi(rw.w) * te};
#pragma unroll
                for (int e = 0; e < 8; ++e) BT[(n0 + e) * 136 + j] = (bf16)f2bf(v[e]); }
            else { *(u32x4*)(Cm + j * 72 + (cgp - 16) * 8) = rw; }
        }
        if (c + 1 < nch) SSD_FETCH(c + 1);
        __syncthreads();
        {
            const bf16x8 af0 = ldfrag(Cm + 16 * w * 72, 72, lane, 0), af1 = ldfrag(Cm + 16 * w * 72, 72, lane, 1);
            for (int jt = 0; jt < 8; ++jt) { f32x4 acc = (f32x4){0.f, 0.f, 0.f, 0.f};
                acc = mma16(af0, ldfrag(Bm + 16 * jt * 72, 72, lane, 0), acc); acc = mma16(af1, ldfrag(Bm + 16 * jt * 72, 72, lane, 1), acc);
#pragma unroll
                for (int r = 0; r < 4; ++r) { const int i = 16 * w + 4 * fq + r, j = 16 * jt + fr; float v = (j <= i) ? acc[r] * __expf(cum[i] - cum[j]) : 0.f; if (dir == 0 && i == j) v += Dh / dtv[i]; Mm[i * 136 + j] = (bf16)f2bf(v); } }
        }
        __syncthreads();
        {
            f32x4 yd[4], yo[4];
#pragma unroll
            for (int q = 0; q < 4; ++q) { yd[q] = (f32x4){0.f, 0.f, 0.f, 0.f}; yo[q] = (f32x4){0.f, 0.f, 0.f, 0.f}; }
#pragma unroll
            for (int ks = 0; ks < 4; ++ks) { if (32 * ks <= 16 * w + 15) { const bf16x8 am = ldfrag(Mm + 16 * w * 136, 136, lane, ks);
#pragma unroll
                for (int q = 0; q < 4; ++q) yd[q] = mma16(am, ldfrag(XT + 16 * q * 136, 136, lane, ks), yd[q]); } }
#pragma unroll
            for (int ks = 0; ks < 2; ++ks) { const bf16x8 ac = ldfrag(Cm + 16 * w * 72, 72, lane, ks);
#pragma unroll
                for (int q = 0; q < 4; ++q) yo[q] = mma16(ac, ldfrag(ST + 16 * q * 72, 72, lane, ks), yo[q]); }
#pragma unroll
            for (int r = 0; r < 4; ++r) { const int i = 16 * w + 4 * fq + r; const float ec = __expf(cum[i]); const int t = dir ? (L - 1 - (c * 128 + i)) : (c * 128 + i);
                bf16* yp = YD + ((size_t)dir * T + tok0 + t) * 512 + h * 64 + fr;
#pragma unroll
                for (int q = 0; q < 4; ++q) yp[16 * q] = (bf16)f2bf(yd[q][r] + ec * yo[q][r]); }
        }
        {
            const float cd = __expf(cl);
#pragma unroll
            for (int q = 0; q < 2; ++q) st[q] = st[q] * cd;
#pragma unroll
            for (int ks = 0; ks < 4; ++ks) { const bf16x8 ax = ldfrag(XT + 16 * pt * 136, 136, lane, ks);
#pragma unroll
                for (int q = 0; q < 2; ++q) st[q] = mma16(ax, ldfrag(BT + 16 * (nt0 + q) * 136, 136, lane, ks), st[q]); }
        }
        __syncthreads();
    }
#undef SSD_FETCH
    if (!lat) {
#pragma unroll
        for (int q = 0; q < 2; ++q)
#pragma unroll
            for (int r = 0; r < 4; ++r) { const int p = 16 * pt + 4 * fq + r, n = 16 * (nt0 + q) + fr; A.out[O_SSD + (size_t)((seq * 2 + dir) * 8 + h) * 4096 + p * 64 + n] = st[q][r]; }
    }
}

template <int CTRL> __device__ __forceinline__ float dpp_f(float v) { return __builtin_bit_cast(float, __builtin_amdgcn_update_dpp(0, __builtin_bit_cast(int, v), CTRL, 0xF, 0xF, true)); }
__device__ __forceinline__ float red16_max(float v) { v = fmaxf(v, dpp_f<0xB1>(v)); v = fmaxf(v, dpp_f<0x4E>(v)); v = fmaxf(v, dpp_f<0x141>(v)); v = fmaxf(v, dpp_f<0x140>(v)); return v; }
__device__ __forceinline__ float red16_sum(float v) { v += dpp_f<0xB1>(v); v += dpp_f<0x4E>(v); v += dpp_f<0x141>(v); v += dpp_f<0x140>(v); return v; }
__device__ __forceinline__ void attn_pair(CArgs& A, unsigned char* lds, int pairidx) {
    const int tid = opaque_tid(), half = __builtin_amdgcn_readfirstlane(tid >> 8), ht = tid & 255, lane = tid & 63, w = __builtin_amdgcn_readfirstlane((tid >> 6) & 3), fr = lane & 15, fq = lane >> 4;
    unsigned char* hl = lds + half * 49152;
    bf16* Ksb = (bf16*)hl; bf16* Vtb = Ksb + 2 * 64 * 72; bf16* Ps = Vtb + 2 * 64 * 72 + w * 16 * 72; float* rp = (float*)(hl + 46080);
    bf16* PROJ = (bf16*)(A.ws + WS_R2);
    const int item = pairidx * 2 + half;
    const bool lat = item < 2048;
    int b, h, r = 0, rs = 0, qtok0, ntiles;
    if (lat) { b = item >> 8; h = (item >> 5) & 7; r = item & 31; qtok0 = TC + b * 2048 + r * 64; rs = min(max(r - 4, 0), 24); ntiles = 12; }
    else { const int it = item - 2048; b = it >> 5; h = (it >> 2) & 7; const int qb = it & 3; qtok0 = b * 256 + qb * 64; ntiles = 4; }
    for (int i = ht; i < 465; i += 256) rp[i] = A.in[23][h * 465 + i];
    bf16x8 qf[2];
    { const bf16* qp = PROJ + (size_t)(qtok0 + 16 * w + fr) * PLD + PQ + h * 64 + fq * 8; qf[0] = *(const bf16x8*)qp; qf[1] = *(const bf16x8*)(qp + 32); }
    f32x4 o[4]; float m[4], l[4];
#pragma unroll
    for (int q = 0; q < 4; ++q) { o[q] = (f32x4){0.f, 0.f, 0.f, 0.f}; m[q] = -1e30f; l[q] = 0.f; }
    int bio[4][4];
#pragma unroll
    for (int t = 0; t < 4; ++t)
#pragma unroll
        for (int rr = 0; rr < 4; ++rr) { const int qc = 16 * w + 4 * fq + rr, kc = 16 * t + fr; const int cs = min(max(qc - 8, 0), 48); bio[t][rr] = ((kc >= cs) && (kc < cs + 16)) ? (kc - qc + 15) : -1; }
    const int tlo = max(w - 1, 0), thi = min(w + 1, 3);
    f32x4 pf[2][4];
#define ATT_PREFETCH(TI) do { _Pragma("unroll") for (int u_ = 0; u_ < 2; ++u_) { const int idx_ = ht + 256 * u_; const int key_ = idx_ & 63, dc_ = idx_ >> 6; \
        if (lat && (TI) >= 8) { const size_t off_ = (((size_t)b * 256 + ((TI) - 8) * 64 + key_) * 8 + h) * 64 + dc_ * 8; \
            pf[u_][0] = *(const f32x4*)(A.in[2] + off_); pf[u_][1] = *(const f32x4*)(A.in[2] + off_ + 4); pf[u_][2] = *(const f32x4*)(A.in[3] + off_); pf[u_][3] = *(const f32x4*)(A.in[3] + off_ + 4); } \
        else { const size_t tok_ = lat ? (size_t)(TC + b * 2048 + (rs + (TI)) * 64 + key_) : (size_t)(b * 256 + (TI) * 64 + key_); \
            pf[u_][0] = *(const f32x4*)(PROJ + tok_ * PLD + PK + h * 64 + dc_ * 8); pf[u_][1] = *(const f32x4*)(PROJ + tok_ * PLD + PV + h * 64 + dc_ * 8); } } } while (0)
    ATT_PREFETCH(0);
    for (int ti = 0; ti < ntiles; ++ti) {
        bf16* Ks = Ksb + (ti & 1) * 64 * 72; bf16* Vt = Vtb + (ti & 1) * 64 * 72;
#pragma unroll
        for (int u = 0; u < 2; ++u) { const int idx = ht + 256 * u; const int key = idx & 63, dc = idx >> 6; u32x4 kv, vv;
            if (lat && ti >= 8) { kv.x = pk2(pf[u][0][0], pf[u][0][1]); kv.y = pk2(pf[u][0][2], pf[u][0][3]); kv.z = pk2(pf[u][1][0], pf[u][1][1]); kv.w = pk2(pf[u][1][2], pf[u][1][3]);
                vv.x = pk2(pf[u][2][0], pf[u][2][1]); vv.y = pk2(pf[u][2][2], pf[u][2][3]); vv.z = pk2(pf[u][3][0], pf[u][3][1]); vv.w = pk2(pf[u][3][2], pf[u][3][3]); }
            else { kv = __builtin_bit_cast(u32x4, pf[u][0]); vv = __builtin_bit_cast(u32x4, pf[u][1]); }
            *(u32x4*)(Ks + key * 72 + dc * 8) = kv;
            bf16* vt = Vt + (dc * 8) * 72 + key;
            vt[0] = (bf16)(vv.x & 0xffff); vt[72] = (bf16)(vv.x >> 16); vt[144] = (bf16)(vv.y & 0xffff); vt[216] = (bf16)(vv.y >> 16);
            vt[288] = (bf16)(vv.z & 0xffff); vt[360] = (bf16)(vv.z >> 16); vt[432] = (bf16)(vv.w & 0xffff); vt[504] = (bf16)(vv.w >> 16); }
        if (ti + 1 < ntiles) ATT_PREFETCH(ti + 1);
        __syncthreads();
        const bool loc = lat && ti < 8;
        f32x4 s[4];
#pragma unroll
        for (int t = 0; t < 4; ++t) {
            if (!loc || (t >= tlo && t <= thi)) { s[t] = (f32x4){0.f, 0.f, 0.f, 0.f};
#pragma unroll
                for (int ks = 0; ks < 2; ++ks) s[t] = mma16(qf[ks], ldfrag(Ks + 16 * t * 72, 72, lane, ks), s[t]);
                if (loc) { const float* rpr = rp + (rs + ti - r + 7) * 31;
#pragma unroll
                    for (int rr = 0; rr < 4; ++rr) s[t][rr] = bio[t][rr] >= 0 ? s[t][rr] + rpr[bio[t][rr]] : -1e30f; } }
            else s[t] = (f32x4){-1e30f, -1e30f, -1e30f, -1e30f}; }
#pragma unroll
        for (int rr = 0; rr < 4; ++rr) {
            float mx = red16_max(fmaxf(fmaxf(s[0][rr], s[1][rr]), fmaxf(s[2][rr], s[3][rr])));
            const float mn = fmaxf(m[rr], mx); const float al = __expf(m[rr] - mn); m[rr] = mn; float sum = 0.f;
#pragma unroll
            for (int t = 0; t < 4; ++t) { const float p = (!loc || (t >= tlo && t <= thi)) ? __expf(s[t][rr] - mn) : 0.f; s[t][rr] = p; sum += p; }
            sum = red16_sum(sum);
            l[rr] = l[rr] * al + sum;
#pragma unroll
            for (int q = 0; q < 4; ++q) o[q][rr] *= al;
        }
#pragma unroll
        for (int t = 0; t < 4; ++t)
#pragma unroll
            for (int rr = 0; rr < 4; ++rr) Ps[(4 * fq + rr) * 72 + 16 * t + fr] = (bf16)f2bf(s[t][rr]);
        LDS_WAIT(); asm volatile("" ::: "memory");
#pragma unroll
        for (int ks = 0; ks < 2; ++ks) { if (!loc || (2 * ks + 1 >= tlo && 2 * ks <= thi)) { const bf16x8 pa = ldfrag(Ps, 72, lane, ks);
#pragma unroll
            for (int q = 0; q < 4; ++q) o[q] = mma16(pa, ldfrag(Vt + 16 * q * 72, 72, lane, ks), o[q]); } }
    }
#undef ATT_PREFETCH
#pragma unroll
    for (int rr = 0; rr < 4; ++rr) { const float inv = 1.f / l[rr]; bf16* op = PROJ + (size_t)(qtok0 + 16 * w + 4 * fq + rr) * PLD + PQ + h * 64 + fr;
#pragma unroll
        for (int q = 0; q < 4; ++q) op[16 * q] = (bf16)f2bf(o[q][rr] * inv); }
}

__device__ __forceinline__ void s5_scan_phase(CArgs& A) {
    const int gt = blockIdx.x * 512 + opaque_tid(), NGT = gridDim.x * 512;
    const float* Sloc = (const float*)(A.ws + WS_R1); bf16* A2 = (bf16*)(A.ws + WS_R2 + R2_A2);
    for (int idx = gt; idx < 163840; idx += NGT) {
        const bool lat = idx < 32768; const int i2 = lat ? idx : idx - 32768;
        const int b = i2 >> 12, rem = i2 & 4095, g = rem >> 7, d = (rem >> 6) & 1, p = rem & 63;
        const int nch = lat ? 128 : 16, chunk0 = lat ? 512 + b * 128 : b * 16, rowbase = g * 1536 + chunk0;
        const float step = __expf(A.in[28][d * 32 + g]); const float lre = A.in[26][(d * 32 + g) * 64 + p], lim = A.in[27][(d * 32 + g) * 64 + p];
        float ar, ai; cpow(lre, lim, step, 16.f, ar, ai);
        float sr = 0.f, si = 0.f;
        if (lat) { const float* s0 = A.in[5] + ((size_t)((b * 2 + d) * 32 + g) * 64 + p) * 2; sr = s0[0]; si = s0[1]; }
        for (int n0 = 0; n0 < nch; n0 += 16) {
            float xr[16], xi[16];
#pragma unroll
            for (int u = 0; u < 16; ++u) { const int n = d == 0 ? n0 + u : nch - 1 - (n0 + u); const float* sp = Sloc + (size_t)(rowbase + n) * 256 + d * 128 + p; xr[u] = sp[0]; xi[u] = sp[64]; }
#pragma unroll
            for (int u = 0; u < 16; ++u) { const int n = d == 0 ? n0 + u : nch - 1 - (n0 + u); bf16* ap = A2 + (size_t)(rowbase + n) * 512 + 256 + d * 128 + p;
                ap[0] = (bf16)f2bf(sr); ap[64] = (bf16)f2bf(si);
                const float nr = ar * sr - ai * si + xr[u], ni = ar * si + ai * sr + xi[u]; sr = nr; si = ni; }
        }
        if (!lat) { float* o = A.out + O_S5 + ((size_t)((b * 2 + d) * 32 + g) * 64 + p) * 2; o[0] = sr; o[1] = si; }
    }
}


#define XB_TMO      128
#define XB_XCNT(j)  (256  + 64 * (j))
#define XB_XSUB(j)  (1280 + 64 * (j))
#define XB_XGEN(j)  (2304 + 64 * (j))
#define XB_TOP      3328
#define XB_TOPGEN   3392
#define XB_SPIN_CAP (1u << 22)
__device__ __forceinline__ unsigned xb_ld(unsigned* p)              { return __hip_atomic_load(p, __ATOMIC_RELAXED, __HIP_MEMORY_SCOPE_AGENT); }
__device__ __forceinline__ unsigned xb_add(unsigned* p, unsigned v) { return __hip_atomic_fetch_add(p, v, __ATOMIC_RELAXED, __HIP_MEMORY_SCOPE_AGENT); }
__device__ __forceinline__ unsigned xb_xcc_id() { return (unsigned)__builtin_amdgcn_s_getreg((3 << 11) | 20) & 0xFu; }
#define XB_SPIN(cond, bar) do { unsigned _sp = 0; while (cond) { __builtin_amdgcn_s_sleep(1); \
    if ((++_sp & 255u) == 0u) { if (xb_ld(&(bar)[XB_TMO])) break; if (_sp > XB_SPIN_CAP) { atomicAdd(&(bar)[XB_TMO], 1u); break; } } } } while (0)
struct XcdBarrier { unsigned* bar; unsigned x; volatile unsigned* st; };
__device__ __forceinline__ XcdBarrier xcd_barrier_post(unsigned* bar, volatile unsigned* st) {
    XcdBarrier b; b.bar = bar; b.x = xb_xcc_id(); b.st = st;
    if (threadIdx.x == 0) (void)xb_add(&bar[XB_XCNT(b.x)], 1u);
    return b;
}
__device__ __forceinline__ void xcd_barrier_complete(unsigned* bar, unsigned x, unsigned& nloc, unsigned& nx) {
    const unsigned G = gridDim.x;
    unsigned sum, cnt, mine, sp = 0u;
    for (;;) {
        sum = 0u; cnt = 0u; mine = 0u;
#pragma unroll
        for (unsigned j = 0; j < 16; ++j) { const unsigned c = xb_ld(&bar[XB_XCNT(j)]); sum += c; cnt += (c > 0u) ? 1u : 0u; mine = (j == x) ? c : mine; }
        if (sum == G) break;
        __builtin_amdgcn_s_sleep(1);
        if ((++sp & 255u) == 0u) { if (xb_ld(&bar[XB_TMO])) break; if (sp > XB_SPIN_CAP) { atomicAdd(&bar[XB_TMO], 1u); break; } }
    }
    nloc = mine > 0u ? mine : 1u; nx = cnt > 0u ? cnt : 1u;
}
__device__ __forceinline__ void xcd_barrier(const XcdBarrier& b) {
    asm volatile("s_waitcnt vmcnt(0)" ::: "memory");
    __syncthreads();
    if (threadIdx.x == 0) {
        unsigned* bar = b.bar;
        __builtin_amdgcn_s_waitcnt(0);
        unsigned nloc = b.st[0], nx = b.st[1];
        if (nloc == 0u) { xcd_barrier_complete(bar, b.x, nloc, nx); b.st[0] = nloc; b.st[1] = nx; }
        const unsigned old = xb_add(&bar[XB_XSUB(b.x)], 1u);
        const unsigned gen = old / nloc;
        if (old + 1u == (gen + 1u) * nloc) {
            __builtin_amdgcn_fence(__ATOMIC_RELEASE, "agent");
            asm volatile("s_waitcnt vmcnt(0)" ::: "memory");
            const unsigned og = xb_add(&bar[XB_TOP], 1u);
            const unsigned tg = og / nx;
            if (og + 1u == (tg + 1u) * nx) xb_add(&bar[XB_TOPGEN], 1u);
            else XB_SPIN(xb_ld(&bar[XB_TOPGEN]) == tg, bar);
            __builtin_amdgcn_fence(__ATOMIC_ACQUIRE, "agent");
            xb_add(&bar[XB_XGEN(b.x)], 1u);
            asm volatile("s_waitcnt vmcnt(0)" ::: "memory");
        } else {
            XB_SPIN(xb_ld(&bar[XB_XGEN(b.x)]) == gen, bar);
            __builtin_amdgcn_fence(__ATOMIC_ACQUIRE, "agent");
            asm volatile("s_waitcnt vmcnt(0)" ::: "memory");
        }
    }
    __syncthreads();
}

__global__ void __launch_bounds__(512, 2) mk_fwd(Args Aparam) {
    extern __shared__ __attribute__((aligned(16))) unsigned char lds[];
    cg::grid_group grid = cg::this_grid();
    const int G = gridDim.x, bx = blockIdx.x;
    unsigned char* ws = Aparam.ws;
    LAS unsigned char* ldsl = (LAS unsigned char*)lds;
    const int lo = Aparam.ph_lo, hi = Aparam.ph_hi;
#define IN(k) (lo <= (k) && (k) < hi)
#define SEAM(k) do { if (IN(k) && (k) + 1 < hi) { if (hi > 1000) grid.sync(); else xcd_barrier(xb); } } while (0)
    volatile unsigned* xst = (volatile unsigned*)(lds + SLOT_OFF + 16);
    if (threadIdx.x == 0) { xst[0] = 0u; xst[1] = 0u; }
    __syncthreads();
    XcdBarrier xb; xb.bar = (unsigned*)(ws + WS_BAR); xb.x = 0; xb.st = xst;
    if (hi - lo > 1) xb = xcd_barrier_post((unsigned*)(ws + WS_BAR), xst);
#define XR (A.out)
#define MODV ((const float*)(ws + WS_MODV))
#define MODV1 (MODV + 9 * 6144)
#define H ((bf16*)(ws + WS_R1))
#define PROJ ((bf16*)(ws + WS_R2))
#define Gb ((bf16*)(ws + WS_R2))
#define MIX2 ((bf16*)(ws + WS_R1))
#define A2 ((bf16*)(ws + WS_R2 + R2_A2))
#define ZTL ((bf16*)(ws + WS_R2 + R2_ZTL))
#define ZTC ((bf16*)(ws + WS_R2 + R2_ZTC))
#define G5 ((bf16*)(ws + WS_R2 + R2_G5))
#define RSS ((float*)(ws + WS_RSS))
#define SWT ((float*)(ws + WS_SW))
#define H2 ((bf16*)(ws + WS_R2 + 84 * MiB))
#define G1 ((bf16*)(ws + WS_R1))
    if (IN(0)) { CArgs& A = *kargs(); unsigned char* ws = A.ws; (void)ws; prologue(A, lds); } SEAM(0);
    if (IN(1)) { CArgs& A = *kargs(); unsigned char* ws = A.ws; (void)ws; normpass0(A.in[0], A.in[1], A.in[10], MODV + 1024, H, RSS);
        const int tid = opaque_tid(); const int gw = bx * 8 + (tid >> 6), NGW = G * 8;
        sw_compute((const bf16*)(ws + WS_WEVIN), 3072, MODV, SWT + SW0_OFF, (float*)lds, gw, NGW);
        sw_compute((const bf16*)(ws + WS_WFUP), 5632, MODV + 3072, SWT + SW1_OFF, (float*)lds, gw, NGW);
        sw_compute((const bf16*)(ws + WS_WODIN), 1536, MODV1, SWT + SW2_OFF, (float*)lds, gw, NGW); } SEAM(1);
    if (IN(2)) { CArgs& A = *kargs(); unsigned char* ws = A.ws; (void)ws; pg8::Gemm g{H, (const bf16*)(ws + WS_WEVIN), 1024, 1024, 1024}; pg8::StaticOrder S; S.init(T, 3072, G, bx);
        pg8::Epi8N<EInProj0> E{{PROJ, (float*)(ws + WS_DT), A.out + O_K, A.out + O_V}, RSS, SWT + SW0_OFF, 3072}; pg8::gemm_phase(ldsl, g, S, E); } SEAM(2);
    if (IN(2)) { CArgs& A = *kargs(); conv_phase(A); } SEAM(2);
    if (IN(3)) { CArgs& A = *kargs(); unsigned char* ws = A.ws; (void)ws;
        unsigned* ctr = (unsigned*)(ws + WS_CTL); volatile int* slot = (volatile int*)(lds + SLOT_OFF);
        for (;;) { __syncthreads(); if (opaque_tid() == 0) *slot = (int)atomicAdd(ctr, 1u); __syncthreads(); const int it = *slot; if (it >= 640) break; ssd_item(A, lds, it); }
        for (;;) { __syncthreads(); if (opaque_tid() == 0) *slot = (int)atomicAdd(ctr + 64, 1u); __syncthreads(); const int it = *slot; if (it >= 1536) break; attn_pair(A, lds, it); }
    } SEAM(3);
    if (IN(4)) { CArgs& A = *kargs(); unsigned char* ws = A.ws; (void)ws; gate_phase((const bf16*)(ws + WS_R1), PROJ, A.in[22]); } SEAM(4);
    if (IN(5)) { CArgs& A = *kargs(); unsigned char* ws = A.ws; (void)ws; pg8::Gemm g{PROJ, (const bf16*)(ws + WS_WEVOUT), 1024, PLD, 1024}; pg8::StaticOrder S; S.init(T, 1024, G, bx);
        pg8::EpiResid E{A.in[0], A.in[1], XR, MODV + 2048, 1, H, A.in[11], MODV + 4096, RSS + T}; pg8::gemm_phase(ldsl, g, S, E);
        if (bx >= 128) gen_dftl(ws, bx - 128, G - 128); } SEAM(5);
    if (IN(7)) { CArgs& A = *kargs(); unsigned char* ws = A.ws; (void)ws; pg8::Gemm g{H, (const bf16*)(ws + WS_WFUP), 1024, 1024, 1024}; pg8::StaticOrder S; S.init(T, 5632, G, bx);
        pg8::Epi8N<ESwiglu> E{{Gb}, RSS + T, SWT + SW1_OFF, 5632}; pg8::gemm_phase(ldsl, g, S, E); } SEAM(7);
    if (IN(8)) { CArgs& A = *kargs(); unsigned char* ws = A.ws; (void)ws; pg8::Gemm g{Gb, (const bf16*)(ws + WS_WFDN), 2816, 2816, 2816}; pg8::StaticOrder S; S.init(T, 1024, G, bx);
        pg8::EpiResid E{A.in[0], A.in[1], XR, MODV + 5120, 0, H, A.in[10] + 1024, MODV1 + 1024, RSS + 2 * T}; pg8::gemm_phase(ldsl, g, S, E);
        if (bx >= 128) gen_s5(A, lds, bx - 128, G - 128); } SEAM(8);
    if (IN(10)) { CArgs& A = *kargs(); unsigned char* ws = A.ws; (void)ws; pg8::Gemm g{H, (const bf16*)(ws + WS_WODIN), 1024, 1024, 1024}; pg8::StaticOrder S; S.init(T, 1536, G, bx);
        pg8::Epi8N<EInProj1> E{{A2, ZTL, ZTC}, RSS + 2 * T, SWT + SW2_OFF, 1536}; pg8::gemm_phase(ldsl, g, S, E); } SEAM(10);
    if (IN(11)) { CArgs& A = *kargs(); unsigned char* ws = A.ws; (void)ws; pg8::Gemm g{A2, (const bf16*)(ws + WS_WBS), 256, 512, 256}; pg8::SchedS5 S{G, bx, 192};
        pg8::Epi8<ESloc> E{{(float*)(ws + WS_R1)}}; pg8::gemm_phase(ldsl, g, S, E); } SEAM(11);
    if (IN(12)) { CArgs& A = *kargs(); unsigned char* ws = A.ws; (void)ws; s5_scan_phase(A);
        __syncthreads();
        const int tid = opaque_tid(); float* scr = (float*)(lds + (tid >> 6) * 17408); const int gw = bx * 8 + (tid >> 6), NGW = G * 8, lane = tid & 63;
        transpose_all<2>(A.in[12] + (size_t)1024 * 2816, 1024, 2816, 2816, (bf16*)(ws + WS_WFUP), scr, gw, NGW, lane);
        transpose_all<3>(A.in[13] + (size_t)1024 * 2816, 1024, 2816, 2816, (bf16*)(ws + WS_WFUP), scr, gw, NGW, lane);
        transpose_all<0>(A.in[14] + (size_t)2816 * 1024, 2816, 1024, 1024, (bf16*)(ws + WS_WFDN), scr, gw, NGW, lane);
        __syncthreads(); } SEAM(12);
    if (IN(13)) { CArgs& A = *kargs(); unsigned char* ws = A.ws; (void)ws;
        { pg8::Gemm g{(const bf16*)(ws + WS_DFTL), ZTL, 4096, 4096, 4096}; pg8::StaticOrder S; S.init(2048, 4096, 128, bx < 128 ? bx : (1 << 30));
          pg8::Epi8<EFnetL> E{{MIX2}}; pg8::gemm_phase(ldsl, g, S, E); }
        { pg8::Gemm g{A2, (const bf16*)(ws + WS_WWY), 512, 512, 512}; pg8::SchedS5 S{128, bx >= 128 ? bx - 128 : (1 << 30), 192};
          pg8::Epi8<EY> E{{G5}}; pg8::gemm_phase(ldsl, g, S, E); }
        { pg8::Gemm g{(const bf16*)(ws + WS_DFTC), ZTC, 512, 512, 512}; pg8::StaticOrder S; S.init(256, 16384, 64, bx >= 192 ? bx - 192 : (1 << 30));
          pg8::Epi8<EFnetC> E{{MIX2}}; pg8::gemm_phase(ldsl, g, S, E); }
    } SEAM(13);
    if (IN(14)) { CArgs& A = *kargs(); unsigned char* ws = A.ws; (void)ws; { pg8::Gemm g{G5, (const bf16*)(ws + WS_WGLU), 512, 512, 512}; pg8::StaticOrder S; S.init(T, 512, G, bx);
        pg8::Epi8<EGlu> E{{G5, A.in[35], MIX2}}; pg8::gemm_phase(ldsl, g, S, E); }
        if (bx >= 192) { const int tid = opaque_tid(); sw_compute((const bf16*)(ws + WS_WFUP), 5632, MODV1 + 3072, SWT + SW3_OFF, (float*)lds, (bx - 192) * 8 + (tid >> 6), (G - 192) * 8); } } SEAM(14);
    if (IN(15)) { CArgs& A = *kargs(); unsigned char* ws = A.ws; (void)ws; pg8::Gemm g{MIX2, (const bf16*)(ws + WS_WODOUT), 1024, 1024, 1024}; pg8::StaticOrder S; S.init(T, 1024, G, bx);
        pg8::EpiResid E{A.in[0], A.in[1], XR, MODV1 + 2048, 0, H2, A.in[11] + 1024, MODV1 + 4096, RSS + 3 * T}; pg8::gemm_phase(ldsl, g, S, E); } SEAM(15);
    if (IN(17)) { CArgs& A = *kargs(); unsigned char* ws = A.ws; (void)ws; pg8::Gemm g{H2, (const bf16*)(ws + WS_WFUP), 1024, 1024, 1024}; pg8::StaticOrder S; S.init(T, 5632, G, bx);
        pg8::Epi8N<ESwiglu> E{{G1}, RSS + 3 * T, SWT + SW3_OFF, 5632}; pg8::gemm_phase(ldsl, g, S, E); } SEAM(17);
    if (IN(18)) { CArgs& A = *kargs(); unsigned char* ws = A.ws; (void)ws; pg8::Gemm g{G1, (const bf16*)(ws + WS_WFDN), 2816, 2816, 2816}; pg8::StaticOrder S; S.init(T, 1024, G, bx);
        pg8::EpiResid E{A.in[0], A.in[1], XR, MODV1 + 5120, 0, (bf16*)nullptr, A.in[15], MODV1, RSS + 4 * T}; pg8::gemm_phase(ldsl, g, S, E); } SEAM(18);
    if (IN(19)) { CArgs& A = *kargs(); unsigned char* ws = A.ws; (void)ws; final_norm_phase(XR, A.in[15], RSS + 4 * T); }
#undef IN
#undef SEAM
#undef XR
#undef MODV
#undef MODV1
#undef H
#undef PROJ
#undef Gb
#undef MIX2
#undef A2
#undef ZTL
#undef ZTC
#undef G5
#undef RSS
#undef SWT
#undef H2
#undef G1
}

extern "C" void kernel_launch(void* const* d_in, const int* in_sizes, int n_in, void* d_out, int out_size, void* d_ws, size_t ws_size, hipStream_t stream) {
    static int grid = 0;
    if (grid == 0) {
        if (n_in != 37 || ws_size < WS_END) { fprintf(stderr, "kernel_launch: unexpected n_in %d / ws %zu\n", n_in, ws_size); grid = -1; return; }
        int dev = 0, cus = 0, per_cu = 0;
        hipGetDevice(&dev); hipDeviceGetAttribute(&cus, hipDeviceAttributeMultiprocessorCount, dev);
        if (hipFuncSetAttribute((const void*)mk_fwd, hipFuncAttributeMaxDynamicSharedMemorySize, LDS_BYTES) != hipSuccess) { fprintf(stderr, "kernel_launch: hipFuncSetAttribute failed\n"); grid = -1; return; }
        hipOccupancyMaxActiveBlocksPerMultiprocessor(&per_cu, (const void*)mk_fwd, 512, LDS_BYTES);
        (void)hipGetLastError();
        if (per_cu < 1) per_cu = 1;
        grid = cus * 1;
        if (grid <= 0) grid = 256;
    }
    if (grid < 0) return;
    hipMemsetAsync((char*)d_ws + WS_CTL, 0, CTL_BYTES, stream);
    Args a{};
    for (int i = 0; i < 37; ++i) a.in[i] = (const float*)d_in[i];
    a.out = (float*)d_out; a.ws = (unsigned char*)d_ws;
#if MK_MODE == 1
    for (int ph = 0; ph < NPH; ++ph) { a.ph_lo = ph; a.ph_hi = ph + 1; hipLaunchKernelGGL(mk_fwd, dim3(grid), dim3(512), LDS_BYTES, stream, a); }
#else
    a.ph_lo = 0; a.ph_hi = NPH;
    void* params[] = {&a};
    hipError_t e = hipLaunchCooperativeKernel((const void*)mk_fwd, dim3(grid), dim3(512), params, LDS_BYTES, stream);
    if (e != hipSuccess) fprintf(stderr, "cooperative launch failed: %s (grid %d)\n", hipGetErrorString(e), grid);
#endif
}
```

```cpp
#include <hip/hip_runtime.h>
#include <hip/hip_cooperative_groups.h>
#include <cstdio>
#include <cstdint>
namespace cg = cooperative_groups;

#ifndef MK_MODE
#define MK_MODE 0
#endif

#define LAS __attribute__((address_space(3)))
typedef unsigned short bf16;
typedef short bf16x8 __attribute__((ext_vector_type(8)));
typedef float f32x4 __attribute__((ext_vector_type(4)));
typedef unsigned u32x4 __attribute__((ext_vector_type(4)));
typedef unsigned u32x2 __attribute__((ext_vector_type(2)));

constexpr int D = 1024, TC = 8192, TL = 16384, T = 24576, FF = 2816;
constexpr int PLD = 2816;
constexpr int PZ = 0, PQ = 512, PX = 1024, PK = 1792, PV = 2304;
constexpr int NPH = 20;
constexpr int LDS_BYTES = 147456;
constexpr int SLOT_OFF = LDS_BYTES - 64;
constexpr size_t MiB = 1u << 20;
constexpr size_t WS_CTL = 0, CTL_BYTES = 1048576, WS_BAR = 4096;
constexpr size_t WS_MODV = 64 * 1024;
constexpr size_t WS_RSS = 512 * 1024;
constexpr size_t WS_SW = 249 * MiB;
constexpr size_t WS_DT = 1 * MiB;
constexpr size_t WS_WEVIN = 2 * MiB;
constexpr size_t WS_WEVOUT = 8 * MiB;
constexpr size_t WS_WODIN = 10 * MiB;
constexpr size_t WS_WODOUT = 13 * MiB;
constexpr size_t WS_WGLU = 15 * MiB;
constexpr size_t WS_DFTC = 15 * MiB + 512 * 1024;
constexpr size_t WS_WFUP = 16 * MiB;
constexpr size_t WS_WFDN = 27 * MiB;
constexpr size_t WS_WBS = 33 * MiB;
constexpr size_t WS_WWY = 37 * MiB;
constexpr size_t WS_DFTL = 45 * MiB;
constexpr size_t WS_PQ = 53 * MiB;
constexpr size_t WS_XC = 33 * MiB;
constexpr size_t WS_R1 = 69 * MiB;
constexpr size_t WS_R2 = 117 * MiB;
constexpr size_t WS_END = 250 * MiB;
constexpr size_t SW0_OFF = 0, SW1_OFF = 9 * 3072, SW2_OFF = SW1_OFF + 9 * 5632, SW3_OFF = SW2_OFF + 9 * 1536;
constexpr size_t R2_A2 = 0, R2_ZTL = 48 * MiB, R2_ZTC = 80 * MiB, R2_G5 = 96 * MiB;
constexpr size_t O_K = 25165824, O_V = 29360128, O_SSD = 33554432, O_S5 = 35651584;

struct Args { const float* in[37]; float* out; unsigned char* ws; int ph_lo, ph_hi; };
typedef const __attribute__((address_space(4))) Args CArgs;
__device__ __forceinline__ CArgs* kargs() { CArgs* p = (CArgs*)__builtin_amdgcn_kernarg_segment_ptr(); asm volatile("" : "+s"(p)); return p; }

__device__ __forceinline__ unsigned pk2(float lo, float hi) { unsigned r; asm("v_cvt_pk_bf16_f32 %0, %1, %2" : "=v"(r) : "v"(lo), "v"(hi)); return r; }
__device__ __forceinline__ unsigned f2bf(float f) { return pk2(f, f); }
__device__ __forceinline__ float bflo(unsigned u) { return __builtin_bit_cast(float, u << 16); }
__device__ __forceinline__ float bfhi(unsigned u) { return __builtin_bit_cast(float, u & 0xffff0000u); }
__device__ __forceinline__ unsigned cvt_pk_bf16(float lo, float hi) { return pk2(lo, hi); }
__device__ __forceinline__ u32x4 pack8(f32x4 a, f32x4 b) { u32x4 w; w.x = cvt_pk_bf16(a[0], a[1]); w.y = cvt_pk_bf16(a[2], a[3]); w.z = cvt_pk_bf16(b[0], b[1]); w.w = cvt_pk_bf16(b[2], b[3]); return w; }
__device__ __forceinline__ float silu_f(float x) { return x / (1.f + __expf(-x)); }
__device__ __forceinline__ float sigmoid_f(float x) { return 1.f / (1.f + __expf(-x)); }
__device__ __forceinline__ float gelu_tanh(float x) { const float u = 0.7978845608028654f * (x + 0.044715f * x * x * x); const float t = 1.f - 2.f / (__expf(2.f * u) + 1.f); return 0.5f * x * (1.f + t); }
__device__ __forceinline__ float wave_sum(float v) {
#pragma unroll
    for (int o = 1; o < 64; o <<= 1) v += __shfl_xor(v, o);
    return v;
}
__device__ __forceinline__ int mod_row(int row) { return row < TC ? 0 : 1 + ((row - TC) >> 11); }
#define LDS_WAIT() asm volatile("s_waitcnt lgkmcnt(0)" ::: "memory")
__device__ __forceinline__ int opaque_tid() { int t = threadIdx.x; asm volatile("" : "+v"(t)); return t; }
__device__ __forceinline__ f32x4 mma16(bf16x8 a, bf16x8 b, f32x4 c) { return __builtin_amdgcn_mfma_f32_16x16x32_bf16(a, b, c, 0, 0, 0); }
__device__ __forceinline__ bf16x8 ldfrag(const bf16* base, int stride, int lane, int ks) { return *(const bf16x8*)(base + (lane & 15) * stride + ks * 32 + (lane >> 4) * 8); }

namespace pg8 {
constexpr int BM = 256, BK = 64, HALF = 128, HTB = HALF * BK * 2, NXCD = 8, WGM = 8;
__host__ __device__ __forceinline__ int lds_byte(int r, int c) { const int st = (r >> 4) * 2 + (c >> 5), rr = r & 15, cc = c & 31, ob = rr * 64 + cc * 2; return st * 1024 + (ob ^ (((ob >> 9) & 1) << 5)); }
__host__ __device__ __forceinline__ void stage_rc(int b, int& R, int& C) { const int st = b / 1024, sb = b % 1024, swz = sb ^ (((sb >> 9) & 1) << 5); R = (st >> 1) * 16 + swz / 64; C = (st & 1) * 32 + (swz % 64) / 2; }
__host__ __device__ __forceinline__ int perm32(int rho) { const int n = rho >> 4, i = rho & 15; return 8 * (i >> 2) + 4 * n + (i & 3); }
struct Unit { int pm, pn; };
struct Gemm { const bf16* A; const bf16* Bt; int K, lda, ldb; };
struct StaticOrder {
    int nM, nN, nwg, G, c;
    __device__ void init(int M, int N, int G_, int c_) { nM = M / BM; nN = N / BM; nwg = nM * nN; G = G_; c = c_; }
    __device__ bool next(int i, Unit& u) const {
        const long L = (long)i * G + c; if (L >= nwg) return false;
        int wgid = (int)L; { const int q = nwg / NXCD, r = nwg % NXCD, xcd = wgid % NXCD, off = wgid / NXCD; wgid = (xcd < r ? xcd * (q + 1) : r * (q + 1) + (xcd - r) * q) + off; }
        const int nig = WGM * nN, gid = wgid / nig, fm = gid * WGM, gsz = (nM - fm) < WGM ? (nM - fm) : WGM;
        u.pm = fm + ((wgid % nig) % gsz); u.pn = (wgid % nig) / gsz; return true;
    }
};
struct SchedS5 {
    int G, c, nunits;
    __device__ bool next(int i, Unit& u) const { const long L = (long)i * G + c; if (L >= nunits) return false; u.pm = (int)L; u.pn = (int)L / 6; return true; }
};
template <class F> struct Epi8 {
    static constexpr bool PERM = true;
    F f;
    __device__ __forceinline__ void operator()(const f32x4 (&acc)[2][2][4][2], const Unit& u, int wr, int wc, int fr, int fq) const {
#pragma unroll
        for (int ai = 0; ai < 2; ++ai)
#pragma unroll
            for (int m = 0; m < 4; ++m) { const int row = u.pm * BM + ai * HALF + wr * 64 + m * 16 + fr;
#pragma unroll
                for (int bj = 0; bj < 2; ++bj) { const int col0 = u.pn * BM + bj * HALF + wc * 32 + 8 * fq; f(row, col0, acc[ai][bj][m][0], acc[ai][bj][m][1]); } }
    }
};

template <class F> struct Epi8N {
    static constexpr bool PERM = true;
    F f; const float* rss; const float* sw; int n;
    __device__ __forceinline__ void operator()(const f32x4 (&acc)[2][2][4][2], const Unit& u, int wr, int wc, int fr, int fq) const {
        const int row0 = u.pm * BM + wr * 64 + fr, colb = u.pn * BM + wc * 32 + 8 * fq;
        const float* s = sw + mod_row(u.pm * BM) * n + colb;
        float rs[2][4]; f32x4 sv[2][2];
#pragma unroll
        for (int ai = 0; ai < 2; ++ai)
#pragma unroll
            for (int m = 0; m < 4; ++m) rs[ai][m] = rss[row0 + ai * HALF + m * 16];
#pragma unroll
        for (int bj = 0; bj < 2; ++bj) { sv[bj][0] = *(const f32x4*)(s + bj * HALF); sv[bj][1] = *(const f32x4*)(s + bj * HALF + 4); }
#pragma unroll
        for (int ai = 0; ai < 2; ++ai)
#pragma unroll
            for (int m = 0; m < 4; ++m) { const float rstd = rsqrtf(rs[ai][m] * (1.f / 1024.f) + 1e-6f);
#pragma unroll
                for (int bj = 0; bj < 2; ++bj) f(row0 + ai * HALF + m * 16, colb + bj * HALF, acc[ai][bj][m][0] * rstd + sv[bj][0], acc[ai][bj][m][1] * rstd + sv[bj][1]); }
    }
};
struct EpiResid {
    static constexpr bool PERM = true;
    const float* xp; const float* xs; float* XR; const float* gate; int first; bf16* Hn; const float* gam; const float* scale; float* rss;
    __device__ __forceinline__ void operator()(const f32x4 (&acc)[2][2][4][2], const Unit& u, int wr, int wc, int fr, int fq) const {
        const int row0 = u.pm * BM + wr * 64 + fr, colb = u.pn * BM + wc * 32 + 8 * fq, mr = mod_row(u.pm * BM);
        f32x4 gv[2][2], qv[2][2];
#pragma unroll
        for (int bj = 0; bj < 2; ++bj)
#pragma unroll
            for (int h = 0; h < 2; ++h) { const int c = colb + bj * HALF + 4 * h; gv[bj][h] = *(const f32x4*)(gate + mr * 6144 + c);
                qv[bj][h] = Hn ? *(const f32x4*)(gam + c) * (*(const f32x4*)(scale + mr * 6144 + c) + 1.f) : (f32x4){0.f, 0.f, 0.f, 0.f}; }
#pragma unroll
        for (int am = 0; am < 4; ++am) { const int ai = am >> 1, mb = (am & 1) * 2;
            f32x4 bv[2][2][2];
#pragma unroll
            for (int mm = 0; mm < 2; ++mm) { const int row = row0 + ai * HALF + (mb + mm) * 16;
                const float* b = first ? (row < TC ? xp + (size_t)row * D : xs + (size_t)(row - TC) * D) : XR + (size_t)row * D;
#pragma unroll
                for (int bj = 0; bj < 2; ++bj) { bv[mm][bj][0] = *(const f32x4*)(b + colb + bj * HALF); bv[mm][bj][1] = *(const f32x4*)(b + colb + bj * HALF + 4); } }
#pragma unroll
            for (int mm = 0; mm < 2; ++mm) { const int m = mb + mm; const int row = row0 + ai * HALF + m * 16; float ss = 0.f;
#pragma unroll
                for (int bj = 0; bj < 2; ++bj) { const f32x4 o0 = bv[mm][bj][0] + gv[bj][0] * acc[ai][bj][m][0], o1 = bv[mm][bj][1] + gv[bj][1] * acc[ai][bj][m][1];
                    float* o = XR + (size_t)row * D + colb + bj * HALF; *(f32x4*)o = o0; *(f32x4*)(o + 4) = o1;
                    ss += (o0[0] * o0[0] + o0[1] * o0[1]) + (o0[2] * o0[2] + o0[3] * o0[3]) + (o1[0] * o1[0] + o1[1] * o1[1]) + (o1[2] * o1[2] + o1[3] * o1[3]);
                    if (Hn) *(u32x4*)(Hn + (size_t)row * D + colb + bj * HALF) = pack8(o0 * qv[bj][0], o1 * qv[bj][1]); }
                ss += __shfl_xor(ss, 16); ss += __shfl_xor(ss, 32);
                if (fq == 0) atomicAdd(rss + row, ss); }
        }
    }
};

template <class Epi, class Sched>
__device__ __forceinline__ void gemm_phase(LAS unsigned char* lds, const Gemm g, const Sched& S, const Epi& E) {
    const int tid = opaque_tid(), wid = __builtin_amdgcn_readfirstlane(tid >> 6), lane = tid & 63, wr = wid >> 2, wc = wid & 3, fr = lane & 15, fq = lane >> 4;
    const int K = g.K, nt = K / BK;
    unsigned voffA[2], voffB[2];
#pragma unroll
    for (int i = 0; i < 2; ++i) { int R, C; stage_rc(tid * 16 + i * 8192, R, C); const int Rb = (R & ~31) + perm32(R & 31);
        voffA[i] = (unsigned)(R * g.lda + C) * 2u; voffB[i] = (unsigned)(Rb * g.ldb + C) * 2u; }
    const size_t kstep = (size_t)(BK * 2);
    const size_t hstepA = (size_t)HALF * g.lda * 2, hstepB = (size_t)HALF * g.ldb * 2;
    const size_t tstepA = 2 * hstepA, tstepB = 2 * hstepB;
    const unsigned ldsw = (unsigned)wid * 1024u;
    const int aoff = lds_byte(wr * 64 + fr, fq * 8), boff = lds_byte(wc * 32 + fr, fq * 8);
#define PG8_SA(b, h) (((b) * 2 + (h)) * HTB)
#define PG8_SB(b, h) ((4 + (b) * 2 + (h)) * HTB)
#define PG8_STAGE(bufoff, gbase, voff) do { _Pragma("unroll") for (int _i = 0; _i < 2; ++_i) \
        __builtin_amdgcn_global_load_lds((const unsigned*)((const char*)(gbase) + (voff)[_i]), (LAS unsigned*)(lds + (bufoff) + ldsw + _i * 8192), 16, 0, 0); } while (0)
#define PG8_LDA(dst, b, h) do { _Pragma("unroll") for (int m = 0; m < 4; ++m) _Pragma("unroll") for (int k = 0; k < 2; ++k) dst[m][k] = *(const LAS bf16x8*)(lds + PG8_SA(b, h) + aoff + m * 2048 + k * 1024); } while (0)
#define PG8_LDB(dst, b, h) do { _Pragma("unroll") for (int n = 0; n < 2; ++n) _Pragma("unroll") for (int k = 0; k < 2; ++k) dst[n][k] = *(const LAS bf16x8*)(lds + PG8_SB(b, h) + boff + n * 2048 + k * 1024); } while (0)
#define PG8_MMA(ai, bj, At, Bt) do { __builtin_amdgcn_s_setprio(1); _Pragma("unroll") for (int m = 0; m < 4; ++m) _Pragma("unroll") for (int n = 0; n < 2; ++n) _Pragma("unroll") for (int k = 0; k < 2; ++k) \
        acc[ai][bj][m][n] = __builtin_amdgcn_mfma_f32_16x16x32_bf16(Bt[n][k], At[m][k], acc[ai][bj][m][n], 0, 0, 0); __builtin_amdgcn_s_setprio(0); } while (0)
#define PG8_WAIT_V(n) asm volatile("s_waitcnt vmcnt(" #n ")" ::: "memory")
#define PG8_WAIT_L(n) asm volatile("s_waitcnt lgkmcnt(" #n ")" ::: "memory")
#define PG8_BAR __builtin_amdgcn_s_barrier()
#define PG8_SCHED __builtin_amdgcn_sched_barrier(0)
    Unit cur, nxt; int ui = 0;
    if (!S.next(0, cur)) return;
    f32x4 acc[2][2][4][2];
#pragma unroll
    for (int a = 0; a < 2; ++a)
#pragma unroll
        for (int b = 0; b < 2; ++b)
#pragma unroll
            for (int m = 0; m < 4; ++m)
#pragma unroll
                for (int n = 0; n < 2; ++n) acc[a][b][m][n] = (f32x4){0.f, 0.f, 0.f, 0.f};
    bf16x8 At[4][2], B0[2][2], B1[2][2];
    const char* cA = (const char*)g.A + (size_t)cur.pm * tstepA; const char* cB = (const char*)g.Bt + (size_t)cur.pn * tstepB;
    PG8_STAGE(PG8_SB(0, 0), cB, voffB); PG8_STAGE(PG8_SB(0, 1), cB + hstepB, voffB); PG8_STAGE(PG8_SA(0, 0), cA, voffA); PG8_STAGE(PG8_SA(0, 1), cA + hstepA, voffA);
    if (wr == 1) PG8_BAR;
    PG8_WAIT_V(2); PG8_BAR;
    PG8_STAGE(PG8_SB(1, 0), cB + kstep, voffB); PG8_STAGE(PG8_SA(1, 0), cA + kstep, voffA); PG8_STAGE(PG8_SB(1, 1), cB + hstepB + kstep, voffB);
    PG8_WAIT_V(6); PG8_BAR;
    for (;;) {
        const bool has_next = S.next(ui + 1, nxt);
        const char* nA = has_next ? (const char*)g.A + (size_t)nxt.pm * tstepA : cA; const char* nB = has_next ? (const char*)g.Bt + (size_t)nxt.pn * tstepB : cB;
        for (int t = 0; t < nt; t += 2) {
            const bool last = (t == nt - 2);
            const char* a1 = cA + (size_t)(t + 1) * kstep;
            const char* a2 = last ? nA : cA + (size_t)(t + 2) * kstep; const char* b2 = last ? nB : cB + (size_t)(t + 2) * kstep;
            const char* a3 = a2 + kstep; const char* b3 = b2 + kstep;
            PG8_LDB(B0, 0, 0); PG8_LDB(B1, 0, 1); PG8_SCHED; PG8_LDA(At, 0, 0); PG8_STAGE(PG8_SA(1, 1), a1 + hstepA, voffA);
            PG8_WAIT_V(8); PG8_WAIT_L(0); PG8_BAR; PG8_MMA(0, 0, At, B0); PG8_MMA(0, 1, At, B1); PG8_BAR; PG8_SCHED;
            PG8_LDA(At, 0, 1); PG8_STAGE(PG8_SB(0, 0), b2, voffB); PG8_STAGE(PG8_SB(0, 1), b2 + hstepB, voffB); PG8_STAGE(PG8_SA(0, 0), a2, voffA);
            PG8_WAIT_V(8); PG8_WAIT_L(0); PG8_BAR; PG8_MMA(1, 0, At, B0); PG8_MMA(1, 1, At, B1); PG8_BAR; PG8_SCHED;
            PG8_LDB(B0, 1, 0); PG8_LDB(B1, 1, 1); PG8_SCHED; PG8_LDA(At, 1, 0); PG8_STAGE(PG8_SA(0, 1), a2 + hstepA, voffA);
            PG8_WAIT_V(8); PG8_WAIT_L(0); PG8_BAR; PG8_MMA(0, 0, At, B0); PG8_MMA(0, 1, At, B1); PG8_BAR; PG8_SCHED;
            PG8_LDA(At, 1, 1); PG8_STAGE(PG8_SB(1, 0), b3, voffB); PG8_STAGE(PG8_SB(1, 1), b3 + hstepB, voffB); PG8_STAGE(PG8_SA(1, 0), a3, voffA);
            PG8_WAIT_V(8); PG8_WAIT_L(0); PG8_BAR; PG8_MMA(1, 0, At, B0); PG8_MMA(1, 1, At, B1); PG8_BAR; PG8_SCHED;
        }
        if (wr == 0) PG8_BAR;
        { const int t2 = opaque_tid(); const int w2 = __builtin_amdgcn_readfirstlane(t2 >> 6); E(acc, cur, w2 >> 2, w2 & 3, t2 & 15, (t2 & 63) >> 4); }
        if (!has_next) break;
#pragma unroll
        for (int a = 0; a < 2; ++a)
#pragma unroll
            for (int b = 0; b < 2; ++b)
#pragma unroll
                for (int m = 0; m < 4; ++m)
#pragma unroll
                    for (int n = 0; n < 2; ++n) acc[a][b][m][n] = (f32x4){0.f, 0.f, 0.f, 0.f};
        cur = nxt; cA = nA; cB = nB; ++ui;
        if (wr == 1) PG8_BAR;
    }
    PG8_WAIT_V(0);
    PG8_BAR;
#undef PG8_SA
#undef PG8_SB
#undef PG8_STAGE
#undef PG8_LDA
#undef PG8_LDB
#undef PG8_MMA
#undef PG8_WAIT_V
#undef PG8_WAIT_L
#undef PG8_BAR
#undef PG8_SCHED
}
}

struct EInProj0 { bf16* PROJ; float* DT; float* outk; float* outv;
    __device__ __forceinline__ void operator()(int row, int col, f32x4 v0, f32x4 v1) const {
        if (col < 2816) {
            if (col >= PQ && col < PX) { v0 = v0 * 0.125f; v1 = v1 * 0.125f; }
            *(u32x4*)(PROJ + (size_t)row * PLD + col) = pack8(v0, v1);
            if (row < TC && col >= PK) { float* o = (col < PV) ? outk + (size_t)row * 512 + (col - PK) : outv + (size_t)row * 512 + (col - PV); *(f32x4*)o = v0; *(f32x4*)(o + 4) = v1; }
        } else if (col == 2816) { float* o = DT + (size_t)row * 8; *(f32x4*)o = v0; *(f32x4*)(o + 4) = v1; }
    } };
struct ESwiglu { bf16* G;
    __device__ __forceinline__ void operator()(int row, int col, f32x4 v0, f32x4 v1) const {
        u32x2 w; w.x = cvt_pk_bf16(silu_f(v0[0]) * v1[0], silu_f(v0[1]) * v1[1]); w.y = cvt_pk_bf16(silu_f(v0[2]) * v1[2], silu_f(v0[3]) * v1[3]);
        *(u32x2*)(G + (size_t)row * FF + (col >> 1)) = w;
    } };
struct EInProj1 { bf16* A2; bf16* ZTL; bf16* ZTC;
    __device__ __forceinline__ void operator()(int row, int col, f32x4 v0, f32x4 v1) const {
        if (col < 512) { const int g = col >> 4, cc = col & 15, ch = row >> 4, j = row & 15;
            *(u32x4*)(A2 + ((size_t)(g * 1536 + ch)) * 512 + j * 16 + cc) = pack8(v0, v1);
        } else { const int cs = (col - 512) >> 9, n = (col - 512) & 511; bf16* p; size_t st;
            if (row < TC) { const int b = row >> 8, l = row & 255; p = ZTC + ((size_t)(b * 512 + n)) * 512 + cs * 256 + l; st = 512; }
            else { const int r2 = row - TC, b = r2 >> 11, l = r2 & 2047; p = ZTL + ((size_t)(b * 512 + n)) * 4096 + cs * 2048 + l; st = 4096; }
#pragma unroll
            for (int e = 0; e < 4; ++e) { p[(size_t)e * st] = (bf16)f2bf(v0[e]); p[(size_t)(e + 4) * st] = (bf16)f2bf(v1[e]); }
        }
    } };
struct ESloc { float* S;
    __device__ __forceinline__ void operator()(int row, int col, f32x4 v0, f32x4 v1) const { float* o = S + (size_t)row * 256 + (col & 255); *(f32x4*)o = v0; *(f32x4*)(o + 4) = v1; } };
struct EY { bf16* G5;
    __device__ __forceinline__ void operator()(int row, int col, f32x4 v0, f32x4 v1) const {
        const int g = row / 1536, ch = row - g * 1536, c2 = col & 255, i = c2 >> 4, cc = c2 & 15;
        f32x4 a, b;
#pragma unroll
        for (int e = 0; e < 4; ++e) { a[e] = gelu_tanh(v0[e]); b[e] = gelu_tanh(v1[e]); }
        *(u32x4*)(G5 + (size_t)(ch * 16 + i) * 512 + g * 16 + cc) = pack8(a, b);
    } };
struct EGlu { const bf16* G5; const float* bias; bf16* MIX2;
    __device__ __forceinline__ void operator()(int row, int col, f32x4 v0, f32x4 v1) const {
        const u32x4 gr = *(const u32x4*)(G5 + (size_t)row * 512 + col); const f32x4 b0 = *(const f32x4*)(bias + col), b1 = *(const f32x4*)(bias + col + 4);
        f32x4 a, b;
        a[0] = bflo(gr.x) * sigmoid_f(v0[0] + b0[0]); a[1] = bfhi(gr.x) * sigmoid_f(v0[1] + b0[1]); a[2] = bflo(gr.y) * sigmoid_f(v0[2] + b0[2]); a[3] = bfhi(gr.y) * sigmoid_f(v0[3] + b0[3]);
        b[0] = bflo(gr.z) * sigmoid_f(v1[0] + b1[0]); b[1] = bfhi(gr.z) * sigmoid_f(v1[1] + b1[1]); b[2] = bflo(gr.w) * sigmoid_f(v1[2] + b1[2]); b[3] = bfhi(gr.w) * sigmoid_f(v1[3] + b1[3]);
        *(u32x4*)(MIX2 + (size_t)row * D + col) = pack8(a, b);
    } };
struct EFnetL { bf16* PQ;
    __device__ __forceinline__ void operator()(int row, int col, f32x4 v0, f32x4 v1) const { *(u32x4*)(PQ + (size_t)row * 4096 + (col & 4095)) = pack8(v0, v1); } };
struct EFnetC { bf16* MIX2;
    __device__ __forceinline__ void operator()(int row, int col, f32x4 v0, f32x4 v1) const { const int b = col >> 9, n = col & 511; *(u32x4*)(MIX2 + (size_t)(b * 256 + row) * D + 512 + n) = pack8(v0, v1); } };

__device__ __forceinline__ int evin_dst(int n) {
    if (n < 512) return n;
    if (n < 1280) return n - 512 + PX;
    if (n < 1288) return n - 1280 + 2816;
    if (n < 1800) return n - 1288 + PQ;
    if (n < 2312) return n - 1800 + PK;
    return n - 2312 + PV;
}
template <int MODE> __device__ __forceinline__ int dst_row(int n) {
    if (MODE == 0) return n;
    if (MODE == 1) return evin_dst(n);
    if (MODE == 2) return 8 * (n >> 2) + (n & 3);
    return 8 * (n >> 2) + 4 + (n & 3);
}
template <int MODE> __device__ __forceinline__ void transpose_item(const float* W, int K, int N, int ldw, bf16* WT, float* scr, int item, int lane) {
    const int nblk = (N + 127) >> 7, kb = item / nblk, nb = item - kb * nblk, k0 = 32 * kb, n0 = 128 * nb;
    const int nn = n0 + 4 * (lane & 31); const bool ok = nn < N;
    f32x4 v[16];
#pragma unroll
    for (int i = 0; i < 16; ++i) { const int kk = 2 * i + (lane >> 5); v[i] = ok ? *(const f32x4*)(W + (size_t)(k0 + kk) * ldw + nn) : (f32x4){0.f, 0.f, 0.f, 0.f}; }
#pragma unroll
    for (int i = 0; i < 16; ++i) { const int kk = 2 * i + (lane >> 5); float* s = scr + kk * 129 + 4 * (lane & 31); s[0] = v[i][0]; s[1] = v[i][1]; s[2] = v[i][2]; s[3] = v[i][3]; }
    LDS_WAIT(); asm volatile("" ::: "memory");
#pragma unroll
    for (int j = 0; j < 2; ++j) { const int n = lane + 64 * j;
        if (n0 + n < N) { const float* s = scr + n; bf16* o = WT + (size_t)dst_row<MODE>(n0 + n) * K + k0;
#pragma unroll
            for (int q = 0; q < 4; ++q) { u32x4 w; w.x = pk2(s[(8 * q) * 129], s[(8 * q + 1) * 129]); w.y = pk2(s[(8 * q + 2) * 129], s[(8 * q + 3) * 129]); w.z = pk2(s[(8 * q + 4) * 129], s[(8 * q + 5) * 129]); w.w = pk2(s[(8 * q + 6) * 129], s[(8 * q + 7) * 129]);
                *(u32x4*)(o + 8 * q) = w; } } }
    LDS_WAIT(); asm volatile("" ::: "memory");
}
template <int MODE> __device__ __forceinline__ void transpose_all(const float* W, int K, int N, int ldw, bf16* WT, float* scr, int gw, int NGW, int lane) {
    const int nitems = (K >> 5) * ((N + 127) >> 7);
    for (int it = gw; it < nitems; it += NGW) transpose_item<MODE>(W, K, N, ldw, WT, scr, it, lane);
}
__device__ __forceinline__ void fold_item(const float* W, bf16* WT, float* scr, int item, int lane) {
    const int g = item >> 6, k0 = (item & 63) * 16;
    for (int i = 0; i < 16; ++i) scr[i * 65 + lane] = W[(size_t)(k0 + i) * 1024 + 512 + g * 64 + lane];
    scr[16 * 65 + lane] = cospif(lane * (1.f / 32.f)) * 0.125f; scr[16 * 65 + 64 + lane] = sinpif(lane * (1.f / 32.f)) * 0.125f;
    LDS_WAIT(); asm volatile("" ::: "memory");
    float ac[16], as[16];
#pragma unroll
    for (int kk = 0; kk < 16; ++kk) { ac[kk] = 0.f; as[kk] = 0.f; }
    for (int c = 0; c < 64; ++c) { const int idx = (c * lane) & 63; const float ct = scr[16 * 65 + idx], st = scr[16 * 65 + 64 + idx];
#pragma unroll
        for (int kk = 0; kk < 16; ++kk) { const float w = scr[kk * 65 + c]; ac[kk] += w * ct; as[kk] += w * st; } }
    bf16* oc = WT + (size_t)(512 + g * 64 + lane) * 1024 + k0; bf16* os = WT + (size_t)(1024 + g * 64 + lane) * 1024 + k0;
#pragma unroll
    for (int q = 0; q < 2; ++q) {
        u32x4 a, b; a.x = pk2(ac[8 * q], ac[8 * q + 1]); a.y = pk2(ac[8 * q + 2], ac[8 * q + 3]); a.z = pk2(ac[8 * q + 4], ac[8 * q + 5]); a.w = pk2(ac[8 * q + 6], ac[8 * q + 7]);
        b.x = pk2(as[8 * q], as[8 * q + 1]); b.y = pk2(as[8 * q + 2], as[8 * q + 3]); b.z = pk2(as[8 * q + 4], as[8 * q + 5]); b.w = pk2(as[8 * q + 6], as[8 * q + 7]);
        *(u32x4*)(oc + 8 * q) = a; *(u32x4*)(os + 8 * q) = b; }
    LDS_WAIT(); asm volatile("" ::: "memory");
}
__device__ __forceinline__ void cpow(float lre, float lim, float step, float e, float& re, float& im) {
    const float mag = __expf(e * lre * step); float tr = e * (lim * step * 0.15915494309189535f); tr -= floorf(tr);
    re = mag * cospif(2.f * tr); im = mag * sinpif(2.f * tr);
}
__device__ __forceinline__ void s5_k(float lre, float lim, float step, float& kr, float& ki) {
    const float zr = lre * step, zi = lim * step;
    if (zr * zr + zi * zi < 0.01f) {
        float pr = 1.f, pi = 0.f, sr = 1.f, si = 0.f; const float inv[4] = {0.5f, 1.f / 6.f, 1.f / 24.f, 1.f / 120.f};
#pragma unroll
        for (int q = 0; q < 4; ++q) { const float nr = pr * zr - pi * zi, ni = pr * zi + pi * zr; pr = nr; pi = ni; sr += pr * inv[q]; si += pi * inv[q]; }
        kr = step * sr; ki = step * si;
    } else { float ar, ai; cpow(lre, lim, step, 1.f, ar, ai); ar -= 1.f; const float den = lre * lre + lim * lim; kr = (ar * lre + ai * lim) / den; ki = (ai * lre - ar * lim) / den; }
}

__device__ __forceinline__ void prologue(CArgs& A, unsigned char* lds) {
    const int tid = opaque_tid(), lane = tid & 63, wave = tid >> 6, G = gridDim.x;
    const int gw = blockIdx.x * 8 + wave, NGW = G * 8;
    const int gt = blockIdx.x * 512 + tid, NGT = G * 512;
    unsigned char* ws = A.ws;
    float* scr = (float*)(lds + wave * 17408);
    for (int item = blockIdx.x; item < 384; item += G) {
        const int layer = item / 192, rem = item - layer * 192, n0 = (rem >> 2) * 128, kq = rem & 3;
        float* sc = (float*)lds;
        float* red = (float*)(lds + 9216);
        __syncthreads();
        for (int i = tid; i < 9 * 256; i += 512) { const int r = i >> 8, k = kq * 256 + (i & 255); const float v = r == 0 ? A.in[7][k] : A.in[6][(r - 1) * 1024 + k]; sc[i] = silu_f(v); }
        const float* W = A.in[8] + ((size_t)layer * 1024 + kq * 256 + wave * 32) * 6144 + n0 + 2 * lane;
        float wx[32], wy[32];
#pragma unroll
        for (int u = 0; u < 32; ++u) { const float* p = W + (size_t)u * 6144; wx[u] = p[0]; wy[u] = p[1]; }
        __syncthreads();
        float ax[9], ay[9];
#pragma unroll
        for (int r = 0; r < 9; ++r) { ax[r] = 0.f; ay[r] = 0.f; }
#pragma unroll
        for (int u = 0; u < 32; ++u)
#pragma unroll
            for (int r = 0; r < 9; ++r) { const float s = sc[r * 256 + wave * 32 + u]; ax[r] += s * wx[u]; ay[r] += s * wy[u]; }
#pragma unroll
        for (int r = 0; r < 9; ++r) { red[(wave * 9 + r) * 128 + 2 * lane] = ax[r]; red[(wave * 9 + r) * 128 + 2 * lane + 1] = ay[r]; }
        __syncthreads();
        for (int i = tid; i < 9 * 128; i += 512) { const int r = i >> 7, l = i & 127; float s = kq == 0 ? A.in[9][layer * 6144 + n0 + l] : 0.f;
#pragma unroll
            for (int w = 0; w < 8; ++w) s += red[(w * 9 + r) * 128 + l];
            atomicAdd(((float*)(ws + WS_MODV)) + (layer * 9 + r) * 6144 + n0 + l, s); }
    }
    __syncthreads();
    transpose_all<1>(A.in[16], 1024, 2824, 2824, (bf16*)(ws + WS_WEVIN), scr, gw, NGW, lane);
    transpose_all<0>(A.in[24], 1024, 1024, 1024, (bf16*)(ws + WS_WEVOUT), scr, gw, NGW, lane);
    transpose_all<0>(A.in[25], 1024, 512, 1024, (bf16*)(ws + WS_WODIN), scr, gw, NGW, lane);
    transpose_all<0>(A.in[36], 1024, 1024, 1024, (bf16*)(ws + WS_WODOUT), scr, gw, NGW, lane);
    transpose_all<0>(A.in[34], 512, 512, 512, (bf16*)(ws + WS_WGLU), scr, gw, NGW, lane);
    for (int it = gw; it < 512; it += NGW) fold_item(A.in[25], (bf16*)(ws + WS_WODIN), scr, it, lane);
    { u32x4* z = (u32x4*)(ws + WS_WEVIN + (size_t)2824 * 1024 * 2); const int n16 = 248 * 1024 * 2 / 16; for (int i = gt; i < n16; i += NGT) z[i] = (u32x4){0u, 0u, 0u, 0u}; }
    { bf16* DC = (bf16*)(ws + WS_DFTC); const float sc2 = 0.0625f;
      for (int i = gt; i < 256 * 32; i += NGT) { const int k = i >> 5, l0 = (i & 31) * 8; float c[8], s[8];
#pragma unroll
        for (int e = 0; e < 8; ++e) { const int m = (k * (l0 + e)) & 255; const float x = m * (1.f / 128.f); c[e] = cospif(x) * sc2; s[e] = -sinpif(x) * sc2; }
        u32x4 a, b; a.x = pk2(c[0], c[1]); a.y = pk2(c[2], c[3]); a.z = pk2(c[4], c[5]); a.w = pk2(c[6], c[7]); b.x = pk2(s[0], s[1]); b.y = pk2(s[2], s[3]); b.z = pk2(s[4], s[5]); b.w = pk2(s[6], s[7]);
        *(u32x4*)(DC + (size_t)k * 512 + l0) = a; *(u32x4*)(DC + (size_t)k * 512 + 256 + l0) = b; } }
}

__device__ __forceinline__ void gen_dftl(unsigned char* ws, int vb, int VG) {
    const int gt = vb * 512 + opaque_tid(), NGT = VG * 512;
    bf16* DL = (bf16*)(ws + WS_DFTL); const float sc = 0.02209708691207961f;
    for (int i = gt; i < 1024 * 256; i += NGT) { const int k = i >> 8, l0 = (i & 255) * 8; float c[8], s[8];
#pragma unroll
        for (int e = 0; e < 8; ++e) { const int m = (k * (l0 + e)) & 2047; const float x = m * (1.f / 1024.f); c[e] = cospif(x) * sc; s[e] = sinpif(x) * sc; }
        u32x4 a, b; a.x = pk2(c[0], c[1]); a.y = pk2(c[2], c[3]); a.z = pk2(c[4], c[5]); a.w = pk2(c[6], c[7]); b.x = pk2(s[0], s[1]); b.y = pk2(s[2], s[3]); b.z = pk2(s[4], s[5]); b.w = pk2(s[6], s[7]);
        *(u32x4*)(DL + (size_t)k * 2048 + l0) = a; *(u32x4*)(DL + (size_t)(1024 + k) * 2048 + l0) = b; }
}
__device__ __forceinline__ void fnet_combine(unsigned char* ws, int vb, int VG) {
    const int tid = opaque_tid(); const int gt = vb * 512 + tid, NGT = VG * 512;
    const bf16* PQ = (const bf16*)(ws + WS_PQ); bf16* MIX2 = (bf16*)(ws + WS_R1); const bf16* ZTL = (const bf16*)(ws + WS_R2 + R2_ZTL);
    for (int i = gt; i < 1024 * 512; i += NGT) { const int k = i >> 9, c0 = (i & 511) * 8, b = c0 >> 9, n = c0 & 511;
        const u32x4 p = *(const u32x4*)(PQ + (size_t)k * 4096 + c0), q = *(const u32x4*)(PQ + (size_t)(1024 + k) * 4096 + c0);
        const f32x4 p0 = {bflo(p.x), bfhi(p.x), bflo(p.y), bfhi(p.y)}, p1 = {bflo(p.z), bfhi(p.z), bflo(p.w), bfhi(p.w)};
        const f32x4 q0 = {bflo(q.x), bfhi(q.x), bflo(q.y), bfhi(q.y)}, q1 = {bflo(q.z), bfhi(q.z), bflo(q.w), bfhi(q.w)};
        *(u32x4*)(MIX2 + (size_t)(TC + b * 2048 + k) * D + 512 + n) = pack8(p0 - q0, p1 - q1);
        if (k > 0) *(u32x4*)(MIX2 + (size_t)(TC + b * 2048 + 2048 - k) * D + 512 + n) = pack8(p0 + q0, p1 + q1); }
    const int lane = tid & 63, gw = vb * 8 + (tid >> 6), NGW = VG * 8;
    for (int col = gw; col < 4096; col += NGW) { const bf16* xr = ZTL + (size_t)col * 4096; float s = 0.f;
#pragma unroll
        for (int j = 0; j < 4; ++j) { const u32x4 v = *(const u32x4*)(xr + 8 * lane + 512 * j);
            s += (bflo(v.x) - bfhi(v.x)) + (bflo(v.y) - bfhi(v.y)) + (bflo(v.z) - bfhi(v.z)) + (bflo(v.w) - bfhi(v.w)); }
        s = wave_sum(s) * 0.02209708691207961f;
        if (lane == 0) { const int b = col >> 9, n = col & 511; MIX2[(size_t)(TC + b * 2048 + 1024) * D + 512 + n] = (bf16)f2bf(s); } }
}

__device__ __forceinline__ void gen_s5(CArgs& A, unsigned char* lds, int vb, int VG) {
    const int tid = opaque_tid(); const int gt = vb * 512 + tid, NGT = VG * 512; unsigned char* ws = A.ws;
    { const float* lamr = A.in[26]; const float* lami = A.in[27]; const float* lstep = A.in[28];
      const float* bre = A.in[29]; const float* bim = A.in[30]; const float* cre = A.in[31]; const float* cim = A.in[32]; const float* dsk = A.in[33];
      bf16* WY = (bf16*)(ws + WS_WWY); bf16* BS = (bf16*)(ws + WS_WBS);
      { float* Qr = (float*)lds; float* Qi = Qr + 2048; float* Tt = Qi + 2048;
        for (int item = vb; item < 512; item += VG) {
          const int g = item >> 4, tau = item & 15;
          __syncthreads();
#pragma unroll
          for (int q = 0; q < 4; ++q) { const int e = tid + 512 * q, d = e >> 10, p = (e >> 4) & 63, cp = e & 15;
              const float step = __expf(lstep[d * 32 + g]); const float lre = lamr[(d * 32 + g) * 64 + p], lim = lami[(d * 32 + g) * 64 + p];
              float kr, ki; s5_k(lre, lim, step, kr, ki); float pr, pi; cpow(lre, lim, step, (float)tau, pr, pi);
              const float br = bre[(g * 64 + p) * 16 + cp], bi = bim[(g * 64 + p) * 16 + cp];
              const float tbr = kr * br - ki * bi, tbi = kr * bi + ki * br;
              Qr[e] = pr * tbr - pi * tbi; Qi[e] = pr * tbi + pi * tbr; }
          __syncthreads();
          { const int d = tid >> 8, c = (tid >> 4) & 15, cp = tid & 15; float acc = 0.f;
            for (int p = 0; p < 64; ++p) acc += cre[(g * 16 + c) * 64 + p] * Qr[(d * 64 + p) * 16 + cp] - cim[(g * 16 + c) * 64 + p] * Qi[(d * 64 + p) * 16 + cp];
            Tt[tid] = acc; }
          __syncthreads();
          if (tid < 256) { const int c = tid >> 4, cp = tid & 15; const float t0 = Tt[tid], t1 = Tt[256 + tid];
              bf16* base = WY + (size_t)g * 256 * 512;
              if (tau == 0) { const float v = t0 + t1 + (c == cp ? dsk[g * 16 + c] : 0.f); for (int ii = 0; ii < 16; ++ii) base[(size_t)(ii * 16 + c) * 512 + ii * 16 + cp] = (bf16)f2bf(v); }
              else { for (int ii = tau; ii < 16; ++ii) base[(size_t)(ii * 16 + c) * 512 + (ii - tau) * 16 + cp] = (bf16)f2bf(t0);
                     for (int ii = 0; ii < 16 - tau; ++ii) base[(size_t)(ii * 16 + c) * 512 + (ii + tau) * 16 + cp] = (bf16)f2bf(t1); } }
        }
        __syncthreads(); }
      for (int i = gt; i < 32 * 16 * 16 * 128; i += NGT) {
          const int p = i & 63, d = (i >> 6) & 1, c = (i >> 7) & 15, ii = (i >> 11) & 15, g = i >> 15;
          const float step = __expf(lstep[d * 32 + g]); const float lre = lamr[(d * 32 + g) * 64 + p], lim = lami[(d * 32 + g) * 64 + p];
          float pr, pi; cpow(lre, lim, step, d == 0 ? (float)(ii + 1) : (float)(16 - ii), pr, pi);
          const float cr = cre[(g * 16 + c) * 64 + p], ci = cim[(g * 16 + c) * 64 + p];
          const float vr = cr * pr - ci * pi, vi = cr * pi + ci * pr;
          bf16* rowp = WY + ((size_t)g * 256 + ii * 16 + c) * 512 + 256 + d * 128;
          rowp[p] = (bf16)f2bf(vr); rowp[64 + p] = (bf16)f2bf(-vi);
      }
      for (int i = gt; i < 32 * 2 * 64 * 256; i += NGT) {
          const int cp = i & 15, j = (i >> 4) & 15, p = (i >> 8) & 63, d = (i >> 14) & 1, g = i >> 15;
          const float step = __expf(lstep[d * 32 + g]); const float lre = lamr[(d * 32 + g) * 64 + p], lim = lami[(d * 32 + g) * 64 + p];
          float kr, ki; s5_k(lre, lim, step, kr, ki); float pr, pi; cpow(lre, lim, step, d == 0 ? (float)(15 - j) : (float)j, pr, pi);
          const float br = bre[(g * 64 + p) * 16 + cp], bi = bim[(g * 64 + p) * 16 + cp];
          const float tbr = kr * br - ki * bi, tbi = kr * bi + ki * br;
          bf16* o = BS + ((size_t)g * 256 + d * 128 + p) * 256 + j * 16 + cp;
          o[0] = (bf16)f2bf(pr * tbr - pi * tbi); o[(size_t)64 * 256] = (bf16)f2bf(pr * tbi + pi * tbr);
      }
    }
}

__device__ __forceinline__ void normpass0(const float* xp, const float* xs, const float* gam, const float* scale, bf16* H, float* rss) {
    const int tid_ = opaque_tid(); const int lane = tid_ & 63, gw = blockIdx.x * 8 + (tid_ >> 6), NGW = gridDim.x * 8;
    for (int row = gw; row < T; row += NGW) {
        const float* xr = row < TC ? xp + (size_t)row * D : xs + (size_t)(row - TC) * D;
        f32x4 v[4]; float s = 0.f;
#pragma unroll
        for (int j = 0; j < 4; ++j) { v[j] = *(const f32x4*)(xr + 4 * lane + 256 * j); s += (v[j][0] * v[j][0] + v[j][1] * v[j][1]) + (v[j][2] * v[j][2] + v[j][3] * v[j][3]); }
        s = wave_sum(s); if (lane == 0) rss[row] = s;
        const int mr = mod_row(row);
#pragma unroll
        for (int j = 0; j < 4; ++j) { const int c = 4 * lane + 256 * j; const f32x4 g = *(const f32x4*)(gam + c), sc = *(const f32x4*)(scale + mr * 6144 + c);
            const f32x4 y = v[j] * g * (sc + 1.f); u32x2 w; w.x = cvt_pk_bf16(y[0], y[1]); w.y = cvt_pk_bf16(y[2], y[3]); *(u32x2*)(H + (size_t)row * D + c) = w; }
    }
}
__device__ __forceinline__ void sw_compute(const bf16* WT, int N, const float* shift, float* SWo, float* sh, int gw0, int NGW0) {
    const int tid = opaque_tid(), lane = tid & 63;
    __syncthreads();
    for (int i = tid; i < 9 * 1024; i += 512) sh[i] = shift[(i >> 10) * 6144 + (i & 1023)];
    __syncthreads();
    for (int n = gw0; n < N; n += NGW0) {
        float w[16];
#pragma unroll
        for (int j = 0; j < 4; ++j) { const u32x2 a = *(const u32x2*)(WT + (size_t)n * 1024 + 4 * lane + 256 * j); w[4 * j] = bflo(a.x); w[4 * j + 1] = bfhi(a.x); w[4 * j + 2] = bflo(a.y); w[4 * j + 3] = bfhi(a.y); }
#pragma unroll
        for (int r = 0; r < 9; ++r) { float s = 0.f;
#pragma unroll
            for (int j = 0; j < 4; ++j) { const f32x4 q = *(const f32x4*)(sh + r * 1024 + 4 * lane + 256 * j); s += (w[4 * j] * q[0] + w[4 * j + 1] * q[1]) + (w[4 * j + 2] * q[2] + w[4 * j + 3] * q[3]); }
            s = wave_sum(s); if (lane == 0) SWo[r * N + n] = s; }
    }
    __syncthreads();
}
__device__ __forceinline__ void final_norm_phase(float* XR, const float* gam, const float* rss) {
    const int tid_ = opaque_tid(); const int lane = tid_ & 63, gw = blockIdx.x * 8 + (tid_ >> 6), NGW = gridDim.x * 8;
    for (int row = gw; row < T; row += NGW) {
        float* xr = XR + (size_t)row * D; const float rstd = rsqrtf(rss[row] * (1.f / D) + 1e-6f);
#pragma unroll
        for (int j = 0; j < 4; ++j) { const int c = 4 * lane + 256 * j; const f32x4 g = *(const f32x4*)(gam + c); *(f32x4*)(xr + c) = *(const f32x4*)(xr + c) * rstd * g; }
    }
}
__device__ __forceinline__ void gate_phase(const bf16* YD, bf16* PROJ, const float* gam) {
    const int tid_ = opaque_tid(); const int lane = tid_ & 63, gw = blockIdx.x * 8 + (tid_ >> 6), NGW = gridDim.x * 8;
    for (int row = gw; row < T; row += NGW) {
        const u32x4 a = *(const u32x4*)(YD + (size_t)row * 512 + 8 * lane), b = *(const u32x4*)(YD + ((size_t)T + row) * 512 + 8 * lane), z = *(const u32x4*)(PROJ + (size_t)row * PLD + 8 * lane);
        float y[8];
        y[0] = (bflo(a.x) + bflo(b.x)) * silu_f(bflo(z.x)); y[1] = (bfhi(a.x) + bfhi(b.x)) * silu_f(bfhi(z.x));
        y[2] = (bflo(a.y) + bflo(b.y)) * silu_f(bflo(z.y)); y[3] = (bfhi(a.y) + bfhi(b.y)) * silu_f(bfhi(z.y));
        y[4] = (bflo(a.z) + bflo(b.z)) * silu_f(bflo(z.z)); y[5] = (bfhi(a.z) + bfhi(b.z)) * silu_f(bfhi(z.z));
        y[6] = (bflo(a.w) + bflo(b.w)) * silu_f(bflo(z.w)); y[7] = (bfhi(a.w) + bfhi(b.w)) * silu_f(bfhi(z.w));
        float s = 0.f;
#pragma unroll
        for (int e = 0; e < 8; ++e) s += y[e] * y[e];
        const float rstd = rsqrtf(wave_sum(s) * (1.f / 512.f) + 1e-6f);
        const f32x4 g0 = *(const f32x4*)(gam + 8 * lane), g1 = *(const f32x4*)(gam + 8 * lane + 4);
        u32x4 o; o.x = cvt_pk_bf16(y[0] * rstd * g0[0], y[1] * rstd * g0[1]); o.y = cvt_pk_bf16(y[2] * rstd * g0[2], y[3] * rstd * g0[3]);
        o.z = cvt_pk_bf16(y[4] * rstd * g1[0], y[5] * rstd * g1[1]); o.w = cvt_pk_bf16(y[6] * rstd * g1[2], y[7] * rstd * g1[3]);
        *(u32x4*)(PROJ + (size_t)row * PLD + 8 * lane) = o;
    }
}

__device__ __forceinline__ void conv_phase(CArgs& A) {
    const int gt = blockIdx.x * 512 + opaque_tid(), NGT = gridDim.x * 512;
    const bf16* PROJ = (const bf16*)(A.ws + WS_R2); bf16* XC = (bf16*)(A.ws + WS_XC); const float* cw = A.in[17]; const float* cb = A.in[18];
    for (int i = gt; i < (T / 4) * 96; i += NGT) {
        const int tq = i / 96, cg8 = i - tq * 96, t0 = tq * 4, ch = cg8 * 8;
        const int L = t0 < TC ? 256 : 2048, tl = t0 < TC ? (t0 & 255) : ((t0 - TC) & 2047);
        u32x4 raw[8];
#pragma unroll
        for (int q = 0; q < 8; ++q) { const int dt = q - 2; const int tt = min(max(tl + dt, 0), L - 1); raw[q] = *(const u32x4*)(PROJ + (size_t)(t0 - tl + tt) * PLD + PX + ch); }
        f32x4 w0[5], w1[5];
#pragma unroll
        for (int wv = 0; wv < 5; ++wv) { w0[wv] = *(const f32x4*)(cw + wv * 768 + ch); w1[wv] = *(const f32x4*)(cw + wv * 768 + ch + 4); }
        const f32x4 b0 = *(const f32x4*)(cb + ch), b1 = *(const f32x4*)(cb + ch + 4);
#pragma unroll
        for (int o = 0; o < 4; ++o) { f32x4 a0 = b0, a1 = b1;
#pragma unroll
            for (int wv = 0; wv < 5; ++wv) { const int tt = tl + o + wv - 2; const float mk = (tt >= 0 && tt < L) ? 1.f : 0.f; const u32x4 rw = raw[o + wv];
                const f32x4 x0 = {bflo(rw.x), bfhi(rw.x), bflo(rw.y), bfhi(rw.y)}, x1 = {bflo(rw.z), bfhi(rw.z), bflo(rw.w), bfhi(rw.w)};
                a0 = a0 + w0[wv] * x0 * mk; a1 = a1 + w1[wv] * x1 * mk; }
            f32x4 s0, s1;
#pragma unroll
            for (int e = 0; e < 4; ++e) { s0[e] = silu_f(a0[e]); s1[e] = silu_f(a1[e]); }
            *(u32x4*)(XC + (size_t)(t0 + o) * 768 + ch) = pack8(s0, s1); }
    }
}

__device__ __forceinline__ void ssd_item(CArgs& A, unsigned char* lds, int item) {
    const int tid = opaque_tid(), lane = tid & 63, w = __builtin_amdgcn_readfirstlane(tid >> 6), fr = lane & 15, fq = lane >> 4;
    int seq, dir, h, L, tok0, nch; bool lat;
    if (item < 128) { lat = true; seq = item >> 4; dir = (item >> 3) & 1; h = item & 7; L = 2048; tok0 = TC + seq * 2048; nch = 16; }
    else { const int it = item - 128; lat = false; seq = it >> 4; dir = (it >> 3) & 1; h = it & 7; L = 256; tok0 = seq * 256; nch = 2; }
    const int g = h >> 2;
    bf16* Cm = (bf16*)lds; bf16* Bm = Cm + 128 * 72; bf16* XT = Bm + 128 * 72; bf16* BT = XT + 64 * 136; bf16* Mm = BT + 64 * 136; bf16* ST = Mm + 128 * 136;
    float* cum = (float*)(ST + 64 * 72); float* dtv = cum + 128; float* da = dtv + 128;
    const bf16* PROJ = (const bf16*)(A.ws + WS_R2); const float* DT = (const float*)(A.ws + WS_DT); bf16* YD = (bf16*)(A.ws + WS_R1);
    const int pt = w >> 1, nt0 = 2 * (w & 1);
    f32x4 st[2];
#pragma unroll
    for (int q = 0; q < 2; ++q)
#pragma unroll
        for (int r = 0; r < 4; ++r) { const int p = 16 * pt + 4 * fq + r, n = 16 * (nt0 + q) + fr; st[q][r] = lat ? A.in[4][(size_t)((seq * 2 + dir) * 8 + h) * 4096 + p * 64 + n] : 0.f; }
    const float Aneg = -__expf(A.in[19][dir * 8 + h]); const float dtb = A.in[20][dir * 8 + h]; const float Dh = A.in[21][h];
    const bf16* XC = (const bf16*)(A.ws + WS_XC);
    u32x4 raw[6]; float dtr = 0.f;
#define SSD_FETCH(C_) do { int tl_ = tid; asm volatile("" : "+v"(tl_)); \
        _Pragma("unroll") for (int it = 0; it < 6; ++it) { const int idx = tl_ + 512 * it; const int j = idx & 127, cgp = idx >> 7; const int t = dir ? (L - 1 - ((C_) * 128 + j)) : ((C_) * 128 + j); \
            const int ch = cgp < 8 ? h * 64 + cgp * 8 : (cgp < 16 ? 512 + g * 64 + (cgp - 8) * 8 : 640 + g * 64 + (cgp - 16) * 8); \
            raw[it] = *(const u32x4*)(XC + (size_t)(tok0 + t) * 768 + ch); } \
        if (tl_ < 128) { const int t = dir ? (L - 1 - ((C_) * 128 + tl_)) : ((C_) * 128 + tl_); dtr = DT[(size_t)(tok0 + t) * 8 + h]; } } while (0)
    SSD_FETCH(0);
    for (int c = 0; c < nch; ++c) {
        int tl = tid; asm volatile("" : "+v"(tl));
        float dav = 0.f;
        if (tid < 128) { const float x = dtr + dtb; const float dt = x > 20.f ? x : log1pf(__expf(x)); dtv[tid] = dt; dav = dt * Aneg;
#pragma unroll
            for (int o = 1; o < 64; o <<= 1) { const float tv = __shfl_up(dav, o); if (lane >= o) dav += tv; }
            if (tid == 63) da[0] = dav; }
#pragma unroll
        for (int q = 0; q < 2; ++q)
#pragma unroll
            for (int r = 0; r < 4; ++r) ST[(16 * pt + 4 * fq + r) * 72 + 16 * (nt0 + q) + fr] = (bf16)f2bf(st[q][r]);
        __syncthreads();
        if (tid < 128) { if (tid >= 64) dav += da[0]; cum[tid] = dav; }
        __syncthreads();
        const float cl = cum[127];
#pragma unroll
        for (int it = 0; it < 6; ++it) { const int idx = tl + 512 * it; const int j = idx & 127, cgp = idx >> 7; const u32x4 rw = raw[it];
            if (cgp < 8) { const float dt = dtv[j];
                const float v[8] = {bflo(rw.x) * dt, bfhi(rw.x) * dt, bflo(rw.y) * dt, bfhi(rw.y) * dt, bflo(rw.z) * dt, bfhi(rw.z) * dt, bflo(rw.w) * dt, bfhi(rw.w) * dt};
#pragma unroll
                for (int e = 0; e < 8; ++e) XT[(cgp * 8 + e) * 136 + j] = (bf16)f2bf(v[e]); }
            else if (cgp < 16) { const float te = __expf(cl - cum[j]); const int n0 = (cgp - 8) * 8;
                *(u32x4*)(Bm + j * 72 + n0) = rw;
                const float v[8] = {bflo(rw.x) * te, bfhi(rw.x) * te, bflo(rw.y) * te, bfhi(rw.y) * te, bflo(rw.z) * te, bfhi(rw.z) * te, bflo(rw.w) * te, bfhi(rw.w) * te};
#pragma unroll
                for (int e = 0; e < 8; ++e) BT[(n0 + e) * 136 + j] = (bf16)f2bf(v[e]); }
            else { *(u32x4*)(Cm + j * 72 + (cgp - 16) * 8) = rw; }
        }
        if (c + 1 < nch) SSD_FETCH(c + 1);
        __syncthreads();
        {
            const bf16x8 af0 = ldfrag(Cm + 16 * w * 72, 72, lane, 0), af1 = ldfrag(Cm + 16 * w * 72, 72, lane, 1);
            float dsk[4], cmi[4];
#pragma unroll
            for (int r = 0; r < 4; ++r) { const int i = 16 * w + 4 * fq + r; dsk[r] = dir == 0 ? Dh / dtv[i] : 0.f; cmi[r] = cum[i]; }
            const int jtmax = w | 1;
            for (int jt = 0; jt <= jtmax; ++jt) { f32x4 acc = (f32x4){0.f, 0.f, 0.f, 0.f};
                acc = mma16(af0, ldfrag(Bm + 16 * jt * 72, 72, lane, 0), acc); acc = mma16(af1, ldfrag(Bm + 16 * jt * 72, 72, lane, 1), acc);
                const int j = 16 * jt + fr; const float cmj = cum[j];
#pragma unroll
                for (int r = 0; r < 4; ++r) { const int i = 16 * w + 4 * fq + r; float v = (j <= i) ? acc[r] * __expf(cmi[r] - cmj) : 0.f; if (i == j) v += dsk[r]; Mm[i * 136 + j] = (bf16)f2bf(v); } }
        }
        __syncthreads();
        {
            f32x4 yd[4], yo[4];
#pragma unroll
            for (int q = 0; q < 4; ++q) { yd[q] = (f32x4){0.f, 0.f, 0.f, 0.f}; yo[q] = (f32x4){0.f, 0.f, 0.f, 0.f}; }
#pragma unroll
            for (int ks = 0; ks < 4; ++ks) { if (32 * ks <= 16 * w + 15) { const bf16x8 am = ldfrag(Mm + 16 * w * 136, 136, lane, ks);
#pragma unroll
                for (int q = 0; q < 4; ++q) yd[q] = mma16(am, ldfrag(XT + 16 * q * 136, 136, lane, ks), yd[q]); } }
#pragma unroll
            for (int ks = 0; ks < 2; ++ks) { const bf16x8 ac = ldfrag(Cm + 16 * w * 72, 72, lane, ks);
#pragma unroll
                for (int q = 0; q < 4; ++q) yo[q] = mma16(ac, ldfrag(ST + 16 * q * 72, 72, lane, ks), yo[q]); }
#pragma unroll
            for (int r = 0; r < 4; ++r) { const int i = 16 * w + 4 * fq + r; const float ec = __expf(cum[i]); const int t = dir ? (L - 1 - (c * 128 + i)) : (c * 128 + i);
                bf16* yp = YD + ((size_t)dir * T + tok0 + t) * 512 + h * 64 + fr;
#pragma unroll
                for (int q = 0; q < 4; ++q) yp[16 * q] = (bf16)f2bf(yd[q][r] + ec * yo[q][r]); }
        }
        {
            const float cd = __expf(cl);
#pragma unroll
            for (int q = 0; q < 2; ++q) st[q] = st[q] * cd;
#pragma unroll
            for (int ks = 0; ks < 4; ++ks) { const bf16x8 ax = ldfrag(XT + 16 * pt * 136, 136, lane, ks);
#pragma unroll
                for (int q = 0; q < 2; ++q) st[q] = mma16(ax, ldfrag(BT + 16 * (nt0 + q) * 136, 136, lane, ks), st[q]); }
        }
        __syncthreads();
    }
#undef SSD_FETCH
    if (!lat) {
#pragma unroll
        for (int q = 0; q < 2; ++q)
#pragma unroll
            for (int r = 0; r < 4; ++r) { const int p = 16 * pt + 4 * fq + r, n = 16 * (nt0 + q) + fr; A.out[O_SSD + (size_t)((seq * 2 + dir) * 8 + h) * 4096 + p * 64 + n] = st[q][r]; }
    }
}

template <int CTRL> __device__ __forceinline__ float dpp_f(float v) { return __builtin_bit_cast(float, __builtin_amdgcn_update_dpp(0, __builtin_bit_cast(int, v), CTRL, 0xF, 0xF, true)); }
__device__ __forceinline__ float red16_max(float v) { v = fmaxf(v, dpp_f<0xB1>(v)); v = fmaxf(v, dpp_f<0x4E>(v)); v = fmaxf(v, dpp_f<0x141>(v)); v = fmaxf(v, dpp_f<0x140>(v)); return v; }
__device__ __forceinline__ float red16_sum(float v) { v += dpp_f<0xB1>(v); v += dpp_f<0x4E>(v); v += dpp_f<0x141>(v); v += dpp_f<0x140>(v); return v; }
__device__ __forceinline__ void attn_pair(CArgs& A, unsigned char* lds, int pairidx) {
    const int tid = opaque_tid(), half = __builtin_amdgcn_readfirstlane(tid >> 8), ht = tid & 255, lane = tid & 63, w = __builtin_amdgcn_readfirstlane((tid >> 6) & 3), fr = lane & 15, fq = lane >> 4;
    unsigned char* hl = lds + half * 49152;
    bf16* Ksb = (bf16*)hl; bf16* Vtb = Ksb + 2 * 64 * 72; bf16* Ps = Vtb + 2 * 64 * 72 + w * 16 * 72; float* rp = (float*)(hl + 46080);
    bf16* PROJ = (bf16*)(A.ws + WS_R2);
    const int item = pairidx * 2 + half;
    const bool lat = item < 2048;
    int b, h, r = 0, rs = 0, qtok0, ntiles;
    if (lat) { b = item >> 8; h = (item >> 5) & 7; r = item & 31; qtok0 = TC + b * 2048 + r * 64; rs = min(max(r - 4, 0), 24); ntiles = 12; }
    else { const int it = item - 2048; b = it >> 5; h = (it >> 2) & 7; const int qb = it & 3; qtok0 = b * 256 + qb * 64; ntiles = 4; }
    for (int i = ht; i < 465; i += 256) rp[i] = A.in[23][h * 465 + i];
    bf16x8 qf[2];
    { const bf16* qp = PROJ + (size_t)(qtok0 + 16 * w + fr) * PLD + PQ + h * 64 + fq * 8; qf[0] = *(const bf16x8*)qp; qf[1] = *(const bf16x8*)(qp + 32); }
    f32x4 o[4]; float m[4], l[4];
#pragma unroll
    for (int q = 0; q < 4; ++q) { o[q] = (f32x4){0.f, 0.f, 0.f, 0.f}; m[q] = -1e30f; l[q] = 0.f; }
    int bio[4][4];
#pragma unroll
    for (int t = 0; t < 4; ++t)
#pragma unroll
        for (int rr = 0; rr < 4; ++rr) { const int qc = 16 * w + 4 * fq + rr, kc = 16 * t + fr; const int cs = min(max(qc - 8, 0), 48); bio[t][rr] = ((kc >= cs) && (kc < cs + 16)) ? (kc - qc + 15) : -1; }
    const int tlo = max(w - 1, 0), thi = min(w + 1, 3);
    f32x4 pf[2][4];
#define ATT_PREFETCH(TI) do { _Pragma("unroll") for (int u_ = 0; u_ < 2; ++u_) { const int idx_ = ht + 256 * u_; const int key_ = idx_ & 63, dc_ = idx_ >> 6; \
        if (lat && (TI) >= 8) { const size_t off_ = (((size_t)b * 256 + ((TI) - 8) * 64 + key_) * 8 + h) * 64 + dc_ * 8; \
            pf[u_][0] = *(const f32x4*)(A.in[2] + off_); pf[u_][1] = *(const f32x4*)(A.in[2] + off_ + 4); pf[u_][2] = *(const f32x4*)(A.in[3] + off_); pf[u_][3] = *(const f32x4*)(A.in[3] + off_ + 4); } \
        else { const size_t tok_ = lat ? (size_t)(TC + b * 2048 + (rs + (TI)) * 64 + key_) : (size_t)(b * 256 + (TI) * 64 + key_); \
            pf[u_][0] = *(const f32x4*)(PROJ + tok_ * PLD + PK + h * 64 + dc_ * 8); pf[u_][1] = *(const f32x4*)(PROJ + tok_ * PLD + PV + h * 64 + dc_ * 8); } } } while (0)
    ATT_PREFETCH(0);
    for (int ti = 0; ti < ntiles; ++ti) {
        bf16* Ks = Ksb + (ti & 1) * 64 * 72; bf16* Vt = Vtb + (ti & 1) * 64 * 72;
#pragma unroll
        for (int u = 0; u < 2; ++u) { const int idx = ht + 256 * u; const int key = idx & 63, dc = idx >> 6; u32x4 kv, vv;
            if (lat && ti >= 8) { kv.x = pk2(pf[u][0][0], pf[u][0][1]); kv.y = pk2(pf[u][0][2], pf[u][0][3]); kv.z = pk2(pf[u][1][0], pf[u][1][1]); kv.w = pk2(pf[u][1][2], pf[u][1][3]);
                vv.x = pk2(pf[u][2][0], pf[u][2][1]); vv.y = pk2(pf[u][2][2], pf[u][2][3]); vv.z = pk2(pf[u][3][0], pf[u][3][1]); vv.w = pk2(pf[u][3][2], pf[u][3][3]); }
            else { kv = __builtin_bit_cast(u32x4, pf[u][0]); vv = __builtin_bit_cast(u32x4, pf[u][1]); }
            *(u32x4*)(Ks + key * 72 + dc * 8) = kv;
            bf16* vt = Vt + (dc * 8) * 72 + key;
            vt[0] = (bf16)(vv.x & 0xffff); vt[72] = (bf16)(vv.x >> 16); vt[144] = (bf16)(vv.y & 0xffff); vt[216] = (bf16)(vv.y >> 16);
            vt[288] = (bf16)(vv.z & 0xffff); vt[360] = (bf16)(vv.z >> 16); vt[432] = (bf16)(vv.w & 0xffff); vt[504] = (bf16)(vv.w >> 16); }
        if (ti + 1 < ntiles) ATT_PREFETCH(ti + 1);
        __syncthreads();
        const bool loc = lat && ti < 8;
        f32x4 s[4];
#pragma unroll
        for (int t = 0; t < 4; ++t) {
            if (!loc || (t >= tlo && t <= thi)) { s[t] = (f32x4){0.f, 0.f, 0.f, 0.f};
#pragma unroll
                for (int ks = 0; ks < 2; ++ks) s[t] = mma16(qf[ks], ldfrag(Ks + 16 * t * 72, 72, lane, ks), s[t]);
                if (loc) { const float* rpr = rp + (rs + ti - r + 7) * 31;
#pragma unroll
                    for (int rr = 0; rr < 4; ++rr) s[t][rr] = bio[t][rr] >= 0 ? s[t][rr] + rpr[bio[t][rr]] : -1e30f; } }
            else s[t] = (f32x4){-1e30f, -1e30f, -1e30f, -1e30f}; }
#pragma unroll
        for (int rr = 0; rr < 4; ++rr) {
            float mx = red16_max(fmaxf(fmaxf(s[0][rr], s[1][rr]), fmaxf(s[2][rr], s[3][rr])));
            const float mn = fmaxf(m[rr], mx); const float al = __expf(m[rr] - mn); m[rr] = mn; float sum = 0.f;
#pragma unroll
            for (int t = 0; t < 4; ++t) { const float p = (!loc || (t >= tlo && t <= thi)) ? __expf(s[t][rr] - mn) : 0.f; s[t][rr] = p; sum += p; }
            sum = red16_sum(sum);
            l[rr] = l[rr] * al + sum;
#pragma unroll
            for (int q = 0; q < 4; ++q) o[q][rr] *= al;
        }
#pragma unroll
        for (int t = 0; t < 4; ++t)
#pragma unroll
            for (int rr = 0; rr < 4; ++rr) Ps[(4 * fq + rr) * 72 + 16 * t + fr] = (bf16)f2bf(s[t][rr]);
        LDS_WAIT(); asm volatile("" ::: "memory");
#pragma unroll
        for (int ks = 0; ks < 2; ++ks) { if (!loc || (2 * ks + 1 >= tlo && 2 * ks <= thi)) { const bf16x8 pa = ldfrag(Ps, 72, lane, ks);
#pragma unroll
            for (int q = 0; q < 4; ++q) o[q] = mma16(pa, ldfrag(Vt + 16 * q * 72, 72, lane, ks), o[q]); } }
    }
#undef ATT_PREFETCH
#pragma unroll
    for (int rr = 0; rr < 4; ++rr) { const float inv = 1.f / l[rr]; bf16* op = PROJ + (size_t)(qtok0 + 16 * w + 4 * fq + rr) * PLD + PQ + h * 64 + fr;
#pragma unroll
        for (int q = 0; q < 4; ++q) op[16 * q] = (bf16)f2bf(o[q][rr] * inv); }
}

__device__ __forceinline__ void s5_scan_phase(CArgs& A) {
    const int gt = blockIdx.x * 512 + opaque_tid(), NGT = gridDim.x * 512;
    const float* Sloc = (const float*)(A.ws + WS_R1); bf16* A2 = (bf16*)(A.ws + WS_R2 + R2_A2);
    for (int idx = gt; idx < 163840; idx += NGT) {
        const bool lat = idx < 32768; const int i2 = lat ? idx : idx - 32768;
        const int b = i2 >> 12, rem = i2 & 4095, g = rem >> 7, d = (rem >> 6) & 1, p = rem & 63;
        const int nch = lat ? 128 : 16, chunk0 = lat ? 512 + b * 128 : b * 16, rowbase = g * 1536 + chunk0;
        const float step = __expf(A.in[28][d * 32 + g]); const float lre = A.in[26][(d * 32 + g) * 64 + p], lim = A.in[27][(d * 32 + g) * 64 + p];
        float ar, ai; cpow(lre, lim, step, 16.f, ar, ai);
        float sr = 0.f, si = 0.f;
        if (lat) { const float* s0 = A.in[5] + ((size_t)((b * 2 + d) * 32 + g) * 64 + p) * 2; sr = s0[0]; si = s0[1]; }
        for (int n0 = 0; n0 < nch; n0 += 16) {
            float xr[16], xi[16];
#pragma unroll
            for (int u = 0; u < 16; ++u) { const int n = d == 0 ? n0 + u : nch - 1 - (n0 + u); const float* sp = Sloc + (size_t)(rowbase + n) * 256 + d * 128 + p; xr[u] = sp[0]; xi[u] = sp[64]; }
#pragma unroll
            for (int u = 0; u < 16; ++u) { const int n = d == 0 ? n0 + u : nch - 1 - (n0 + u); bf16* ap = A2 + (size_t)(rowbase + n) * 512 + 256 + d * 128 + p;
                ap[0] = (bf16)f2bf(sr); ap[64] = (bf16)f2bf(si);
                const float nr = ar * sr - ai * si + xr[u], ni = ar * si + ai * sr + xi[u]; sr = nr; si = ni; }
        }
        if (!lat) { float* o = A.out + O_S5 + ((size_t)((b * 2 + d) * 32 + g) * 64 + p) * 2; o[0] = sr; o[1] = si; }
    }
}


#define XB_TMO      128
#define XB_XCNT(j)  (256  + 64 * (j))
#define XB_XSUB(j)  (1280 + 64 * (j))
#define XB_XGEN(j)  (2304 + 64 * (j))
#define XB_TOP      3328
#define XB_TOPGEN   3392
#define XB_SPIN_CAP (1u << 22)
__device__ __forceinline__ unsigned xb_ld(unsigned* p)              { return __hip_atomic_load(p, __ATOMIC_RELAXED, __HIP_MEMORY_SCOPE_AGENT); }
__device__ __forceinline__ unsigned xb_add(unsigned* p, unsigned v) { return __hip_atomic_fetch_add(p, v, __ATOMIC_RELAXED, __HIP_MEMORY_SCOPE_AGENT); }
__device__ __forceinline__ unsigned xb_xcc_id() { return (unsigned)__builtin_amdgcn_s_getreg((3 << 11) | 20) & 0xFu; }
#define XB_SPIN(cond, bar) do { unsigned _sp = 0; while (cond) { __builtin_amdgcn_s_sleep(1); \
    if ((++_sp & 255u) == 0u) { if (xb_ld(&(bar)[XB_TMO])) break; if (_sp > XB_SPIN_CAP) { atomicAdd(&(bar)[XB_TMO], 1u); break; } } } } while (0)
struct XcdBarrier { unsigned* bar; unsigned x; volatile unsigned* st; };
__device__ __forceinline__ XcdBarrier xcd_barrier_post(unsigned* bar, volatile unsigned* st) {
    XcdBarrier b; b.bar = bar; b.x = xb_xcc_id(); b.st = st;
    if (threadIdx.x == 0) (void)xb_add(&bar[XB_XCNT(b.x)], 1u);
    return b;
}
__device__ __forceinline__ void xcd_barrier_complete(unsigned* bar, unsigned x, unsigned& nloc, unsigned& nx) {
    const unsigned G = gridDim.x;
    unsigned sum, cnt, mine, sp = 0u;
    for (;;) {
        sum = 0u; cnt = 0u; mine = 0u;
#pragma unroll
        for (unsigned j = 0; j < 16; ++j) { const unsigned c = xb_ld(&bar[XB_XCNT(j)]); sum += c; cnt += (c > 0u) ? 1u : 0u; mine = (j == x) ? c : mine; }
        if (sum == G) break;
        __builtin_amdgcn_s_sleep(1);
        if ((++sp & 255u) == 0u) { if (xb_ld(&bar[XB_TMO])) break; if (sp > XB_SPIN_CAP) { atomicAdd(&bar[XB_TMO], 1u); break; } }
    }
    nloc = mine > 0u ? mine : 1u; nx = cnt > 0u ? cnt : 1u;
}
__device__ __forceinline__ void xcd_barrier(const XcdBarrier& b) {
    asm volatile("s_waitcnt vmcnt(0)" ::: "memory");
    __syncthreads();
    if (threadIdx.x == 0) {
        unsigned* bar = b.bar;
        __builtin_amdgcn_s_waitcnt(0);
        unsigned nloc = b.st[0], nx = b.st[1];
        if (nloc == 0u) { xcd_barrier_complete(bar, b.x, nloc, nx); b.st[0] = nloc; b.st[1] = nx; }
        const unsigned old = xb_add(&bar[XB_XSUB(b.x)], 1u);
        const unsigned gen = old / nloc;
        if (old + 1u == (gen + 1u) * nloc) {
            __builtin_amdgcn_fence(__ATOMIC_RELEASE, "agent");
            asm volatile("s_waitcnt vmcnt(0)" ::: "memory");
            const unsigned og = xb_add(&bar[XB_TOP], 1u);
            const unsigned tg = og / nx;
            if (og + 1u == (tg + 1u) * nx) xb_add(&bar[XB_TOPGEN], 1u);
            else XB_SPIN(xb_ld(&bar[XB_TOPGEN]) == tg, bar);
            __builtin_amdgcn_fence(__ATOMIC_ACQUIRE, "agent");
            xb_add(&bar[XB_XGEN(b.x)], 1u);
            asm volatile("s_waitcnt vmcnt(0)" ::: "memory");
        } else {
            XB_SPIN(xb_ld(&bar[XB_XGEN(b.x)]) == gen, bar);
            __builtin_amdgcn_fence(__ATOMIC_ACQUIRE, "agent");
            asm volatile("s_waitcnt vmcnt(0)" ::: "memory");
        }
    }
    __syncthreads();
}

__global__ void __launch_bounds__(512, 2) mk_fwd(Args Aparam) {
    extern __shared__ __attribute__((aligned(16))) unsigned char lds[];
    cg::grid_group grid = cg::this_grid();
    const int G = gridDim.x, bx = blockIdx.x;
    unsigned char* ws = Aparam.ws;
    LAS unsigned char* ldsl = (LAS unsigned char*)lds;
    const int lo = Aparam.ph_lo, hi = Aparam.ph_hi;
#define IN(k) (lo <= (k) && (k) < hi)
#define SEAM(k) do { if (IN(k) && (k) + 1 < hi) { if (hi > 1000) grid.sync(); else xcd_barrier(xb); } } while (0)
    volatile unsigned* xst = (volatile unsigned*)(lds + SLOT_OFF + 16);
    if (threadIdx.x == 0) { xst[0] = 0u; xst[1] = 0u; }
    __syncthreads();
    XcdBarrier xb; xb.bar = (unsigned*)(ws + WS_BAR); xb.x = 0; xb.st = xst;
    if (hi - lo > 1) xb = xcd_barrier_post((unsigned*)(ws + WS_BAR), xst);
#define XR (A.out)
#define MODV ((const float*)(ws + WS_MODV))
#define MODV1 (MODV + 9 * 6144)
#define H ((bf16*)(ws + WS_R1))
#define PROJ ((bf16*)(ws + WS_R2))
#define Gb ((bf16*)(ws + WS_R2))
#define MIX2 ((bf16*)(ws + WS_R1))
#define A2 ((bf16*)(ws + WS_R2 + R2_A2))
#define ZTL ((bf16*)(ws + WS_R2 + R2_ZTL))
#define ZTC ((bf16*)(ws + WS_R2 + R2_ZTC))
#define G5 ((bf16*)(ws + WS_R2 + R2_G5))
#define RSS ((float*)(ws + WS_RSS))
#define SWT ((float*)(ws + WS_SW))
#define H2 ((bf16*)(ws + WS_R2 + 84 * MiB))
#define G1 ((bf16*)(ws + WS_R1))
    if (IN(0)) { CArgs& A = *kargs(); unsigned char* ws = A.ws; (void)ws; prologue(A, lds); } SEAM(0);
    if (IN(1)) { CArgs& A = *kargs(); unsigned char* ws = A.ws; (void)ws; normpass0(A.in[0], A.in[1], A.in[10], MODV + 1024, H, RSS);
        const int tid = opaque_tid(); const int gw = bx * 8 + (tid >> 6), NGW = G * 8;
        sw_compute((const bf16*)(ws + WS_WEVIN), 3072, MODV, SWT + SW0_OFF, (float*)lds, gw, NGW);
        sw_compute((const bf16*)(ws + WS_WODIN), 1536, MODV1, SWT + SW2_OFF, (float*)lds, gw, NGW); } SEAM(1);
    if (IN(2)) { CArgs& A = *kargs(); unsigned char* ws = A.ws; (void)ws; pg8::Gemm g{H, (const bf16*)(ws + WS_WEVIN), 1024, 1024, 1024}; pg8::StaticOrder S; S.init(T, 3072, G, bx);
        pg8::Epi8N<EInProj0> E{{PROJ, (float*)(ws + WS_DT), A.out + O_K, A.out + O_V}, RSS, SWT + SW0_OFF, 3072}; pg8::gemm_phase(ldsl, g, S, E);
        if (bx >= 128) { const int tid = opaque_tid(); float* scr = (float*)(lds + (tid >> 6) * 17408); const int gw = (bx - 128) * 8 + (tid >> 6), NGW = (G - 128) * 8, lane = tid & 63;
            transpose_all<2>(A.in[12], 1024, 2816, 2816, (bf16*)(ws + WS_WFUP), scr, gw, NGW, lane);
            transpose_all<3>(A.in[13], 1024, 2816, 2816, (bf16*)(ws + WS_WFUP), scr, gw, NGW, lane); } } SEAM(2);
    if (IN(2)) { CArgs& A = *kargs(); conv_phase(A); } SEAM(2);
    if (IN(3)) { CArgs& A = *kargs(); unsigned char* ws = A.ws; (void)ws;
        unsigned* ctr = (unsigned*)(ws + WS_CTL); volatile int* slot = (volatile int*)(lds + SLOT_OFF);
        for (;;) { __syncthreads(); if (opaque_tid() == 0) *slot = (int)atomicAdd(ctr, 1u); __syncthreads(); const int it = *slot; if (it >= 640) break; ssd_item(A, lds, it); }
        for (;;) { __syncthreads(); if (opaque_tid() == 0) *slot = (int)atomicAdd(ctr + 64, 1u); __syncthreads(); const int it = *slot; if (it >= 1536) break; attn_pair(A, lds, it); }
    } SEAM(3);
    if (IN(4)) { CArgs& A = *kargs(); unsigned char* ws = A.ws; (void)ws; gate_phase((const bf16*)(ws + WS_R1), PROJ, A.in[22]); } SEAM(4);
    if (IN(5)) { CArgs& A = *kargs(); unsigned char* ws = A.ws; (void)ws; pg8::Gemm g{PROJ, (const bf16*)(ws + WS_WEVOUT), 1024, PLD, 1024}; pg8::StaticOrder S; S.init(T, 1024, G, bx);
        pg8::EpiResid E{A.in[0], A.in[1], XR, MODV + 2048, 1, H, A.in[11], MODV + 4096, RSS + T};
        if (bx >= 128) { gen_dftl(ws, bx - 128, G - 128);
            const int tid = opaque_tid(); float* scr = (float*)(lds + (tid >> 6) * 17408); const int gw = (bx - 128) * 8 + (tid >> 6), NGW = (G - 128) * 8, lane = tid & 63;
            transpose_all<0>(A.in[14], 2816, 1024, 1024, (bf16*)(ws + WS_WFDN), scr, gw, NGW, lane);
            sw_compute((const bf16*)(ws + WS_WFUP), 5632, MODV + 3072, SWT + SW1_OFF, (float*)lds, gw, NGW); }
        pg8::gemm_phase(ldsl, g, S, E); } SEAM(5);
    if (IN(7)) { CArgs& A = *kargs(); unsigned char* ws = A.ws; (void)ws; pg8::Gemm g{H, (const bf16*)(ws + WS_WFUP), 1024, 1024, 1024}; pg8::StaticOrder S; S.init(T, 5632, G, bx);
        pg8::Epi8N<ESwiglu> E{{Gb}, RSS + T, SWT + SW1_OFF, 5632}; pg8::gemm_phase(ldsl, g, S, E); } SEAM(7);
    if (IN(8)) { CArgs& A = *kargs(); unsigned char* ws = A.ws; (void)ws; pg8::Gemm g{Gb, (const bf16*)(ws + WS_WFDN), 2816, 2816, 2816}; pg8::StaticOrder S; S.init(T, 1024, G, bx);
        pg8::EpiResid E{A.in[0], A.in[1], XR, MODV + 5120, 0, H, A.in[10] + 1024, MODV1 + 1024, RSS + 2 * T};
        if (bx >= 128) { gen_s5(A, lds, bx - 128, G - 128); __syncthreads();
            const int tid = opaque_tid(); float* scr = (float*)(lds + (tid >> 6) * 17408); const int gw = (bx - 128) * 8 + (tid >> 6), NGW = (G - 128) * 8, lane = tid & 63;
            transpose_all<2>(A.in[12] + (size_t)1024 * 2816, 1024, 2816, 2816, (bf16*)(ws + WS_WFUP), scr, gw, NGW, lane);
            transpose_all<3>(A.in[13] + (size_t)1024 * 2816, 1024, 2816, 2816, (bf16*)(ws + WS_WFUP), scr, gw, NGW, lane); __syncthreads(); }
        pg8::gemm_phase(ldsl, g, S, E); } SEAM(8);
    if (IN(10)) { CArgs& A = *kargs(); unsigned char* ws = A.ws; (void)ws; pg8::Gemm g{H, (const bf16*)(ws + WS_WODIN), 1024, 1024, 1024}; pg8::StaticOrder S; S.init(T, 1536, G, bx);
        pg8::Epi8N<EInProj1> E{{A2, ZTL, ZTC}, RSS + 2 * T, SWT + SW2_OFF, 1536}; pg8::gemm_phase(ldsl, g, S, E); } SEAM(10);
    if (IN(11)) { CArgs& A = *kargs(); unsigned char* ws = A.ws; (void)ws; pg8::Gemm g{A2, (const bf16*)(ws + WS_WBS), 256, 512, 256}; pg8::SchedS5 S{G, bx, 192};
        pg8::Epi8<ESloc> E{{(float*)(ws + WS_R1)}}; pg8::gemm_phase(ldsl, g, S, E); } SEAM(11);
    if (IN(12)) { CArgs& A = *kargs(); unsigned char* ws = A.ws; (void)ws; s5_scan_phase(A);
        __syncthreads();
        const int tid = opaque_tid(); float* scr = (float*)(lds + (tid >> 6) * 17408); const int gw = bx * 8 + (tid >> 6), NGW = G * 8, lane = tid & 63;
        transpose_all<0>(A.in[14] + (size_t)2816 * 1024, 2816, 1024, 1024, (bf16*)(ws + WS_WFDN), scr, gw, NGW, lane);
        __syncthreads(); } SEAM(12);
    if (IN(13)) { CArgs& A = *kargs(); unsigned char* ws = A.ws; (void)ws;
        { pg8::Gemm g{(const bf16*)(ws + WS_DFTL), ZTL, 2048, 2048, 4096}; pg8::StaticOrder S; S.init(1024, 4096, 64, bx < 64 ? bx : (1 << 30));
          pg8::Epi8<EFnetL> E{{(bf16*)(ws + WS_PQ)}}; pg8::gemm_phase(ldsl, g, S, E); }
        { pg8::Gemm g{(const bf16*)(ws + WS_DFTL) + (size_t)1024 * 2048, ZTL + 2048, 2048, 2048, 4096}; pg8::StaticOrder S; S.init(1024, 4096, 64, (bx >= 64 && bx < 128) ? bx - 64 : (1 << 30));
          pg8::Epi8<EFnetL> E{{(bf16*)(ws + WS_PQ) + (size_t)1024 * 4096}}; pg8::gemm_phase(ldsl, g, S, E); }
        { pg8::Gemm g{A2, (const bf16*)(ws + WS_WWY), 512, 512, 512}; pg8::SchedS5 S{128, bx >= 128 ? bx - 128 : (1 << 30), 192};
          pg8::Epi8<EY> E{{G5}}; pg8::gemm_phase(ldsl, g, S, E); }
        { pg8::Gemm g{(const bf16*)(ws + WS_DFTC), ZTC, 512, 512, 512}; pg8::StaticOrder S; S.init(256, 16384, 64, bx >= 192 ? bx - 192 : (1 << 30));
          pg8::Epi8<EFnetC> E{{MIX2}}; pg8::gemm_phase(ldsl, g, S, E); }
    } SEAM(13);
    if (IN(14)) { CArgs& A = *kargs(); unsigned char* ws = A.ws; (void)ws; { pg8::Gemm g{G5, (const bf16*)(ws + WS_WGLU), 512, 512, 512}; pg8::StaticOrder S; S.init(T, 512, G, bx);
        pg8::Epi8<EGlu> E{{G5, A.in[35], MIX2}}; pg8::gemm_phase(ldsl, g, S, E); }
        if (bx >= 192) fnet_combine(ws, bx - 192, G - 192); } SEAM(14);
    if (IN(15)) { CArgs& A = *kargs(); unsigned char* ws = A.ws; (void)ws; pg8::Gemm g{MIX2, (const bf16*)(ws + WS_WODOUT), 1024, 1024, 1024}; pg8::StaticOrder S; S.init(T, 1024, G, bx);
        pg8::EpiResid E{A.in[0], A.in[1], XR, MODV1 + 2048, 0, H2, A.in[11] + 1024, MODV1 + 4096, RSS + 3 * T};
        if (bx >= 128) { const int tid = opaque_tid(); sw_compute((const bf16*)(ws + WS_WFUP), 5632, MODV1 + 3072, SWT + SW3_OFF, (float*)lds, (bx - 128) * 8 + (tid >> 6), (G - 128) * 8); }
        pg8::gemm_phase(ldsl, g, S, E); } SEAM(15);
    if (IN(17)) { CArgs& A = *kargs(); unsigned char* ws = A.ws; (void)ws; pg8::Gemm g{H2, (const bf16*)(ws + WS_WFUP), 1024, 1024, 1024}; pg8::StaticOrder S; S.init(T, 5632, G, bx);
        pg8::Epi8N<ESwiglu> E{{G1}, RSS + 3 * T, SWT + SW3_OFF, 5632}; pg8::gemm_phase(ldsl, g, S, E); } SEAM(17);
    if (IN(18)) { CArgs& A = *kargs(); unsigned char* ws = A.ws; (void)ws; pg8::Gemm g{G1, (const bf16*)(ws + WS_WFDN), 2816, 2816, 2816}; pg8::StaticOrder S; S.init(T, 1024, G, bx);
        pg8::EpiResid E{A.in[0], A.in[1], XR, MODV1 + 5120, 0, (bf16*)nullptr, A.in[15], MODV1, RSS + 4 * T}; pg8::gemm_phase(ldsl, g, S, E); } SEAM(18);
    if (IN(19)) { CArgs& A = *kargs(); unsigned char* ws = A.ws; (void)ws; final_norm_phase(XR, A.in[15], RSS + 4 * T); }
#undef IN
#undef SEAM
#undef XR
#undef MODV
#undef MODV1
#undef H
#undef PROJ
#undef Gb
#undef MIX2
#undef A2
#undef ZTL
#undef ZTC
#undef G5
#undef RSS
#undef SWT
#undef H2
#undef G1
}

extern "C" void kernel_launch(void* const* d_in, const int* in_sizes, int n_in, void* d_out, int out_size, void* d_ws, size_t ws_size, hipStream_t stream) {
    static int grid = 0;
    if (grid == 0) {
        if (n_in != 37 || ws_size < WS_END) { fprintf(stderr, "kernel_launch: unexpected n_in %d / ws %zu\n", n_in, ws_size); grid = -1; return; }
        int dev = 0, cus = 0, per_cu = 0;
        hipGetDevice(&dev); hipDeviceGetAttribute(&cus, hipDeviceAttributeMultiprocessorCount, dev);
        if (hipFuncSetAttribute((const void*)mk_fwd, hipFuncAttributeMaxDynamicSharedMemorySize, LDS_BYTES) != hipSuccess) { fprintf(stderr, "kernel_launch: hipFuncSetAttribute failed\n"); grid = -1; return; }
        hipOccupancyMaxActiveBlocksPerMultiprocessor(&per_cu, (const void*)mk_fwd, 512, LDS_BYTES);
        (void)hipGetLastError();
        if (per_cu < 1) per_cu = 1;
        grid = cus * 1;
        if (grid <= 0) grid = 256;
    }
    if (grid < 0) return;
    hipMemsetAsync((char*)d_ws + WS_CTL, 0, CTL_BYTES, stream);
    Args a{};
    for (int i = 0; i < 37; ++i) a.in[i] = (const float*)d_in[i];
    a.out = (float*)d_out; a.ws = (unsigned char*)d_ws;
#if MK_MODE == 1
    for (int ph = 0; ph < NPH; ++ph) { a.ph_lo = ph; a.ph_hi = ph + 1; hipLaunchKernelGGL(mk_fwd, dim3(grid), dim3(512), LDS_BYTES, stream, a); }
#else
    a.ph_lo = 0; a.ph_hi = NPH;
    void* params[] = {&a};
    hipError_t e = hipLaunchCooperativeKernel((const void*)mk_fwd, dim3(grid), dim3(512), params, LDS_BYTES, stream);
    if (e != hipSuccess) fprintf(stderr, "cooperative launch failed: %s (grid %d)\n", hipGetErrorString(e), grid);
#endif
}
```
